# Optimizing an MI355X kernel written in HIP

```python
import math
import jax, jax.numpy as jnp
from jax import lax
import numpy as np

D_MODEL = 1024
BATCH = 8
SEQ = 4096
DEPTH = 4

N_EVEN = (DEPTH + 1) // 2
N_ODD = DEPTH // 2
W_A = D_MODEL // 2
CONV_A = 3
W_B = D_MODEL // 2
SG_HEADS = 8
SG_HEAD_DIM = W_B // SG_HEADS
CHUNK = 128
EVEN_IN = 3 * W_A + 2 * W_B
EVEN_OUT = W_A + W_B
W_C = D_MODEL // 2
CONV_C = 31
MLA_HEADS = 8
QK_NOPE = 64
QK_ROPE = 32
V_DIM = 64
Q_RANK = 256
KV_RANK = 128
ROPE_THETA = 10000.0
Q_BLOCK = 128
ODD_IN = 2 * W_C + Q_RANK + KV_RANK + QK_ROPE
ODD_OUT = W_C + MLA_HEADS * V_DIM
N_EXPERTS = 32
TOP_K = 4
D_EXPERT = D_MODEL
SWIGLU_LIMIT = 7.0
SWIGLU_ALPHA = 1.702
EXPERT_BLOCK = 128
DEEPNORM_ALPHA = (2.0 * DEPTH) ** 0.25
DEEPNORM_BETA = (8.0 * DEPTH) ** -0.25
LN_EPS = 1e-5
RMS_EPS = 1e-6

kernel_name = 'hybrid_shortconv_sgmlp_conformer_mla_moe_trunk'


def layer_norm(x, g, b):
    xf = x.astype(jnp.float32)
    mu = jnp.mean(xf, axis=-1, keepdims=True)
    var = jnp.mean(jnp.square(xf - mu), axis=-1, keepdims=True)
    y = (xf - mu) * lax.rsqrt(var + LN_EPS)
    return (y * g.astype(jnp.float32) + b.astype(jnp.float32)).astype(x.dtype)


def rms_norm(x, g):
    xf = x.astype(jnp.float32)
    y = xf * lax.rsqrt(jnp.mean(jnp.square(xf), axis=-1, keepdims=True) + RMS_EPS)
    return (y * g.astype(jnp.float32)).astype(x.dtype)


def causal_dwconv(x, w):
    k = w.shape[0]
    return lax.conv_general_dilated(
        x, w[:, None, :].astype(x.dtype), window_strides=(1,), padding=[(k - 1, 0)],
        dimension_numbers=('NWC', 'WIO', 'NWC'), feature_group_count=x.shape[-1])


def rope_tables(positions):
    inv_freq = ROPE_THETA ** (-jnp.arange(0, QK_ROPE, 2, dtype=jnp.float32) / QK_ROPE)
    ang = positions.astype(jnp.float32)[..., None] * inv_freq
    return jnp.cos(ang), jnp.sin(ang)


def apply_rope(x, cos, sin):
    half = x.shape[-1] // 2
    x1 = x[..., :half].astype(jnp.float32)
    x2 = x[..., half:].astype(jnp.float32)
    return jnp.concatenate([x1 * cos - x2 * sin, x2 * cos + x1 * sin], axis=-1).astype(x.dtype)


def causal_block_attention(q, k, v):
    bsz, seq, heads, dqk = q.shape
    n_blk = seq // Q_BLOCK
    scale = 1.0 / math.sqrt(dqk)
    q_blocks = jnp.moveaxis(q.reshape(bsz, n_blk, Q_BLOCK, heads, dqk), 1, 0)
    k_pos = jnp.arange(seq)

    def attend(args):
        qb, i = args
        s = jnp.einsum('bqhd,bkhd->bhqk', qb, k, preferred_element_type=jnp.float32) * scale
        q_pos = i * Q_BLOCK + jnp.arange(Q_BLOCK)
        s = jnp.where(k_pos[None, :] <= q_pos[:, None], s, -1e30)
        p = jax.nn.softmax(s, axis=-1).astype(v.dtype)
        return jnp.einsum('bhqk,bkhd->bqhd', p, v)

    out = lax.map(attend, (q_blocks, jnp.arange(n_blk)))
    return jnp.moveaxis(out, 0, 1).reshape(bsz, seq, heads, v.shape[-1])


def even_mixer(u, w_in, conv_w, sg_w, sg_b, vn_g, vn_b, w_out):
    bsz, seq, _ = u.shape
    proj = u @ w_in
    b_gate, c_gate, xa, zu, zv = jnp.split(proj, [W_A, 2 * W_A, 3 * W_A, 3 * W_A + W_B], axis=-1)
    y_a = b_gate * causal_dwconv(c_gate * xa, conv_w)
    zu = jax.nn.gelu(zu, approximate=False)
    zv = layer_norm(jax.nn.gelu(zv, approximate=False), vn_g, vn_b)
    zv = zv.reshape(bsz, seq // CHUNK, CHUNK, SG_HEADS, SG_HEAD_DIM)
    causal = jnp.tril(jnp.ones((CHUNK, CHUNK), dtype=sg_w.dtype))
    mixed = jnp.einsum('hij,bnjhd->bnihd', sg_w * causal, zv) + jnp.swapaxes(sg_b, 0, 1)[:, :, None]
    y_b = zu * mixed.reshape(bsz, seq, W_B)
    return jnp.concatenate([y_a, y_b], axis=-1) @ w_out


def odd_mixer(u, cos, sin, w_in, dw_w, dw_b, cn_g, cn_b, qn_g, w_uq, kvn_g, w_ukv, w_out):
    bsz, seq, _ = u.shape
    proj = u @ w_in
    ga, gb, cq, ckv, k_rope = jnp.split(
        proj, [W_C, 2 * W_C, 2 * W_C + Q_RANK, 2 * W_C + Q_RANK + KV_RANK], axis=-1)
    h = causal_dwconv(ga * jax.nn.sigmoid(gb), dw_w) + dw_b
    y_c = jax.nn.silu(layer_norm(h, cn_g, cn_b))
    q = (rms_norm(cq, qn_g) @ w_uq).reshape(bsz, seq, MLA_HEADS, QK_NOPE + QK_ROPE)
    kv = (rms_norm(ckv, kvn_g) @ w_ukv).reshape(bsz, seq, MLA_HEADS, QK_NOPE + V_DIM)
    q = jnp.concatenate(
        [q[..., :QK_NOPE], apply_rope(q[..., QK_NOPE:], cos[:, :, None], sin[:, :, None])], axis=-1)
    k_rope = apply_rope(k_rope, cos, sin)[:, :, None, :]
    k = jnp.concatenate(
        [kv[..., :QK_NOPE], jnp.broadcast_to(k_rope, (bsz, seq, MLA_HEADS, QK_ROPE))], axis=-1)
    v = kv[..., QK_NOPE:]
    y_d = causal_block_attention(q, k, v).reshape(bsz, seq, MLA_HEADS * V_DIM)
    return jnp.concatenate([y_c, y_d], axis=-1) @ w_out


def clamped_swiglu(xb, w_gu, b_gu, w_dn, b_dn):
    gu = xb @ w_gu + b_gu
    gate, up = gu[..., :D_EXPERT], gu[..., D_EXPERT:]
    gate = jnp.minimum(gate, SWIGLU_LIMIT)
    up = jnp.clip(up, -SWIGLU_LIMIT, SWIGLU_LIMIT)
    glu = gate * jax.nn.sigmoid(SWIGLU_ALPHA * gate)
    return ((up + 1.0) * glu) @ w_dn + b_dn


def moe_ffn(h, router_w, router_b, w_gu, b_gu, w_dn, b_dn):
    bsz, seq, d = h.shape
    n_tok = bsz * seq
    n_assign = n_tok * TOP_K
    xt = h.reshape(n_tok, d)
    logits = (xt @ router_w + router_b).astype(jnp.float32)
    top_val, top_exp = lax.top_k(logits, TOP_K)
    gates = jax.nn.softmax(top_val, axis=-1)
    flat_exp = top_exp.reshape(-1)
    flat_tok = jnp.arange(n_assign, dtype=jnp.int32) // TOP_K
    flat_gate = gates.reshape(-1)
    order = jnp.argsort(flat_exp)
    sorted_exp = flat_exp[order]
    counts = jnp.bincount(flat_exp, length=N_EXPERTS)
    padded = (counts + EXPERT_BLOCK - 1) // EXPERT_BLOCK * EXPERT_BLOCK
    start = jnp.cumsum(counts) - counts
    pad_end = jnp.cumsum(padded)
    pad_start = pad_end - padded
    dest = pad_start[sorted_exp] + jnp.arange(n_assign, dtype=jnp.int32) - start[sorted_exp]
    n_slots = n_assign + N_EXPERTS * EXPERT_BLOCK
    n_blocks = n_slots // EXPERT_BLOCK
    slot_tok = jnp.full((n_slots,), n_tok, jnp.int32).at[dest].set(flat_tok[order])
    slot_gate = jnp.zeros((n_slots,), jnp.float32).at[dest].set(flat_gate[order])
    block_exp = jnp.minimum(
        jnp.searchsorted(pad_end, jnp.arange(n_blocks, dtype=jnp.int32) * EXPERT_BLOCK, side='right'),
        N_EXPERTS - 1)
    x_pad = jnp.concatenate([xt, jnp.zeros((1, d), xt.dtype)], axis=0)
    xs = x_pad[slot_tok].reshape(n_blocks, EXPERT_BLOCK, d)

    def run_block(args):
        xb, e = args
        return clamped_swiglu(xb, w_gu[e], b_gu[e], w_dn[e], b_dn[e])

    ys = lax.map(run_block, (xs, block_exp)).reshape(n_slots, d)
    out = jnp.zeros((n_tok + 1, d), ys.dtype).at[slot_tok].add(ys * slot_gate[:, None].astype(ys.dtype))
    return out[:n_tok].reshape(bsz, seq, d)


def setup_inputs(seed: int = 0) -> dict:
    key = jax.random.key(seed)
    ks = iter(jax.random.split(key, 48))

    def nrm(shape, scale):
        return jax.random.normal(next(ks), shape, jnp.float32) * scale

    def gain(shape):
        return 1.0 + nrm(shape, 0.02)

    d = D_MODEL
    x = nrm((BATCH, SEQ, d), 1.0)
    c = nrm((BATCH, d), 1.0)
    offsets = jax.random.randint(next(ks), (BATCH, 1), 0, 1024, dtype=jnp.int32)
    positions = (offsets + jnp.arange(SEQ, dtype=jnp.int32)[None, :]).astype(jnp.int32)
    return {
        'x': x,
        'c': c,
        'positions': positions,
        'ada_w': nrm((DEPTH, d, 6 * d), 0.5 * d ** -0.5),
        'ada_b': nrm((DEPTH, 6 * d), 0.02),
        'ln_mix_g': gain((DEPTH, d)),
        'ln_mix_b': nrm((DEPTH, d), 0.02),
        'ln_ffn_g': gain((DEPTH, d)),
        'ln_ffn_b': nrm((DEPTH, d), 0.02),
        'ev_w_in': nrm((N_EVEN, d, EVEN_IN), d ** -0.5),
        'ev_conv_w': nrm((N_EVEN, CONV_A, W_A), CONV_A ** -0.5),
        'ev_sg_w': nrm((N_EVEN, SG_HEADS, CHUNK, CHUNK), CHUNK ** -0.5),
        'ev_sg_b': 1.0 + nrm((N_EVEN, SG_HEADS, CHUNK), 0.1),
        'ev_vn_g': gain((N_EVEN, W_B)),
        'ev_vn_b': nrm((N_EVEN, W_B), 0.02),
        'ev_w_out': nrm((N_EVEN, EVEN_OUT, d), EVEN_OUT ** -0.5 * DEEPNORM_BETA),
        'od_w_in': nrm((N_ODD, d, ODD_IN), d ** -0.5),
        'od_dw_w': nrm((N_ODD, CONV_C, W_C), CONV_C ** -0.5),
        'od_dw_b': nrm((N_ODD, W_C), 0.02),
        'od_cn_g': gain((N_ODD, W_C)),
        'od_cn_b': nrm((N_ODD, W_C), 0.02),
        'od_qn_g': gain((N_ODD, Q_RANK)),
        'od_w_uq': nrm((N_ODD, Q_RANK, MLA_HEADS * (QK_NOPE + QK_ROPE)), Q_RANK ** -0.5),
        'od_kvn_g': gain((N_ODD, KV_RANK)),
        'od_w_ukv': nrm((N_ODD, KV_RANK, MLA_HEADS * (QK_NOPE + V_DIM)), KV_RANK ** -0.5),
        'od_w_out': nrm((N_ODD, ODD_OUT, d), ODD_OUT ** -0.5 * DEEPNORM_BETA),
        'moe_router_w': nrm((DEPTH, d, N_EXPERTS), d ** -0.5),
        'moe_router_b': nrm((DEPTH, N_EXPERTS), 0.01),
        'moe_w_gu': nrm((DEPTH, N_EXPERTS, d, 2 * D_EXPERT), d ** -0.5),
        'moe_b_gu': nrm((DEPTH, N_EXPERTS, 2 * D_EXPERT), 0.02),
        'moe_w_dn': nrm((DEPTH, N_EXPERTS, D_EXPERT, d), D_EXPERT ** -0.5 * DEEPNORM_BETA),
        'moe_b_dn': nrm((DEPTH, N_EXPERTS, d), 0.02),
    }


def reference(x, c, positions, ada_w, ada_b, ln_mix_g, ln_mix_b, ln_ffn_g, ln_ffn_b,
              ev_w_in, ev_conv_w, ev_sg_w, ev_sg_b, ev_vn_g, ev_vn_b, ev_w_out,
              od_w_in, od_dw_w, od_dw_b, od_cn_g, od_cn_b, od_qn_g, od_w_uq, od_kvn_g, od_w_ukv, od_w_out,
              moe_router_w, moe_router_b, moe_w_gu, moe_b_gu, moe_w_dn, moe_b_dn):
    cos, sin = rope_tables(positions)
    cond = jax.nn.silu(c)
    for layer in range(DEPTH):
        mod = (cond @ ada_w[layer] + ada_b[layer])[:, None, :]
        shift_m, scale_m, gate_m, shift_f, scale_f, gate_f = jnp.split(mod, 6, axis=-1)
        u = x * (1.0 + scale_m) + shift_m
        i = layer // 2
        if layer % 2 == 0:
            y = even_mixer(u, ev_w_in[i], ev_conv_w[i], ev_sg_w[i], ev_sg_b[i],
                           ev_vn_g[i], ev_vn_b[i], ev_w_out[i])
        else:
            y = odd_mixer(u, cos, sin, od_w_in[i], od_dw_w[i], od_dw_b[i], od_cn_g[i], od_cn_b[i],
                          od_qn_g[i], od_w_uq[i], od_kvn_g[i], od_w_ukv[i], od_w_out[i])
        x = layer_norm(DEEPNORM_ALPHA * x + (1.0 + gate_m) * y, ln_mix_g[layer], ln_mix_b[layer])
        u = x * (1.0 + scale_f) + shift_f
        y = moe_ffn(u, moe_router_w[layer], moe_router_b[layer], moe_w_gu[layer], moe_b_gu[layer],
                    moe_w_dn[layer], moe_b_dn[layer])
        x = layer_norm(DEEPNORM_ALPHA * x + (1.0 + gate_f) * y, ln_ffn_g[layer], ln_ffn_b[layer])
    return x
```

```cpp
#include <hip/hip_runtime.h>
#include <cstdio>
#include <cstdint>

constexpr int NB = 8, SEQ = 4096, DM = 1024, NT = NB * SEQ, DEPTH = 4;
constexpr int NEXP = 32, TOPK = 4, NASSIGN = NT * TOPK;
constexpr int NSLOT = NASSIGN + NEXP * 256;
constexpr float ALPHA = 1.681792830507429f;
constexpr float LN_EPS = 1e-5f, RMS_EPS = 1e-6f;
constexpr float QSCALE = 0.1472444460259031f;

typedef unsigned short bf16_t;
__device__ __forceinline__ float bf2f(bf16_t v) { return __uint_as_float(((unsigned)v) << 16); }
__device__ __forceinline__ bf16_t f2bf(float f) { unsigned u = __float_as_uint(f); u += 0x7fffu + ((u >> 16) & 1u); return (bf16_t)(u >> 16); }
__device__ __forceinline__ float wave_sum(float v) {
#pragma unroll
    for (int o = 1; o < 64; o <<= 1) v += __shfl_xor(v, o);
    return v;
}
__device__ __forceinline__ float gelu_erf(float x) { return 0.5f * x * (1.0f + erff(x * 0.70710678118654752f)); }
__device__ __forceinline__ float sigmoidf_(float x) { return 1.0f / (1.0f + __expf(-x)); }

constexpr size_t MiB = 1ull << 20;
constexpr size_t WS_CTL = 0;
constexpr size_t WS_MOD = 1 * MiB;
constexpr size_t WS_CS = 2 * MiB;
constexpr size_t WS_X = 8 * MiB;
constexpr size_t WS_V = 136 * MiB;
constexpr size_t WS_U = 264 * MiB;
constexpr size_t WS_Y = 328 * MiB;
constexpr size_t WS_BG = 392 * MiB;
constexpr size_t WS_CX = 424 * MiB;
constexpr size_t WS_GZU = 456 * MiB;
constexpr size_t WS_GZV = 488 * MiB;
constexpr size_t WS_GLU = 520 * MiB;
constexpr size_t WS_CQKV = 552 * MiB;
constexpr size_t WS_CQKVN = 584 * MiB;
constexpr size_t WS_KRR = 616 * MiB;
constexpr size_t WS_KR = 620 * MiB;
constexpr size_t WS_Q = 624 * MiB;
constexpr size_t WS_KN = 672 * MiB;
constexpr size_t WS_VV = 704 * MiB;
constexpr size_t WS_TOPE = 736 * MiB;
constexpr size_t WS_TOPG = 737 * MiB;
constexpr size_t WS_POS = 738 * MiB;
constexpr size_t WS_SLOT = 739 * MiB;
constexpr size_t WS_ROWTOK = 740 * MiB;
constexpr size_t WS_STAT = 741 * MiB;
constexpr size_t WS_H = 744 * MiB;
constexpr size_t WS_YS = 1016 * MiB;
constexpr size_t WS_WT = 1288 * MiB;
constexpr size_t WS_U8 = 3176 * MiB;
constexpr size_t WS_END = 3208 * MiB;
constexpr int CW_CNT = 1024;
constexpr int CW_OFFS = 2048;

__device__ __constant__ double INVF[16] = {1.0, 0.5623413251903491, 0.31622776601683794, 0.1778279410038923, 0.1, 0.05623413251903491, 0.03162277660168379, 0.01778279410038923,
                                            0.01, 0.005623413251903491, 0.0031622776601683794, 0.0017782794100389228, 0.001, 0.0005623413251903491, 0.00031622776601683794, 0.00017782794100389227};

__device__ __forceinline__ void sincos_d(double a, float& c, float& s) {
    const double TWO_PI = 6.283185307179586476925286766559;
    double r = a - rint(a / TWO_PI) * TWO_PI;
    r *= 0.25;
    const double r2 = r * r;
    double sn = r * (1.0 + r2 * (-1.0 / 6 + r2 * (1.0 / 120 + r2 * (-1.0 / 5040 + r2 * (1.0 / 362880 + r2 * (-1.0 / 39916800 + r2 * (1.0 / 6227020800.0 + r2 * (-1.0 / 1307674368000.0))))))));
    double cs = 1.0 + r2 * (-0.5 + r2 * (1.0 / 24 + r2 * (-1.0 / 720 + r2 * (1.0 / 40320 + r2 * (-1.0 / 3628800 + r2 * (1.0 / 479001600.0 + r2 * (-1.0 / 87178291200.0 + r2 * (1.0 / 20922789888000.0))))))));
#pragma unroll
    for (int i = 0; i < 2; ++i) { const double s2 = 2.0 * sn * cs, c2 = 1.0 - 2.0 * sn * sn; sn = s2; cs = c2; }
    c = (float)cs; s = (float)sn;
}
#define LAS __attribute__((address_space(3)))
typedef short bf16x8 __attribute__((ext_vector_type(8)));
typedef float f32x4 __attribute__((ext_vector_type(4)));
typedef unsigned u32x4 __attribute__((ext_vector_type(4)));
constexpr int NWAVES = 8, NTHR = 512;
constexpr int RING_BYTES = 131072;
constexpr int MISC_OFF = 139264;
constexpr int MISC_OFF_OLD_UNUSED = RING_BYTES;
constexpr int LDS_BYTES = 147456;
constexpr size_t WT_GU = WS_WT, WT_DN = WS_WT + 512 * MiB, WT_EIN = WS_WT + 768 * MiB, WT_EOUT = WS_WT + 778 * MiB, WT_OIN = WS_WT + 782 * MiB, WT_OUP = WS_WT + 788 * MiB, WT_OOUT = WS_WT + 791 * MiB, WT_SGW = WS_WT + 795 * MiB;
constexpr int BIASSLOT_OFF = MISC_OFF + 5120;
constexpr int ROWSLOT_OFF = MISC_OFF + 4096;
constexpr int CW_BAR = 4096;

__device__ __forceinline__ int lane_id_asm() { int l; asm volatile("v_mbcnt_lo_u32_b32 %0, -1, 0\n\tv_mbcnt_hi_u32_b32 %0, -1, %0" : "=v"(l)); return l; }
__device__ __forceinline__ float shfl_xor_l(float v, int o, int lane) { return __int_as_float(__builtin_amdgcn_ds_bpermute((lane ^ o) << 2, __float_as_int(v))); }
__device__ __forceinline__ float wave_sum_l(float v, int lane) {
#pragma unroll
    for (int o = 1; o < 64; o <<= 1) v += shfl_xor_l(v, o, lane);
    return v;
}
#define XB_TMO      128
#define XB_XCNT(j)  (256  + 64 * (j))
#define XB_XSUB(j)  (1280 + 64 * (j))
#define XB_XGEN(j)  (2304 + 64 * (j))
#define XB_TOP      3328
#define XB_TOPGEN   3392
#define XCD_BAR_WORDS 3456
#define XB_SPIN_CAP (1u << 18)
__device__ __forceinline__ unsigned xb_ld(unsigned* p)              { return __hip_atomic_load(p, __ATOMIC_RELAXED, __HIP_MEMORY_SCOPE_AGENT); }
__device__ __forceinline__ unsigned xb_add(unsigned* p, unsigned v) { return __hip_atomic_fetch_add(p, v, __ATOMIC_RELAXED, __HIP_MEMORY_SCOPE_AGENT); }
__device__ __forceinline__ unsigned xb_xcc_id() { return (unsigned)__builtin_amdgcn_s_getreg((3 << 11) | 20) & 0xFu; }
#define XB_SPIN(cond, bar) do { unsigned _sp = 0; while (cond) { __builtin_amdgcn_s_sleep(1); \
    if ((++_sp & 255u) == 0u) { if (xb_ld(&(bar)[XB_TMO])) break; if (_sp > XB_SPIN_CAP) { atomicAdd(&(bar)[XB_TMO], 1u); break; } } } } while (0)
struct XcdBarrier { unsigned* bar; unsigned x; volatile LAS unsigned* st; int wave; };
__device__ __forceinline__ XcdBarrier xcd_barrier_post(unsigned* bar, volatile LAS unsigned* st, int wave) {
    XcdBarrier b; b.bar = bar; b.x = xb_xcc_id(); b.st = st; b.wave = wave;
    if (threadIdx.x == 0) (void)xb_add(&bar[XB_XCNT(b.x)], 1u);
    return b;
}
__device__ __forceinline__ void xcd_barrier_complete(unsigned* bar, unsigned x, unsigned& nloc, unsigned& nx) {
    const unsigned G = gridDim.x * gridDim.y * gridDim.z;
    unsigned sum, cnt, mine, sp = 0u;
    for (;;) {
        sum = 0u; cnt = 0u; mine = 0u;
#pragma unroll
        for (unsigned j = 0; j < 16; ++j) { const unsigned c = xb_ld(&bar[XB_XCNT(j)]); sum += c; cnt += (c > 0u) ? 1u : 0u; mine = (j == x) ? c : mine; }
        if (sum == G) break;
        __builtin_amdgcn_s_sleep(1);
        if ((++sp & 255u) == 0u) { if (xb_ld(&bar[XB_TMO])) break; if (sp > XB_SPIN_CAP) { atomicAdd(&bar[XB_TMO], 1u); break; } }
    }
    nloc = mine > 0u ? mine : 1u; nx = cnt > 0u ? cnt : 1u;
}
__device__ __forceinline__ void xcd_barrier(const XcdBarrier& b) {
    asm volatile("s_waitcnt vmcnt(0)" ::: "memory");
    __syncthreads();
    if (b.wave == 0 && lane_id_asm() == 0) {
        unsigned* bar = b.bar; asm volatile("" : "+s"(bar));
        __builtin_amdgcn_s_waitcnt(0);
        unsigned nloc = b.st[0], nx = b.st[1];
        if (nloc == 0u) { xcd_barrier_complete(bar, b.x, nloc, nx); b.st[0] = nloc; b.st[1] = nx; }
        const unsigned old = xb_add(&bar[XB_XSUB(b.x)], 1u);
        const unsigned gen = old / nloc;
        if (old + 1u == (gen + 1u) * nloc) {
            __builtin_amdgcn_fence(__ATOMIC_RELEASE, "agent");
            asm volatile("s_waitcnt vmcnt(0)" ::: "memory");
            const unsigned og = xb_add(&bar[XB_TOP], 1u);
            const unsigned tg = og / nx;
            if (og + 1u == (tg + 1u) * nx) xb_add(&bar[XB_TOPGEN], 1u);
            else XB_SPIN(xb_ld(&bar[XB_TOPGEN]) == tg, bar);
            __builtin_amdgcn_fence(__ATOMIC_ACQUIRE, "agent");
            xb_add(&bar[XB_XGEN(b.x)], 1u);
            asm volatile("s_waitcnt vmcnt(0)" ::: "memory");
        } else {
            XB_SPIN(xb_ld(&bar[XB_XGEN(b.x)]) == gen, bar);
            __builtin_amdgcn_fence(__ATOMIC_ACQUIRE, "agent");
            asm volatile("s_waitcnt vmcnt(0)" ::: "memory");
        }
    }
    __syncthreads();
}

constexpr int W8_GU_SH = 4, W8_DN_SH = 5;
typedef int v8i_t __attribute__((ext_vector_type(8)));
typedef int u32x4i __attribute__((ext_vector_type(4)));
__device__ __forceinline__ unsigned pk4_fp8(float a, float b, float c, float d) { int w = __builtin_amdgcn_cvt_pk_fp8_f32(a, b, 0, false); w = __builtin_amdgcn_cvt_pk_fp8_f32(c, d, w, true); return (unsigned)w; }
namespace pg8 {
constexpr int BM = 256, BK = 64, HALF = 128, HTB = HALF * BK * 2, STAGE_BYTES = 8 * HTB, NXCD = 8, WGM = 8;
__device__ __forceinline__ int lds_byte(int r, int c) { const int st = (r >> 4) * 2 + (c >> 5), rr = r & 15, cc = c & 31, ob = rr * 64 + cc * 2; return st * 1024 + (ob ^ (((ob >> 9) & 1) << 5)); }
__device__ __forceinline__ void stage_rc(int b, int& R, int& C) { const int st = b / 1024, sb = b % 1024, swz = sb ^ (((sb >> 9) & 1) << 5); R = (st >> 1) * 16 + swz / 64; C = (st & 1) * 32 + (swz % 64) / 2; }
__device__ __forceinline__ int perm32(int rho) { const int n = rho >> 4, i = rho & 15; return 8 * (i >> 2) + 4 * n + (i & 3); }
struct Unit { int pm, pn, e; };
struct Gemm { const bf16_t* A; int lda; const int* rowmap; const bf16_t* Bt; int ldb; size_t strideB; int K; int asplit = 1 << 30, aoff = 0; };
struct Sched {
    int nM, nN, nwg, G, c; const LAS int* tile_e;
    __device__ __forceinline__ void init(int nM_, int nN_, int G_, int c_, const LAS int* tile_e_) { nM = nM_; nN = nN_; nwg = nM * nN; G = G_; c = c_; tile_e = tile_e_; }
    __device__ __forceinline__ bool next(int i, Unit& u) const {
        const int L = i * G + c; if (L >= nwg) return false;
        int wgid = L; { const int q = nwg / NXCD, r = nwg % NXCD, xcd = wgid % NXCD, off = wgid / NXCD; wgid = (xcd < r ? xcd * (q + 1) : r * (q + 1) + (xcd - r) * q) + off; }
        const int nig = WGM * nN, gid = wgid / nig, fm = gid * WGM, gsz = (nM - fm) < WGM ? (nM - fm) : WGM;
        u.pm = fm + ((wgid % nig) % gsz); u.pn = (wgid % nig) / gsz; u.e = 0;
        if (tile_e) u.e = __builtin_amdgcn_readfirstlane(tile_e[u.pm]);
        return true;
    }
};
__device__ __forceinline__ unsigned cvt_pk_bf16(float lo, float hi) { unsigned r; asm volatile("v_cvt_pk_bf16_f32 %0, %1, %2" : "=v"(r) : "v"(lo), "v"(hi)); return r; }
__device__ __forceinline__ u32x4 pack8(const f32x4 a, const f32x4 b) { u32x4 w; w.x = cvt_pk_bf16(a[0], a[1]); w.y = cvt_pk_bf16(a[2], a[3]); w.z = cvt_pk_bf16(b[0], b[1]); w.w = cvt_pk_bf16(b[2], b[3]); return w; }
typedef float f32x2 __attribute__((ext_vector_type(2)));
typedef unsigned u32x2 __attribute__((ext_vector_type(2)));
__device__ __forceinline__ f32x2 gelu_pk(f32x2 v) {
    const f32x2 av = __builtin_elementwise_abs(v), d = av * 0.2316418882f + 1.0f;
    f32x2 t; t.x = __builtin_amdgcn_rcpf(d.x); t.y = __builtin_amdgcn_rcpf(d.y);
    f32x2 q = t * 0.5307027145f + (-0.7265760135f); q = q * t + 0.7107068705f; q = q * t + (-0.142248368f); q = q * t + 0.127414796f; q = q * t;
    const f32x2 s = (v * v) * (-0.72134752044f);
    f32x2 e; e.x = __builtin_amdgcn_exp2f(s.x); e.y = __builtin_amdgcn_exp2f(s.y);
    const f32x2 m = v * (q * e), r = v - m;
    f32x2 o; o.x = v.x < 0.f ? m.x : r.x; o.y = v.y < 0.f ? m.y : r.y; return o;
}
__device__ __forceinline__ f32x4 gelu4(const f32x4 v) { const f32x2 a = gelu_pk((f32x2){v[0], v[1]}), b = gelu_pk((f32x2){v[2], v[3]}); return (f32x4){a.x, a.y, b.x, b.y}; }
__device__ __forceinline__ float fsig(float x) { return __builtin_amdgcn_rcpf(1.0f + __builtin_amdgcn_exp2f(-1.4426950408889634f * x)); }

#define EPI_ROWS for (int ai = 0; ai < 2; ++ai) _Pragma("unroll") for (int m = 0; m < 4; ++m)

struct EpiE1 {
    static constexpr bool LDS_BIAS = false;
    bf16_t *BG, *CX, *GZU, *GZV;
    __device__ __forceinline__ void operator()(const f32x4 (&acc)[2][2][4][2], const Unit& u, int wr, int wc, int fr, int fq) const {
        const int row0 = u.pm * BM + wr * 64 + fr, cl = wc * 32 + 8 * fq, t = u.pn;
        if (t < 2) {
#pragma unroll
            EPI_ROWS { bf16_t* rp = BG + (size_t)(row0 + ai * HALF + m * 16) * 512 + t * 256 + cl;
#pragma unroll
                for (int bj = 0; bj < 2; ++bj) *(u32x4*)(rp + bj * HALF) = pack8(acc[ai][bj][m][0], acc[ai][bj][m][1]); }
        } else if (t < 6) {
#pragma unroll
            EPI_ROWS { bf16_t* rp = CX + (size_t)(row0 + ai * HALF + m * 16) * 512 + (t - 2) * 128 + cl;
                *(u32x4*)rp = pack8(acc[ai][0][m][0] * acc[ai][1][m][0], acc[ai][0][m][1] * acc[ai][1][m][1]); }
        } else {
            bf16_t* O = t < 8 ? GZU : GZV; const int tc = (t & 1) * 256 + cl;
#pragma unroll
            EPI_ROWS { bf16_t* rp = O + (size_t)(row0 + ai * HALF + m * 16) * 512 + tc;
#pragma unroll
                for (int bj = 0; bj < 2; ++bj) *(u32x4*)(rp + bj * HALF) = pack8(gelu4(acc[ai][bj][m][0]), gelu4(acc[ai][bj][m][1])); }
        }
    }
};
struct EpiO1 {
    static constexpr bool LDS_BIAS = false;
    bf16_t *GLU, *CQKV, *KRR;
    __device__ __forceinline__ void operator()(const f32x4 (&acc)[2][2][4][2], const Unit& u, int wr, int wc, int fr, int fq) const {
        const int row0 = u.pm * BM + wr * 64 + fr, cl = wc * 32 + 8 * fq, t = u.pn;
        if (t < 4) {
#pragma unroll
            EPI_ROWS { bf16_t* rp = GLU + (size_t)(row0 + ai * HALF + m * 16) * 512 + t * 128 + cl; f32x4 o[2];
#pragma unroll
                for (int n = 0; n < 2; ++n) {
                    const f32x4 ga = acc[ai][0][m][n], tb = acc[ai][1][m][n] * (-1.4426950408889634f);
                    f32x4 e; e[0] = __builtin_amdgcn_exp2f(tb[0]); e[1] = __builtin_amdgcn_exp2f(tb[1]); e[2] = __builtin_amdgcn_exp2f(tb[2]); e[3] = __builtin_amdgcn_exp2f(tb[3]);
                    const f32x4 d = e + 1.0f;
                    f32x4 r; r[0] = __builtin_amdgcn_rcpf(d[0]); r[1] = __builtin_amdgcn_rcpf(d[1]); r[2] = __builtin_amdgcn_rcpf(d[2]); r[3] = __builtin_amdgcn_rcpf(d[3]);
                    o[n] = ga * r; }
                *(u32x4*)rp = pack8(o[0], o[1]); }
        } else if (t == 4) {
#pragma unroll
            EPI_ROWS { bf16_t* rp = CQKV + (size_t)(row0 + ai * HALF + m * 16) * 384 + cl;
#pragma unroll
                for (int bj = 0; bj < 2; ++bj) *(u32x4*)(rp + bj * HALF) = pack8(acc[ai][bj][m][0], acc[ai][bj][m][1]); }
        } else {
#pragma unroll
            EPI_ROWS { const size_t r = (size_t)(row0 + ai * HALF + m * 16);
                *(u32x4*)(CQKV + r * 384 + 256 + cl) = pack8(acc[ai][0][m][0], acc[ai][0][m][1]);
                if (wc == 0) *(u32x4*)(KRR + r * 32 + 8 * fq) = pack8(acc[ai][1][m][0], acc[ai][1][m][1]); }
        }
    }
};
struct EpiO3 {
    static constexpr bool LDS_BIAS = false;
    bf16_t *Q, *KN, *VV; const float* CS;
    __device__ __forceinline__ void operator()(const f32x4 (&acc)[2][2][4][2], const Unit& u, int wr, int wc, int fr, int fq) const {
        const int row0 = u.pm * BM + wr * 64 + fr, cl = wc * 32 + 8 * fq, t = u.pn;
        if (t < 3) {
#pragma unroll
            for (int bj = 0; bj < 2; ++bj) { const int c0 = t * 256 + bj * HALF + cl, h = c0 / 96, d0 = c0 - 96 * h;
                if (d0 < 64) {
#pragma unroll
                    EPI_ROWS *(u32x4*)(Q + (size_t)(row0 + ai * HALF + m * 16) * 768 + c0) = pack8(acc[ai][bj][m][0] * QSCALE, acc[ai][bj][m][1] * QSCALE);
                } else { const int i0 = (d0 - 64) >> 1;
#pragma unroll
                    EPI_ROWS { const size_t r = (size_t)(row0 + ai * HALF + m * 16); const f32x4 cs = *(const f32x4*)(CS + r * 32 + i0), sn = *(const f32x4*)(CS + r * 32 + 16 + i0);
                        const f32x4 a = acc[ai][bj][m][0], b = acc[ai][bj][m][1]; f32x4 o0, o1;
                        o0[0] = (a[0] * cs[0] - a[1] * sn[0]) * QSCALE; o0[1] = (a[1] * cs[0] + a[0] * sn[0]) * QSCALE; o0[2] = (a[2] * cs[1] - a[3] * sn[1]) * QSCALE; o0[3] = (a[3] * cs[1] + a[2] * sn[1]) * QSCALE;
                        o1[0] = (b[0] * cs[2] - b[1] * sn[2]) * QSCALE; o1[1] = (b[1] * cs[2] + b[0] * sn[2]) * QSCALE; o1[2] = (b[2] * cs[3] - b[3] * sn[3]) * QSCALE; o1[3] = (b[3] * cs[3] + b[2] * sn[3]) * QSCALE;
                        *(u32x4*)(Q + r * 768 + c0) = pack8(o0, o1); }
                } }
        } else {
            bf16_t* O = t < 5 ? KN : VV; const int tc = ((t - 3) & 1) * 256 + cl;
#pragma unroll
            EPI_ROWS { bf16_t* rp = O + (size_t)(row0 + ai * HALF + m * 16) * 512 + tc;
#pragma unroll
                for (int bj = 0; bj < 2; ++bj) *(u32x4*)(rp + bj * HALF) = pack8(acc[ai][bj][m][0], acc[ai][bj][m][1]); }
        }
    }
};
template <bool XF32> struct EpiOut {
    static constexpr bool LDS_BIAS = false;
    const void* xres; const float* gate; bf16_t* V;
    __device__ __forceinline__ void operator()(const f32x4 (&acc)[2][2][4][2], const Unit& u, int wr, int wc, int fr, int fq) const {
        const int row0 = u.pm * BM + wr * 64 + fr, b = (u.pm * BM) / SEQ;
        f32x4 g[2][2];
#pragma unroll
        for (int bj = 0; bj < 2; ++bj)
#pragma unroll
            for (int n = 0; n < 2; ++n) g[bj][n] = *(const f32x4*)(gate + (size_t)b * 6 * DM + u.pn * BM + bj * HALF + wc * 32 + 8 * fq + 4 * n) + 1.0f;
#pragma unroll
        EPI_ROWS { const size_t off = (size_t)(row0 + ai * HALF + m * 16) * DM + u.pn * BM + wc * 32 + 8 * fq;
#pragma unroll
            for (int bj = 0; bj < 2; ++bj) {
                f32x4 x0, x1;
                if (XF32) { x0 = *(const f32x4*)((const float*)xres + off + bj * HALF); x1 = *(const f32x4*)((const float*)xres + off + bj * HALF + 4); }
                else { const u32x4 xb = *(const u32x4*)((const bf16_t*)xres + off + bj * HALF);
                    x0 = (f32x4){__uint_as_float(xb.x << 16), __uint_as_float(xb.x & 0xffff0000u), __uint_as_float(xb.y << 16), __uint_as_float(xb.y & 0xffff0000u)};
                    x1 = (f32x4){__uint_as_float(xb.z << 16), __uint_as_float(xb.z & 0xffff0000u), __uint_as_float(xb.w << 16), __uint_as_float(xb.w & 0xffff0000u)}; }
                *(u32x4*)(V + off + bj * HALF) = pack8(x0 * ALPHA + g[bj][0] * acc[ai][bj][m][0], x1 * ALPHA + g[bj][1] * acc[ai][bj][m][1]); } }
    }
};
struct EpiM1 {
    const float* bgu; unsigned char* H; LAS unsigned char* lds;
    static constexpr bool LDS_BIAS = true;
    __device__ __forceinline__ const float* bias_src(const Unit& u, int lane) const { return bgu + (size_t)u.e * 2048 + (lane >> 5) * 1024 + u.pn * 128 + (lane & 31) * 4; }
    static __device__ __forceinline__ f32x2 act2(f32x2 g, f32x2 u) {
        f32x2 gg, uu; gg.x = fminf(g.x, 7.0f); gg.y = fminf(g.y, 7.0f); uu.x = __builtin_amdgcn_fmed3f(u.x, -6.0f, 8.0f); uu.y = __builtin_amdgcn_fmed3f(u.y, -6.0f, 8.0f);
        const f32x2 t = gg * (-1.702f * 1.4426950408889634f);
        f32x2 e; e.x = __builtin_amdgcn_exp2f(t.x); e.y = __builtin_amdgcn_exp2f(t.y);
        const f32x2 d = e + 1.0f;
        f32x2 r; r.x = __builtin_amdgcn_rcpf(d.x); r.y = __builtin_amdgcn_rcpf(d.y);
        return (uu * gg) * r;
    }
    __device__ __forceinline__ void operator()(const f32x4 (&acc)[2][2][4][2], const Unit& u, int wr, int wc, int fr, int fq) const {
        const int row0 = u.pm * BM + wr * 64 + fr, col = u.pn * 128 + wc * 32 + 8 * fq;
        const LAS float* bp = (const LAS float*)(lds + BIASSLOT_OFF) + wc * 32 + 8 * fq;
        f32x4 bg[2], bu[2];
#pragma unroll
        for (int n = 0; n < 2; ++n) { bg[n] = *(const LAS f32x4*)(bp + 4 * n); bu[n] = *(const LAS f32x4*)(bp + 128 + 4 * n) + 1.0f; }
#pragma unroll
        EPI_ROWS { f32x2 o[2][2];
#pragma unroll
            for (int n = 0; n < 2; ++n) { const f32x4 gv = acc[ai][0][m][n] + bg[n], uv = acc[ai][1][m][n] + bu[n];
                o[n][0] = act2((f32x2){gv[0], gv[1]}, (f32x2){uv[0], uv[1]}); o[n][1] = act2((f32x2){gv[2], gv[3]}, (f32x2){uv[2], uv[3]}); }
            u32x2 w; w.x = pk4_fp8(o[0][0].x, o[0][0].y, o[0][1].x, o[0][1].y); w.y = pk4_fp8(o[1][0].x, o[1][0].y, o[1][1].x, o[1][1].y);
            *(u32x2*)(H + (size_t)(row0 + ai * HALF + m * 16) * DM + col) = w; }
    }
};
struct EpiM2 {
    const float* bdn; unsigned char* YS; LAS unsigned char* lds;
    static constexpr bool LDS_BIAS = true;
    __device__ __forceinline__ const float* bias_src(const Unit& u, int lane) const { return bdn + (size_t)u.e * DM + u.pn * BM + lane * 4; }
    __device__ __forceinline__ void operator()(const f32x4 (&acc)[2][2][4][2], const Unit& u, int wr, int wc, int fr, int fq) const {
        const int row0 = u.pm * BM + wr * 64 + fr, col = u.pn * BM + wc * 32 + 8 * fq;
        f32x4 bv[2][2];
#pragma unroll
        for (int bj = 0; bj < 2; ++bj)
#pragma unroll
            for (int n = 0; n < 2; ++n) bv[bj][n] = *(const LAS f32x4*)((const LAS float*)(lds + BIASSLOT_OFF) + wc * 32 + 8 * fq + bj * HALF + 4 * n);
#pragma unroll
        EPI_ROWS { unsigned char* rp = YS + (size_t)(row0 + ai * HALF + m * 16) * DM + col;
#pragma unroll
            for (int bj = 0; bj < 2; ++bj) { const f32x4 a = (acc[ai][bj][m][0] + bv[bj][0]) * 16.0f, b = (acc[ai][bj][m][1] + bv[bj][1]) * 16.0f;
                u32x2 w; w.x = pk4_fp8(a[0], a[1], a[2], a[3]); w.y = pk4_fp8(b[0], b[1], b[2], b[3]); *(u32x2*)(rp + bj * HALF) = w; } }
    }
};

template <class Epi, int F8SCALE = -1>
__device__ __forceinline__ void gemm_phase(LAS unsigned char* lds, const int wave_id, const Gemm g, const Sched& S, const Epi& E) {
    const int lane = lane_id_asm();
    const int wid = wave_id, wr = wid >> 2, wc = wid & 3, fr = lane & 15, fq = lane >> 4;
    const int K = g.K, nt = K / BK;
    const int swz = (lane * 16) ^ ((((lane * 16) >> 9) & 1) << 5);
#define PG8_STR(i) ((((wid + 8 * (i)) >> 1) * 16) + (swz >> 6))
#define PG8_STC ((wid & 1) * 32 + ((swz & 63) >> 1))
    unsigned voffB[2];
#pragma unroll
    for (int i = 0; i < 2; ++i) { const int R = PG8_STR(i), Rb = (R & ~31) + perm32(R & 31); voffB[i] = (unsigned)(Rb * g.ldb + PG8_STC) * 2u; }
    const size_t kstep = (size_t)(BK * 2);
    const size_t hstepB = (size_t)HALF * g.ldb * 2;
    const unsigned ldsw = (unsigned)wid * 1024u;
    const int aoff = lds_byte(wr * 64 + fr, fq * 8), boff = lds_byte(wc * 32 + fr, fq * 8);
    const char* const abase = (const char*)g.A;
#define PG8_SA(b, h) (((b) * 2 + (h)) * HTB)
#define PG8_SB(b, h) ((4 + (b) * 2 + (h)) * HTB)
#define PG8_STAGEB(bufoff, gbase) do { _Pragma("unroll") for (int _i = 0; _i < 2; ++_i) \
        __builtin_amdgcn_global_load_lds((const unsigned*)((const char*)(gbase) + voffB[_i]), (LAS unsigned*)(lds + (bufoff) + ldsw + _i * 8192), 16, 0, 0); } while (0)
#define PG8_STAGEA(bufoff, koff, VO, h) do { _Pragma("unroll") for (int _i = 0; _i < 2; ++_i) \
        __builtin_amdgcn_global_load_lds((const unsigned*)(abase + (size_t)(koff) + (VO)[h][_i]), (LAS unsigned*)(lds + (bufoff) + ldsw + _i * 8192), 16, 0, 0); } while (0)
#define PG8_LDA(dst, b, h) do { _Pragma("unroll") for (int m = 0; m < 4; ++m) _Pragma("unroll") for (int k = 0; k < 2; ++k) dst[m][k] = *(const LAS bf16x8*)(lds + PG8_SA(b, h) + aoff + m * 2048 + k * 1024); } while (0)
#define PG8_LDB(dst, b, h) do { _Pragma("unroll") for (int n = 0; n < 2; ++n) _Pragma("unroll") for (int k = 0; k < 2; ++k) dst[n][k] = *(const LAS bf16x8*)(lds + PG8_SB(b, h) + boff + n * 2048 + k * 1024); } while (0)
#define PG8_MMA(ai, bj, At, Bt) do { __builtin_amdgcn_s_setprio(1); \
        if constexpr (F8SCALE < 0) { _Pragma("unroll") for (int m = 0; m < 4; ++m) _Pragma("unroll") for (int n = 0; n < 2; ++n) _Pragma("unroll") for (int k = 0; k < 2; ++k) \
            acc[ai][bj][m][n] = __builtin_amdgcn_mfma_f32_16x16x32_bf16(Bt[n][k], At[m][k], acc[ai][bj][m][n], 0, 0, 0); } \
        else { _Pragma("unroll") for (int m = 0; m < 4; ++m) _Pragma("unroll") for (int n = 0; n < 2; ++n) { \
            const v8i_t _b8 = __builtin_shufflevector(__builtin_bit_cast(u32x4i, Bt[n][0]), __builtin_bit_cast(u32x4i, Bt[n][1]), 0, 1, 2, 3, 4, 5, 6, 7); \
            const v8i_t _a8 = __builtin_shufflevector(__builtin_bit_cast(u32x4i, At[m][0]), __builtin_bit_cast(u32x4i, At[m][1]), 0, 1, 2, 3, 4, 5, 6, 7); \
            acc[ai][bj][m][n] = __builtin_amdgcn_mfma_scale_f32_16x16x128_f8f6f4(_b8, _a8, acc[ai][bj][m][n], 0, 0, 0, f8_sb, 0, f8_sa); } \
            _Pragma("unroll") for (int m = 0; m < 4; ++m) _Pragma("unroll") for (int n = 0; n < 2; ++n) asm volatile("" : "+v"(acc[ai][bj][m][n])); }     \
        __builtin_amdgcn_s_setprio(0); } while (0)
#define PG8_WAIT_V(n) asm volatile("s_waitcnt vmcnt(" #n ")" ::: "memory")
#define PG8_WAIT_L(n) asm volatile("s_waitcnt lgkmcnt(" #n ")" ::: "memory")
#define PG8_BAR __builtin_amdgcn_s_barrier()
#define PG8_SCHED __builtin_amdgcn_sched_barrier(0)
#define PG8_LOADROWS(U, RW) do { _Pragma("unroll") for (int _h = 0; _h < 2; ++_h) _Pragma("unroll") for (int _i = 0; _i < 2; ++_i) { const int _row = (U).pm * BM + _h * HALF + PG8_STR(_i); \
        (RW)[_h][_i] = g.rowmap ? ((const __attribute__((address_space(1))) int*)g.rowmap)[_row] : _row; } } while (0)
#define PG8_ROWS2OFF(U, RW, VO) do { const int _ao = (U).pn >= g.asplit ? g.aoff : 0; _Pragma("unroll") for (int _h = 0; _h < 2; ++_h) _Pragma("unroll") for (int _i = 0; _i < 2; ++_i) (VO)[_h][_i] = (unsigned)((RW)[_h][_i] * g.lda + _ao + PG8_STC) * 2u; } while (0)
#define PG8_CALCA(U, VO) do { int _rw[2][2]; PG8_LOADROWS(U, _rw); PG8_ROWS2OFF(U, _rw, VO); } while (0)
    int f8_sb = (F8SCALE) * 0x01010101, f8_sa = 0x7f7f7f7f; asm volatile("" : "+v"(f8_sb), "+v"(f8_sa));
    Unit cur, nxt; int ui = 0;
    if (!S.next(0, cur)) return;
    f32x4 acc[2][2][4][2];
#pragma unroll
    for (int a = 0; a < 2; ++a)
#pragma unroll
        for (int b = 0; b < 2; ++b)
#pragma unroll
            for (int m = 0; m < 4; ++m)
#pragma unroll
                for (int n = 0; n < 2; ++n) acc[a][b][m][n] = (f32x4){0.f, 0.f, 0.f, 0.f};
    bf16x8 At[4][2], B0[2][2], B1[2][2];
    unsigned voC[2][2];
    PG8_CALCA(cur, voC);
    const char* cB = (const char*)g.Bt + ((size_t)cur.e * g.strideB + (size_t)cur.pn * BM * g.ldb) * 2;
    PG8_STAGEB(PG8_SB(0, 0), cB); PG8_STAGEB(PG8_SB(0, 1), cB + hstepB); PG8_STAGEA(PG8_SA(0, 0), 0, voC, 0); PG8_STAGEA(PG8_SA(0, 1), 0, voC, 1);
    if (wr == 1) PG8_BAR;
    PG8_WAIT_V(2); PG8_BAR;
    PG8_STAGEB(PG8_SB(1, 0), cB + kstep); PG8_STAGEA(PG8_SA(1, 0), kstep, voC, 0); PG8_STAGEB(PG8_SB(1, 1), cB + hstepB + kstep);
    PG8_WAIT_V(6); PG8_BAR;
    for (;;) {
        const bool has_next = S.next(ui + 1, nxt);
        const char* nB = has_next ? (const char*)g.Bt + ((size_t)nxt.e * g.strideB + (size_t)nxt.pn * BM * g.ldb) * 2 : cB;
        int rwN[2][2];
#pragma unroll 1
        for (int t = 0; t < nt; t += 2) {
            const bool last = (t == nt - 2);
            const size_t k1 = (size_t)(t + 1) * kstep;
            const size_t k2 = last ? 0 : (size_t)(t + 2) * kstep, k3 = k2 + kstep;
            const char* b2 = last ? nB : cB + (size_t)(t + 2) * kstep; const char* b3 = b2 + kstep;
            if constexpr (Epi::LDS_BIAS) { if (t == 2 && wid == 0) { const int ln = lane_id_asm(); __builtin_amdgcn_global_load_lds((const unsigned*)E.bias_src(cur, ln), (LAS unsigned*)(lds + BIASSLOT_OFF), 16, 0, 0); } }
            if (t == nt - 4 && has_next) {
                if (g.rowmap) { if (wid == 0) __builtin_amdgcn_global_load_lds((const unsigned*)(g.rowmap + (size_t)nxt.pm * BM + lane * 4), (LAS unsigned*)(lds + ROWSLOT_OFF), 16, 0, 0); }
                else PG8_LOADROWS(nxt, rwN);
            }
            PG8_LDB(B0, 0, 0); PG8_LDB(B1, 0, 1); PG8_SCHED; PG8_LDA(At, 0, 0); PG8_STAGEA(PG8_SA(1, 1), k1, voC, 1);
            PG8_WAIT_V(8); PG8_WAIT_L(0); PG8_BAR; PG8_MMA(0, 0, At, B0); PG8_MMA(0, 1, At, B1); PG8_BAR; PG8_SCHED;
            if (last && has_next) {
                if (g.rowmap) {
#pragma unroll
                    for (int h = 0; h < 2; ++h)
#pragma unroll
                        for (int i = 0; i < 2; ++i) rwN[h][i] = *(const LAS int*)(lds + ROWSLOT_OFF + 4 * (h * HALF + PG8_STR(i)));
                }
                PG8_ROWS2OFF(nxt, rwN, voC);
            }
            PG8_LDA(At, 0, 1); PG8_STAGEB(PG8_SB(0, 0), b2); PG8_STAGEB(PG8_SB(0, 1), b2 + hstepB); PG8_STAGEA(PG8_SA(0, 0), k2, voC, 0);
            PG8_WAIT_V(8); PG8_WAIT_L(0); PG8_BAR; PG8_MMA(1, 0, At, B0); PG8_MMA(1, 1, At, B1); PG8_BAR; PG8_SCHED;
            PG8_LDB(B0, 1, 0); PG8_LDB(B1, 1, 1); PG8_SCHED; PG8_LDA(At, 1, 0); PG8_STAGEA(PG8_SA(0, 1), k2, voC, 1);
            PG8_WAIT_V(8); PG8_WAIT_L(0); PG8_BAR; PG8_MMA(0, 0, At, B0); PG8_MMA(0, 1, At, B1); PG8_BAR; PG8_SCHED;
            PG8_LDA(At, 1, 1); PG8_STAGEB(PG8_SB(1, 0), b3); PG8_STAGEB(PG8_SB(1, 1), b3 + hstepB); PG8_STAGEA(PG8_SA(1, 0), k3, voC, 0);
            PG8_WAIT_V(8); PG8_WAIT_L(0); PG8_BAR; PG8_MMA(1, 0, At, B0); PG8_MMA(1, 1, At, B1); PG8_BAR; PG8_SCHED;
        }
        if (wr == 0) PG8_BAR;
        E(acc, cur, wr, wc, fr, fq);
        if (!has_next) break;
#pragma unroll
        for (int a = 0; a < 2; ++a)
#pragma unroll
            for (int b = 0; b < 2; ++b)
#pragma unroll
                for (int m = 0; m < 4; ++m)
#pragma unroll
                    for (int n = 0; n < 2; ++n) acc[a][b][m][n] = (f32x4){0.f, 0.f, 0.f, 0.f};
        cur = nxt; cB = nB; ++ui;
        if (wr == 1) PG8_BAR;
    }
    PG8_WAIT_V(0);
    PG8_BAR;
#undef PG8_SA
#undef PG8_SB
#undef PG8_STAGEA
#undef PG8_STAGEB
#undef PG8_LDA
#undef PG8_LDB
#undef PG8_MMA
#undef PG8_WAIT_V
#undef PG8_WAIT_L
#undef PG8_BAR
#undef PG8_SCHED
#undef PG8_CALCA
#undef PG8_LOADROWS
#undef PG8_ROWS2OFF
#undef PG8_STR
#undef PG8_STC
}
}


typedef float f32x16 __attribute__((ext_vector_type(16)));
__device__ __forceinline__ float max3f_(float a, float b, float c) { float r; asm("v_max3_f32 %0, %1, %2, %3" : "=v"(r) : "v"(a), "v"(b), "v"(c)); return r; }
__device__ __forceinline__ float max2f_(float a, float b) { float r; asm("v_max_f32_e32 %0, %1, %2" : "=v"(r) : "v"(a), "v"(b)); return r; }
typedef short v4i16_t __attribute__((ext_vector_type(4)));
using pg8::u32x2;
constexpr int AT_KROW = 208, AT_KBYTES = 64 * AT_KROW, AT_VBYTES = 8192, AT_BUF = AT_KBYTES + AT_VBYTES;
__device__ __forceinline__ void attn_phase(LAS unsigned char* lds, const int wave, const int lane, const int bx, const int G,
                                           const bf16_t* __restrict__ Q, const bf16_t* __restrict__ KN, const bf16_t* __restrict__ KR, const bf16_t* __restrict__ VV, bf16_t* __restrict__ Y) {
    const int hi = lane >> 5, r32 = lane & 31, tid = wave * 64 + lane;
    const int g1 = (lane >> 4) & 1, i16 = lane & 15, tq = i16 >> 2, tp = i16 & 3;
    const int vlane_off = (4 * hi + tq) * 64 + (16 * g1 + 4 * tp) * 2;
    const int vbx = (G % 8 == 0) ? (bx % 8) * (G / 8) + bx / 8 : bx;
    for (int pidx = vbx; pidx < 512; pidx += G) {
#pragma unroll 1
        for (int jj = 0; jj < 2; ++jj) {
            const int bh = pidx >> 3, x = pidx & 7, qb = jj ? 15 - x : x, b = bh >> 3, h = bh & 7;
            const size_t tb = (size_t)b * SEQ;
            const int q0 = qb * 256 + wave * 32;
            const bf16_t* kn = KN + tb * 512 + h * 64; const bf16_t* kr = KR + tb * 32; const bf16_t* vv = VV + tb * 512 + h * 64;
            bf16x8 qf[6];
#pragma unroll
            for (int s = 0; s < 6; ++s) qf[s] = *(const bf16x8*)(Q + (tb + q0 + r32) * 768 + h * 96 + 16 * s + 8 * hi);
            f32x16 o0, o1;
#pragma unroll
            for (int r = 0; r < 16; ++r) { o0[r] = 0.f; o1[r] = 0.f; }
            float mrow = 0.f, lsum = 0.f;
            const int nt = 4 * (qb + 1);
            u32x4 pfa[3], pfb[3];
            bf16x8 pb[2][2];
            const unsigned offKV = (unsigned)((tid >> 3) * 512 + (tid & 7) * 8) * 2u, offKR = (unsigned)((tid >> 2) * 32 + (tid & 3) * 8) * 2u;
            const unsigned ldsK = (unsigned)((tid >> 3) * AT_KROW + (tid & 7) * 16), ldsR = (unsigned)((tid >> 2) * AT_KROW + 128 + (tid & 3) * 16), ldsV = (unsigned)(((tid & 7) >> 2) * 4096 + (tid >> 3) * 64 + (tid & 3) * 16);
            typedef const __attribute__((address_space(1))) unsigned char* gcp_t; typedef const __attribute__((address_space(1))) u32x4* gv4_t;
#define AT_LOAD(kt, pf) do { const size_t _k0 = (size_t)(kt) * 64; \
                pf[0] = *(gv4_t)((gcp_t)(kn + _k0 * 512) + offKV); pf[1] = *(gv4_t)((gcp_t)(vv + _k0 * 512) + offKV); \
                if (tid < 256) pf[2] = *(gv4_t)((gcp_t)(kr + _k0 * 32) + offKR); } while (0)
#define AT_STORE(par, pf) do { LAS unsigned char* _kb = lds + (par) * AT_KBYTES; LAS unsigned char* _vb = lds + 2 * AT_KBYTES + (par) * AT_VBYTES; \
                *(LAS u32x4*)(_kb + ldsK) = pf[0]; *(LAS u32x4*)(_vb + ldsV) = pf[1]; if (tid < 256) *(LAS u32x4*)(_kb + ldsR) = pf[2]; } while (0)
#define AT_PV(vbuf) do { LAS unsigned char* vlane = lds + 2 * AT_KBYTES + (vbuf) * AT_VBYTES + vlane_off; \
                bf16x8 vf[2][2][2]; \
                _Pragma("unroll") for (int kb2 = 0; kb2 < 2; ++kb2) _Pragma("unroll") for (int s2 = 0; s2 < 2; ++s2) _Pragma("unroll") for (int db = 0; db < 2; ++db) { \
                    LAS unsigned char* va = vlane + db * 4096 + (32 * kb2 + 16 * s2) * 64; \
                    const v4i16_t lo = __builtin_amdgcn_ds_read_tr16_b64_v4i16((LAS v4i16_t*)va); \
                    const v4i16_t hh = __builtin_amdgcn_ds_read_tr16_b64_v4i16((LAS v4i16_t*)(va + 8 * 64)); \
                    vf[kb2][s2][db] = (bf16x8){lo[0], lo[1], lo[2], lo[3], hh[0], hh[1], hh[2], hh[3]}; } \
                __builtin_amdgcn_sched_barrier(0); \
                _Pragma("unroll") for (int kb2 = 0; kb2 < 2; ++kb2) _Pragma("unroll") for (int s2 = 0; s2 < 2; ++s2) { \
                    o0 = __builtin_amdgcn_mfma_f32_32x32x16_bf16(vf[kb2][s2][0], pb[kb2][s2], o0, 0, 0, 0); \
                    o1 = __builtin_amdgcn_mfma_f32_32x32x16_bf16(vf[kb2][s2][1], pb[kb2][s2], o1, 0, 0, 0); } } while (0)
#define AT_ITER(KT, PAR, PFL, PFS) do { const int kt = (KT); \
                if (kt + 2 < nt) AT_LOAD(kt + 2, PFL); \
                const int kbase = kt * 64; \
                if (kbase <= q0 + 31) { \
                    LAS unsigned char* kb = lds + (PAR) * AT_KBYTES; \
                    f32x16 p0, p1; \
                _Pragma("unroll") \
                    for (int r = 0; r < 16; ++r) { p0[r] = -mrow; p1[r] = -mrow; } \
                _Pragma("unroll") \
                    for (int s = 0; s < 6; ++s) { \
                        const bf16x8 k0 = *(const LAS bf16x8*)(kb + r32 * AT_KROW + (16 * s + 8 * hi) * 2); \
                        const bf16x8 k1 = *(const LAS bf16x8*)(kb + (32 + r32) * AT_KROW + (16 * s + 8 * hi) * 2); \
                        p0 = __builtin_amdgcn_mfma_f32_32x32x16_bf16(k0, qf[s], p0, 0, 0, 0); \
                        p1 = __builtin_amdgcn_mfma_f32_32x32x16_bf16(k1, qf[s], p1, 0, 0, 0); \
                    } \
                    if (kbase + 63 > q0) { \
                        const int qrel = q0 + r32 - kbase - 4 * hi; \
                _Pragma("unroll") \
                        for (int r = 0; r < 16; ++r) { if ((r & 3) + 8 * (r >> 2) > qrel) p0[r] = -INFINITY; if ((r & 3) + 8 * (r >> 2) + 32 > qrel) p1[r] = -INFINITY; } \
                    } \
                    float mxa = max3f_(p0[0], p0[1], p1[0]), mxb = max3f_(p0[2], p0[3], p1[1]); mxa = max3f_(mxa, p1[2], p1[3]); \
                _Pragma("unroll") \
                    for (int r = 4; r < 16; r += 4) { mxa = max3f_(mxa, p0[r], p0[r + 1]); mxb = max3f_(mxb, p0[r + 2], p0[r + 3]); mxa = max3f_(mxa, p1[r], p1[r + 1]); mxb = max3f_(mxb, p1[r + 2], p1[r + 3]); } \
                    float mx = max2f_(mxa, mxb); \
                    mx = max2f_(mx, shfl_xor_l(mx, 32, lane)); \
                    if (__builtin_amdgcn_ballot_w64(mx > 0.f) != 0ull) { \
                        const float d = max2f_(mx, 0.f), sc = __builtin_amdgcn_exp2f(-d); \
                        lsum *= sc; \
                _Pragma("unroll") \
                        for (int r = 0; r < 16; ++r) { o0[r] *= sc; o1[r] *= sc; p0[r] -= d; p1[r] -= d; } \
                        mrow += d; \
                    } \
                    float ps = 0.f; \
                _Pragma("unroll") \
                    for (int r = 0; r < 16; ++r) { p0[r] = __builtin_amdgcn_exp2f(p0[r]); p1[r] = __builtin_amdgcn_exp2f(p1[r]); ps += p0[r] + p1[r]; } \
                    lsum += ps; \
                _Pragma("unroll") \
                    for (int s2 = 0; s2 < 2; ++s2) { \
                        u32x4 w0, w1; \
                        w0.x = pg8::cvt_pk_bf16(p0[8 * s2 + 0], p0[8 * s2 + 1]); w0.y = pg8::cvt_pk_bf16(p0[8 * s2 + 2], p0[8 * s2 + 3]); w0.z = pg8::cvt_pk_bf16(p0[8 * s2 + 4], p0[8 * s2 + 5]); w0.w = pg8::cvt_pk_bf16(p0[8 * s2 + 6], p0[8 * s2 + 7]); \
                        w1.x = pg8::cvt_pk_bf16(p1[8 * s2 + 0], p1[8 * s2 + 1]); w1.y = pg8::cvt_pk_bf16(p1[8 * s2 + 2], p1[8 * s2 + 3]); w1.z = pg8::cvt_pk_bf16(p1[8 * s2 + 4], p1[8 * s2 + 5]); w1.w = pg8::cvt_pk_bf16(p1[8 * s2 + 6], p1[8 * s2 + 7]); \
                        pb[0][s2] = __builtin_bit_cast(bf16x8, w0); pb[1][s2] = __builtin_bit_cast(bf16x8, w1); \
                    } \
                    AT_PV(PAR); \
                } \
                if (kt + 1 < nt) AT_STORE(1 - (PAR), PFS); \
                asm volatile("s_waitcnt lgkmcnt(0)\n\ts_barrier" ::: "memory");     \
            } while (0)
            AT_LOAD(0, pfa);
            AT_STORE(0, pfa);
            AT_LOAD(1, pfb);
            __syncthreads();
            for (int kt2 = 0; kt2 < nt; kt2 += 2) { AT_ITER(kt2, 0, pfa, pfb); AT_ITER(kt2 + 1, 1, pfb, pfa); }
#undef AT_ITER
            __syncthreads();
#undef AT_LOAD
#undef AT_STORE
#undef AT_PV
            const float inv = 1.0f / (lsum + shfl_xor_l(lsum, 32, lane));
            bf16_t* yrow = Y + (tb + q0 + r32) * DM + 512 + h * 64 + 4 * hi;
#pragma unroll
            for (int g4 = 0; g4 < 4; ++g4) {
                u32x2 w; w.x = pg8::cvt_pk_bf16(o0[4 * g4] * inv, o0[4 * g4 + 1] * inv); w.y = pg8::cvt_pk_bf16(o0[4 * g4 + 2] * inv, o0[4 * g4 + 3] * inv);
                *(u32x2*)(yrow + 8 * g4) = w;
                u32x2 w2; w2.x = pg8::cvt_pk_bf16(o1[4 * g4] * inv, o1[4 * g4 + 1] * inv); w2.y = pg8::cvt_pk_bf16(o1[4 * g4 + 2] * inv, o1[4 * g4 + 3] * inv);
                *(u32x2*)(yrow + 32 + 8 * g4) = w2;
            }
        }
    }
}

__device__ __forceinline__ void even_mix_phase(LAS unsigned char* lds, const int wave, const int lane, const int bx, const int G,
                                               const bf16_t* __restrict__ BG, const bf16_t* __restrict__ CX, const bf16_t* __restrict__ GZU, const bf16_t* __restrict__ GZV, const bf16_t* __restrict__ SGW,
                                               const float* __restrict__ conv_w, const float* __restrict__ sg_b, const float* __restrict__ vn_g, const float* __restrict__ vn_b, bf16_t* __restrict__ Y) {
    const int hi = lane >> 5, r32 = lane & 31;
    for (int chunk = bx; chunk < NT / 128; chunk += G) {
        const int tok0 = chunk * 128, t0 = tok0 % SEQ;
        {
            float gch[8], bch[8], w0[8], w1[8], w2[8];
#pragma unroll
            for (int c = 0; c < 8; ++c) { gch[c] = vn_g[lane * 8 + c]; bch[c] = vn_b[lane * 8 + c]; w0[c] = conv_w[lane * 8 + c]; w1[c] = conv_w[512 + lane * 8 + c]; w2[c] = conv_w[1024 + lane * 8 + c]; }
            float p1[8], p2[8];
            { const int j0 = wave * 16; const int tq = t0 + j0;
              const u32x4 a1 = tq >= 1 ? *(const u32x4*)(CX + (size_t)(tok0 + j0 - 1) * 512 + lane * 8) : (u32x4){0u, 0u, 0u, 0u};
              const u32x4 a2 = tq >= 2 ? *(const u32x4*)(CX + (size_t)(tok0 + j0 - 2) * 512 + lane * 8) : (u32x4){0u, 0u, 0u, 0u};
#pragma unroll
              for (int c = 0; c < 8; ++c) { p1[c] = __uint_as_float((c & 1) ? (a1[c >> 1] & 0xffff0000u) : (a1[c >> 1] << 16)); p2[c] = __uint_as_float((c & 1) ? (a2[c >> 1] & 0xffff0000u) : (a2[c >> 1] << 16)); } }
            u32x4 zvn[4], cxn[4], bgn[4];
#pragma unroll
            for (int r4 = 0; r4 < 4; ++r4) { const size_t rowoff = (size_t)(tok0 + wave * 16 + r4) * 512 + lane * 8; zvn[r4] = *(const u32x4*)(GZV + rowoff); cxn[r4] = *(const u32x4*)(CX + rowoff); bgn[r4] = *(const u32x4*)(BG + rowoff); }
#pragma unroll
            for (int jb = 0; jb < 16; jb += 4) {
                u32x4 zv4[4], cx4[4], bg4[4];
#pragma unroll
                for (int r4 = 0; r4 < 4; ++r4) { zv4[r4] = zvn[r4]; cx4[r4] = cxn[r4]; bg4[r4] = bgn[r4]; }
                if (jb + 4 < 16) {
#pragma unroll
                    for (int r4 = 0; r4 < 4; ++r4) { const size_t rowoff = (size_t)(tok0 + wave * 16 + jb + 4 + r4) * 512 + lane * 8; zvn[r4] = *(const u32x4*)(GZV + rowoff); cxn[r4] = *(const u32x4*)(CX + rowoff); bgn[r4] = *(const u32x4*)(BG + rowoff); }
                }
#pragma unroll
                for (int r4 = 0; r4 < 4; ++r4) {
                const int j = wave * 16 + jb + r4;
                const u32x4 zv = zv4[r4], cxv = cx4[r4], bgv = bg4[r4];
                float v[8]; float s = 0.f;
#pragma unroll
                for (int c = 0; c < 8; ++c) { v[c] = __uint_as_float((c & 1) ? (zv[c >> 1] & 0xffff0000u) : (zv[c >> 1] << 16)); s += v[c]; }
                const float mean = wave_sum_l(s, lane) * (1.f / 512.f); float q = 0.f;
#pragma unroll
                for (int c = 0; c < 8; ++c) { v[c] -= mean; q += v[c] * v[c]; }
                const float rstd = rsqrtf(wave_sum_l(q, lane) * (1.f / 512.f) + LN_EPS);
                float z[8];
#pragma unroll
                for (int c = 0; c < 8; ++c) z[c] = v[c] * rstd * gch[c] + bch[c];
                *(LAS u32x4*)(lds + (lane >> 2) * 8192 + j * 64 + (lane & 3) * 16) = pg8::pack8((f32x4){z[0], z[1], z[2], z[3]}, (f32x4){z[4], z[5], z[6], z[7]});
                float ya[8];
#pragma unroll
                for (int c = 0; c < 8; ++c) { const float cxc = __uint_as_float((c & 1) ? (cxv[c >> 1] & 0xffff0000u) : (cxv[c >> 1] << 16)), bgc = __uint_as_float((c & 1) ? (bgv[c >> 1] & 0xffff0000u) : (bgv[c >> 1] << 16));
                    ya[c] = bgc * (w0[c] * p2[c] + w1[c] * p1[c] + w2[c] * cxc); p2[c] = p1[c]; p1[c] = cxc; }
                *(u32x4*)(Y + (size_t)(tok0 + j) * DM + lane * 8) = pg8::pack8((f32x4){ya[0], ya[1], ya[2], ya[3]}, (f32x4){ya[4], ya[5], ya[6], ya[7]});
                }
            }
        }
        __syncthreads();
        {
            const int h = wave;
            const int g1 = (lane >> 4) & 1, i16 = lane & 15, tq = i16 >> 2, tp = i16 & 3;
            LAS unsigned char* zl = lds + (2 * h) * 8192 + (8 * hi + tq) * 64 + (16 * g1 + 4 * tp) * 2;
            const bf16_t* wh = SGW + (size_t)h * 128 * 128;
#pragma unroll 1
            for (int ib = 0; ib < 4; ++ib) {
                f32x16 a0, a1;
#pragma unroll
                for (int r = 0; r < 16; ++r) { a0[r] = 0.f; a1[r] = 0.f; }
                const bf16_t* wrow = wh + (size_t)(32 * ib + r32) * 128 + 8 * hi;
                for (int ks = 0; ks < 2 * ib + 2; ++ks) {
                    const bf16x8 bfr = *(const bf16x8*)(wrow + 16 * ks);
                    LAS unsigned char* za = zl + (16 * ks) * 64;
                    const v4i16_t l0 = __builtin_amdgcn_ds_read_tr16_b64_v4i16((LAS v4i16_t*)za), h0 = __builtin_amdgcn_ds_read_tr16_b64_v4i16((LAS v4i16_t*)(za + 4 * 64));
                    const v4i16_t l1 = __builtin_amdgcn_ds_read_tr16_b64_v4i16((LAS v4i16_t*)(za + 8192)), h1 = __builtin_amdgcn_ds_read_tr16_b64_v4i16((LAS v4i16_t*)(za + 8192 + 4 * 64));
                    a0 = __builtin_amdgcn_mfma_f32_32x32x16_bf16((bf16x8){l0[0], l0[1], l0[2], l0[3], h0[0], h0[1], h0[2], h0[3]}, bfr, a0, 0, 0, 0);
                    a1 = __builtin_amdgcn_mfma_f32_32x32x16_bf16((bf16x8){l1[0], l1[1], l1[2], l1[3], h1[0], h1[1], h1[2], h1[3]}, bfr, a1, 0, 0, 0);
                }
                const int irow = 32 * ib + r32; const float bias = sg_b[h * 128 + irow];
                const size_t trow = (size_t)(tok0 + irow);
#pragma unroll
                for (int cb = 0; cb < 2; ++cb)
#pragma unroll
                    for (int g4 = 0; g4 < 4; ++g4) {
                        const int ch = h * 64 + cb * 32 + 8 * g4 + 4 * hi;
                        const u32x2 zu = *(const u32x2*)(GZU + trow * 512 + ch);
                        float o[4];
#pragma unroll
                        for (int c = 0; c < 4; ++c) { const float acc = cb ? a1[4 * g4 + c] : a0[4 * g4 + c]; const float zuf = __uint_as_float((c & 1) ? (zu[c >> 1] & 0xffff0000u) : (zu[c >> 1] << 16)); o[c] = zuf * (acc + bias); }
                        u32x2 w; w.x = pg8::cvt_pk_bf16(o[0], o[1]); w.y = pg8::cvt_pk_bf16(o[2], o[3]);
                        *(u32x2*)(Y + trow * DM + 512 + ch) = w;
                    }
            }
        }
        __syncthreads();
    }
}

typedef __bf16 bf16x2_t __attribute__((ext_vector_type(2)));
constexpr int OM_WBYTES = 31 * 512 * 4, OM_TILE = 32, OM_ROWS = OM_TILE + 30;
__device__ __forceinline__ void odd_mix_phase(LAS unsigned char* lds, const int wave, const int lane, const int bx, const int G,
                                              const bf16_t* __restrict__ GLU, const bf16_t* __restrict__ CQKV, const bf16_t* __restrict__ KRR, const float* __restrict__ CS,
                                              const float* __restrict__ dw_w, const float* __restrict__ dw_b, const float* __restrict__ cn_g, const float* __restrict__ cn_b,
                                              const float* __restrict__ qn_g, const float* __restrict__ kvn_g, bf16_t* __restrict__ Y, bf16_t* __restrict__ CQKVN, bf16_t* __restrict__ KR) {
    const int tid = wave * 64 + lane;
    LAS unsigned char* gl = lds + OM_WBYTES;
    LAS unsigned* wpl = (LAS unsigned*)lds;
    for (int i = tid; i < 16 * 512 / 4; i += NTHR) { const int k2 = i >> 7, c4 = (i & 127) * 4; const f32x4 w0 = *(const f32x4*)(dw_w + (size_t)(2 * k2) * 512 + c4);
        const f32x4 w1 = (2 * k2 + 1 < 31) ? *(const f32x4*)(dw_w + (size_t)(2 * k2 + 1) * 512 + c4) : (f32x4){0.f, 0.f, 0.f, 0.f};
        *(LAS u32x4*)(wpl + 4 * i) = (u32x4){pg8::cvt_pk_bf16(w0[0], w1[0]), pg8::cvt_pk_bf16(w0[1], w1[1]), pg8::cvt_pk_bf16(w0[2], w1[2]), pg8::cvt_pk_bf16(w0[3], w1[3])}; }
    if (tid < 64) { unsigned z = 0u; asm volatile("" : "+v"(z)); *(LAS u32x4*)(gl + OM_ROWS * 1024 + tid * 16) = (u32x4){z, z, z, z}; }
    float bch[8], gch[8], cch[8];
#pragma unroll
    for (int c = 0; c < 8; ++c) { bch[c] = dw_b[lane * 8 + c]; gch[c] = cn_g[lane * 8 + c]; cch[c] = cn_b[lane * 8 + c]; }
    const f32x4 qg = *(const f32x4*)(qn_g + lane * 4); const float kg0 = kvn_g[lane * 2], kg1 = kvn_g[lane * 2 + 1];
    u32x4 pf[8];
#define OM_LOAD(tile_) do { const int _tok0 = (tile_) * OM_TILE, _t0 = _tok0 % SEQ; _Pragma("unroll") for (int i = 0; i < 8; ++i) { const int c = tid + NTHR * i, rr = c >> 6, cc = c & 63; \
        pf[i] = (c < OM_ROWS * 64 && _t0 - 30 + rr >= 0) ? *(const u32x4*)(GLU + (size_t)(_tok0 - 30 + rr) * 512 + cc * 8) : (u32x4){0u, 0u, 0u, 0u}; } } while (0)
    int tile = bx;
    if (tile < NT / OM_TILE) OM_LOAD(tile);
    for (; tile < NT / OM_TILE; tile += G) {
        const int tok0 = tile * OM_TILE;
        __syncthreads();
#pragma unroll
        for (int i = 0; i < 8; ++i) { const int c = tid + NTHR * i, rr = c >> 6, cc = c & 63; if (c < OM_ROWS * 64) *(LAS u32x4*)(gl + rr * 1024 + cc * 16) = pf[i]; }
        __syncthreads();
        if (tile + G < NT / OM_TILE) OM_LOAD(tile + G);
        u32x2 cqv[4]; unsigned ckv[4]; float kx1[4], kx2[4], kcs[4], ksn[4];
#pragma unroll
        for (int tt = 0; tt < 4; ++tt) { const size_t row = (size_t)(tok0 + wave * 4 + tt);
            cqv[tt] = *(const u32x2*)(CQKV + row * 384 + lane * 4); ckv[tt] = *(const unsigned*)(CQKV + row * 384 + 256 + lane * 2);
            kx1[tt] = bf2f(KRR[row * 32 + (lane & 15)]); kx2[tt] = bf2f(KRR[row * 32 + 16 + (lane & 15)]); kcs[tt] = CS[row * 32 + (lane & 15)]; ksn[tt] = CS[row * 32 + 16 + (lane & 15)]; }
        float acc[4][8];
#pragma unroll
        for (int tt = 0; tt < 4; ++tt)
#pragma unroll
            for (int c = 0; c < 8; ++c) acc[tt][c] = bch[c];
#pragma unroll 1
        for (int k2 = 0; k2 < 16; ++k2) {
            const u32x4 wa = *(const LAS u32x4*)(wpl + k2 * 512 + lane * 8), wb = *(const LAS u32x4*)(wpl + k2 * 512 + lane * 8 + 4);
            u32x4 gr[5];
#pragma unroll
            for (int j = 0; j < 5; ++j) gr[j] = *(const LAS u32x4*)(gl + (wave * 4 + 2 * k2 + j) * 1024 + lane * 16);
#pragma unroll
            for (int tt = 0; tt < 4; ++tt)
#pragma unroll
                for (int i = 0; i < 4; ++i) {
                    const unsigned p0 = __builtin_amdgcn_perm(gr[tt + 1][i], gr[tt][i], 0x05040100u), p1 = __builtin_amdgcn_perm(gr[tt + 1][i], gr[tt][i], 0x07060302u);
                    const unsigned wq0 = i < 2 ? wa[2 * i] : wb[2 * i - 4], wq1 = i < 2 ? wa[2 * i + 1] : wb[2 * i - 3];
                    acc[tt][2 * i] = __builtin_amdgcn_fdot2_f32_bf16(__builtin_bit_cast(bf16x2_t, p0), __builtin_bit_cast(bf16x2_t, wq0), acc[tt][2 * i], false);
                    acc[tt][2 * i + 1] = __builtin_amdgcn_fdot2_f32_bf16(__builtin_bit_cast(bf16x2_t, p1), __builtin_bit_cast(bf16x2_t, wq1), acc[tt][2 * i + 1], false);
                }
        }
#pragma unroll
        for (int tt = 0; tt < 4; ++tt) {
            const int row = tok0 + wave * 4 + tt;
            float s = 0.f;
#pragma unroll
            for (int c = 0; c < 8; ++c) s += acc[tt][c];
            const float mean = wave_sum_l(s, lane) * (1.f / 512.f); float q = 0.f;
#pragma unroll
            for (int c = 0; c < 8; ++c) { acc[tt][c] -= mean; q += acc[tt][c] * acc[tt][c]; }
            const float rstd = rsqrtf(wave_sum_l(q, lane) * (1.f / 512.f) + LN_EPS);
            float o8[8];
#pragma unroll
            for (int c = 0; c < 8; ++c) { const float z = acc[tt][c] * rstd * gch[c] + cch[c]; o8[c] = z * pg8::fsig(z); }
            *(u32x4*)(Y + (size_t)row * DM + lane * 8) = pg8::pack8((f32x4){o8[0], o8[1], o8[2], o8[3]}, (f32x4){o8[4], o8[5], o8[6], o8[7]});
            float cq[4], ck[2]; float sq = 0.f, sk = 0.f;
#pragma unroll
            for (int c = 0; c < 4; ++c) { cq[c] = __uint_as_float((c & 1) ? (cqv[tt][c >> 1] & 0xffff0000u) : (cqv[tt][c >> 1] << 16)); sq += cq[c] * cq[c]; }
            ck[0] = __uint_as_float(ckv[tt] << 16); ck[1] = __uint_as_float(ckv[tt] & 0xffff0000u); sk = ck[0] * ck[0] + ck[1] * ck[1];
            const float rq = rsqrtf(wave_sum_l(sq, lane) * (1.f / 256.f) + RMS_EPS), rk = rsqrtf(wave_sum_l(sk, lane) * (1.f / 128.f) + RMS_EPS);
            u32x2 wq; wq.x = pg8::cvt_pk_bf16(cq[0] * rq * qg[0], cq[1] * rq * qg[1]); wq.y = pg8::cvt_pk_bf16(cq[2] * rq * qg[2], cq[3] * rq * qg[3]);
            *(u32x2*)(CQKVN + (size_t)row * 384 + lane * 4) = wq;
            *(unsigned*)(CQKVN + (size_t)row * 384 + 256 + lane * 2) = pg8::cvt_pk_bf16(ck[0] * rk * kg0, ck[1] * rk * kg1);
            if (lane < 16) *(unsigned*)(KR + (size_t)row * 32 + 2 * lane) = pg8::cvt_pk_bf16(kx1[tt] * kcs[tt] - kx2[tt] * ksn[tt], kx2[tt] * kcs[tt] + kx1[tt] * ksn[tt]);
        }
    }
#undef OM_LOAD
    __syncthreads();
}

constexpr int LR_USTRIDE = 2048 + 32;
constexpr int LR_UH = 0, LR_UL = 16 * LR_USTRIDE, LR_PART = 2 * 16 * LR_USTRIDE, LR_LOG = LR_PART + 8 * 16 * 32 * 4, LR_CNT = LR_LOG + 16 * 32 * 4 + 16 * 4 * 4, LR_REC = LR_CNT + 256, LR_END = LR_REC + 4096;
static_assert(LR_END <= MISC_OFF, "lnr LDS map");
__device__ __forceinline__ void lnr_phase(LAS unsigned char* lds, const int wave, const int lane, const int bx, const int G,
                                          const bf16_t* __restrict__ V, const float* __restrict__ lng, const float* __restrict__ lnb, const float* __restrict__ mod_l, float* __restrict__ STAT, unsigned char* __restrict__ U8,
                                          const float* __restrict__ rw, const float* __restrict__ rb, int* __restrict__ TOPE, float* __restrict__ TOPG, int* __restrict__ POS, unsigned* CNT) {
    const int tid = wave * 64 + lane, fr = lane & 15, fq = lane >> 4;
    LAS unsigned* lcnt = (LAS unsigned*)(lds + LR_CNT);
    LAS unsigned* lrec = (LAS unsigned*)(lds + LR_REC);
    LAS float* part = (LAS float*)(lds + LR_PART); LAS float* logit = (LAS float*)(lds + LR_LOG);
    bf16x8 wh[4][2], wl[4][2];
#pragma unroll
    for (int s4 = 0; s4 < 4; ++s4)
#pragma unroll
        for (int nt = 0; nt < 2; ++nt) {
            float wv[8], wr[8];
#pragma unroll
            for (int j = 0; j < 8; ++j) { wv[j] = rw[(size_t)(128 * wave + 32 * s4 + 8 * fq + j) * NEXP + 16 * nt + fr]; wr[j] = wv[j] - bf2f(f2bf(wv[j])); }
            wh[s4][nt] = __builtin_bit_cast(bf16x8, pg8::pack8((f32x4){wv[0], wv[1], wv[2], wv[3]}, (f32x4){wv[4], wv[5], wv[6], wv[7]}));
            wl[s4][nt] = __builtin_bit_cast(bf16x8, pg8::pack8((f32x4){wr[0], wr[1], wr[2], wr[3]}, (f32x4){wr[4], wr[5], wr[6], wr[7]}));
        }
    if (tid < 64) lcnt[tid] = 0u;
    __syncthreads();
    u32x2 vpre[2][4];
    if (bx < NT / 16) {
#pragma unroll
        for (int rr = 0; rr < 2; ++rr)
#pragma unroll
            for (int j = 0; j < 4; ++j) vpre[rr][j] = *(const u32x2*)(V + (size_t)(bx * 16 + 2 * wave + rr) * DM + j * 256 + lane * 4);
    }
    int li = 0;
    for (int sb = bx; sb < NT / 16; sb += G, ++li) {
        const int rbase = sb * 16, b = rbase / SEQ; const float* m = mod_l + (size_t)b * 6 * DM;
        int l4 = lane * 4; asm volatile("" : "+v"(l4));
#pragma unroll
        for (int rr = 0; rr < 2; ++rr) {
            const int r16 = 2 * wave + rr; const size_t row = (size_t)(rbase + r16);
            float v[16]; float s = 0.f;
#pragma unroll
            for (int j = 0; j < 4; ++j) { const u32x2 tb = vpre[rr][j]; const f32x4 t4 = (f32x4){__uint_as_float(tb.x << 16), __uint_as_float(tb.x & 0xffff0000u), __uint_as_float(tb.y << 16), __uint_as_float(tb.y & 0xffff0000u)};
                v[4 * j] = t4[0]; v[4 * j + 1] = t4[1]; v[4 * j + 2] = t4[2]; v[4 * j + 3] = t4[3]; s += (t4[0] + t4[1]) + (t4[2] + t4[3]); }
            const float mean = wave_sum_l(s, lane) * (1.f / DM); float q = 0.f;
#pragma unroll
            for (int i = 0; i < 16; ++i) { v[i] -= mean; q += v[i] * v[i]; }
            const float rstd = rsqrtf(wave_sum_l(q, lane) * (1.f / DM) + LN_EPS);
            if (lane == 0) *(pg8::f32x2*)(STAT + row * 2) = (pg8::f32x2){mean, rstd};
#pragma unroll
            for (int j = 0; j < 4; ++j) {
                const f32x4 g4 = *(const f32x4*)(lng + j * 256 + l4), b4 = *(const f32x4*)(lnb + j * 256 + l4), sc4 = *(const f32x4*)(m + 4 * DM + j * 256 + l4), sh4 = *(const f32x4*)(m + 3 * DM + j * 256 + l4);
                f32x4 xn, uu, ur;
#pragma unroll
                for (int c = 0; c < 4; ++c) { xn[c] = v[4 * j + c] * rstd * g4[c] + b4[c]; uu[c] = xn[c] * (1.0f + sc4[c]) + sh4[c]; }
                u32x2 ub; ub.x = pg8::cvt_pk_bf16(uu[0], uu[1]); ub.y = pg8::cvt_pk_bf16(uu[2], uu[3]);
                *(unsigned*)(U8 + row * DM + j * 256 + l4) = pk4_fp8(uu[0], uu[1], uu[2], uu[3]);
                ur[0] = uu[0] - __uint_as_float(ub.x << 16); ur[1] = uu[1] - __uint_as_float(ub.x & 0xffff0000u); ur[2] = uu[2] - __uint_as_float(ub.y << 16); ur[3] = uu[3] - __uint_as_float(ub.y & 0xffff0000u);
                u32x2 ul; ul.x = pg8::cvt_pk_bf16(ur[0], ur[1]); ul.y = pg8::cvt_pk_bf16(ur[2], ur[3]);
                *(LAS u32x2*)(lds + LR_UH + r16 * LR_USTRIDE + (j * 256 + l4) * 2) = ub;
                *(LAS u32x2*)(lds + LR_UL + r16 * LR_USTRIDE + (j * 256 + l4) * 2) = ul;
            }
        }
        if (sb + G < NT / 16) {
#pragma unroll
            for (int rr = 0; rr < 2; ++rr)
#pragma unroll
                for (int j = 0; j < 4; ++j) vpre[rr][j] = *(const u32x2*)(V + (size_t)((sb + G) * 16 + 2 * wave + rr) * DM + j * 256 + l4);
        }
        __syncthreads();
        f32x4 acc0 = (f32x4){0.f, 0.f, 0.f, 0.f}, acc1 = (f32x4){0.f, 0.f, 0.f, 0.f};
#pragma unroll
        for (int s4 = 0; s4 < 4; ++s4) {
            const bf16x8 uh = *(const LAS bf16x8*)(lds + LR_UH + fr * LR_USTRIDE + (128 * wave + 32 * s4 + 8 * fq) * 2);
            const bf16x8 ul = *(const LAS bf16x8*)(lds + LR_UL + fr * LR_USTRIDE + (128 * wave + 32 * s4 + 8 * fq) * 2);
            acc0 = __builtin_amdgcn_mfma_f32_16x16x32_bf16(uh, wh[s4][0], acc0, 0, 0, 0); acc1 = __builtin_amdgcn_mfma_f32_16x16x32_bf16(uh, wh[s4][1], acc1, 0, 0, 0);
            acc0 = __builtin_amdgcn_mfma_f32_16x16x32_bf16(ul, wh[s4][0], acc0, 0, 0, 0); acc1 = __builtin_amdgcn_mfma_f32_16x16x32_bf16(ul, wh[s4][1], acc1, 0, 0, 0);
            acc0 = __builtin_amdgcn_mfma_f32_16x16x32_bf16(uh, wl[s4][0], acc0, 0, 0, 0); acc1 = __builtin_amdgcn_mfma_f32_16x16x32_bf16(uh, wl[s4][1], acc1, 0, 0, 0);
        }
#pragma unroll
        for (int r = 0; r < 4; ++r) { part[(wave * 16 + 4 * fq + r) * 32 + fr] = acc0[r]; part[(wave * 16 + 4 * fq + r) * 32 + 16 + fr] = acc1[r]; }
        __syncthreads();
        { const int rr = lane >> 5, e = lane & 31, r16 = 2 * wave + rr; const size_t row = (size_t)(rbase + r16);
            float sv = rb[e];
#pragma unroll
            for (int w8 = 0; w8 < 8; ++w8) sv += part[(w8 * 16 + r16) * 32 + e];
            logit[r16 * 32 + e] = sv;
            asm volatile("s_waitcnt lgkmcnt(0)" ::: "memory");
            int rank = 0;
#pragma unroll
            for (int e4 = 0; e4 < 8; ++e4) { const f32x4 t4 = *(const LAS f32x4*)(logit + r16 * 32 + 4 * e4);
#pragma unroll
                for (int c = 0; c < 4; ++c) { const int j = 4 * e4 + c; rank += (t4[c] > sv || (t4[c] == sv && j < e)) ? 1 : 0; } }
            LAS float* sel = logit + 512 + r16 * 4;
            if (rank < 4) sel[rank] = sv;
            asm volatile("s_waitcnt lgkmcnt(0)" ::: "memory");
            if (rank < 4) {
                const f32x4 t4 = *(const LAS f32x4*)sel;
                const float ex1 = __expf(t4[1] - t4[0]), ex2 = __expf(t4[2] - t4[0]), ex3 = __expf(t4[3] - t4[0]), inv = 1.0f / ((1.0f + ex1) + (ex2 + ex3));
                const unsigned k = __hip_atomic_fetch_add(lcnt + e, 1u, __ATOMIC_RELAXED, __HIP_MEMORY_SCOPE_WORKGROUP);
                lrec[(li * 16 + r16) * 4 + rank] = ((unsigned)e << 16) | k;
                TOPE[row * 4 + rank] = e; TOPG[row * 4 + rank] = __expf(sv - t4[0]) * inv;
            }
        }
        __syncthreads();
    }
    if (tid < NEXP) lcnt[32 + tid] = atomicAdd(&CNT[tid], lcnt[tid]);
    __syncthreads();
    for (int i = tid; i < li * 64; i += NTHR) { const unsigned rec = lrec[i]; const int sb = bx + (i >> 6) * G; POS[(size_t)sb * 64 + (i & 63)] = (int)(lcnt[32 + (rec >> 16)] + (rec & 0xffffu)); }
    __syncthreads();
}

__device__ __forceinline__ void unpack8(const u32x4 w, float (&f)[8]) {
#pragma unroll
    for (int c = 0; c < 4; ++c) { f[2 * c] = __uint_as_float(w[c] << 16); f[2 * c + 1] = __uint_as_float(w[c] & 0xffff0000u); }
}
__device__ __forceinline__ void unpack8_fp8(const u32x2 w, float (&f)[8]) {
#pragma unroll
    for (int c = 0; c < 2; ++c) { const auto lo = __builtin_amdgcn_cvt_pk_f32_fp8((int)w[c], false), hi = __builtin_amdgcn_cvt_pk_f32_fp8((int)w[c], true);
        f[4 * c] = lo[0]; f[4 * c + 1] = lo[1]; f[4 * c + 2] = hi[0]; f[4 * c + 3] = hi[1]; }
}
__device__ __forceinline__ void lnf_phase(const int wave, const int lane, const int bx, const int G, const unsigned char* __restrict__ YS, const int* __restrict__ SLOT, const float* __restrict__ TOPG,
                                          const float* __restrict__ lng, const float* __restrict__ lnb, const float* __restrict__ mod_l, const float* __restrict__ mod_n,
                                          const bf16_t* __restrict__ V, const float* __restrict__ STAT, const float* __restrict__ lmg, const float* __restrict__ lmb,
                                          bf16_t* __restrict__ X, bf16_t* __restrict__ U, float* __restrict__ out_final) {
    const int gw = bx * NWAVES + wave, NW = G * NWAVES;
    for (int row0 = gw * 2; row0 < NT; row0 += NW * 2) {
        int l8 = lane * 8; asm volatile("" : "+v"(l8));
        const int b = row0 / SEQ; const float* m = mod_l + (size_t)b * 6 * DM; const float* mn = mod_n + (size_t)b * 6 * DM;
        u32x4 sl[2]; f32x4 gk[2]; pg8::f32x2 st[2];
#pragma unroll
        for (int rr = 0; rr < 2; ++rr) { sl[rr] = *(const u32x4*)(SLOT + (size_t)(row0 + rr) * 4); gk[rr] = *(const f32x4*)(TOPG + (size_t)(row0 + rr) * 4) * 0.0625f; st[rr] = *(const pg8::f32x2*)(STAT + (size_t)(row0 + rr) * 2); }
        u32x2 yv[2][4][2]; u32x4 xv[2][2];
#pragma unroll
        for (int rr = 0; rr < 2; ++rr) {
#pragma unroll
            for (int k = 0; k < 4; ++k)
#pragma unroll
                for (int j = 0; j < 2; ++j) yv[rr][k][j] = *(const u32x2*)(YS + (size_t)sl[rr][k] * DM + j * 512 + l8);
#pragma unroll
            for (int j = 0; j < 2; ++j) xv[rr][j] = *(const u32x4*)(V + (size_t)(row0 + rr) * DM + j * 512 + l8);
        }
#pragma unroll
        for (int rr = 0; rr < 2; ++rr) {
            const size_t row = (size_t)(row0 + rr);
            float v[16]; float s = 0.f;
#pragma unroll
            for (int j = 0; j < 2; ++j) {
                float y[8], t[8], xs[8];
#pragma unroll
                for (int c = 0; c < 8; ++c) y[c] = 0.f;
#pragma unroll
                for (int k = 0; k < 4; ++k) { unpack8_fp8(yv[rr][k][j], t);
#pragma unroll
                    for (int c = 0; c < 8; ++c) y[c] += gk[rr][k] * t[c]; }
                unpack8(xv[rr][j], xs);
                { const f32x4 a0 = *(const f32x4*)(lmg + j * 512 + l8), a1 = *(const f32x4*)(lmg + j * 512 + l8 + 4), b0 = *(const f32x4*)(lmb + j * 512 + l8), b1 = *(const f32x4*)(lmb + j * 512 + l8 + 4);
#pragma unroll
                  for (int c = 0; c < 8; ++c) xs[c] = (xs[c] - st[rr].x) * st[rr].y * (c < 4 ? a0[c & 3] : a1[c & 3]) + (c < 4 ? b0[c & 3] : b1[c & 3]); }
                const f32x4 g0 = *(const f32x4*)(m + 5 * DM + j * 512 + l8), g1 = *(const f32x4*)(m + 5 * DM + j * 512 + l8 + 4);
#pragma unroll
                for (int c = 0; c < 8; ++c) { v[8 * j + c] = ALPHA * xs[c] + (1.0f + (c < 4 ? g0[c & 3] : g1[c & 3])) * y[c]; s += v[8 * j + c]; }
            }
            const float mean = wave_sum_l(s, lane) * (1.f / DM); float q = 0.f;
#pragma unroll
            for (int i = 0; i < 16; ++i) { v[i] -= mean; q += v[i] * v[i]; }
            const float rstd = rsqrtf(wave_sum_l(q, lane) * (1.f / DM) + LN_EPS);
#pragma unroll
            for (int j = 0; j < 2; ++j) {
                const f32x4 a0 = *(const f32x4*)(lng + j * 512 + l8), a1 = *(const f32x4*)(lng + j * 512 + l8 + 4), b0 = *(const f32x4*)(lnb + j * 512 + l8), b1 = *(const f32x4*)(lnb + j * 512 + l8 + 4);
                f32x4 x0, x1;
#pragma unroll
                for (int c = 0; c < 4; ++c) { x0[c] = v[8 * j + c] * rstd * a0[c] + b0[c]; x1[c] = v[8 * j + 4 + c] * rstd * a1[c] + b1[c]; }
                if (out_final) { *(f32x4*)(out_final + row * DM + j * 512 + l8) = x0; *(f32x4*)(out_final + row * DM + j * 512 + l8 + 4) = x1; }
                else {
                    *(u32x4*)(X + row * DM + j * 512 + l8) = pg8::pack8(x0, x1);
                    const f32x4 sc0 = *(const f32x4*)(mn + DM + j * 512 + l8), sc1 = *(const f32x4*)(mn + DM + j * 512 + l8 + 4), sh0 = *(const f32x4*)(mn + j * 512 + l8), sh1 = *(const f32x4*)(mn + j * 512 + l8 + 4);
                    *(u32x4*)(U + row * DM + j * 512 + l8) = pg8::pack8(x0 * (sc0 + 1.0f) + sh0, x1 * (sc1 + 1.0f) + sh1);
                }
            }
        }
    }
}

struct Params {
    const float *x_in, *c_in; const int* pos_in;
    const float *ada_w, *ada_b, *ln_mix_g, *ln_mix_b, *ln_ffn_g, *ln_ffn_b;
    const float *ev_w_in, *ev_conv_w, *ev_sg_w, *ev_sg_b, *ev_vn_g, *ev_vn_b, *ev_w_out;
    const float *od_w_in, *od_dw_w, *od_dw_b, *od_cn_g, *od_cn_b, *od_qn_g, *od_w_uq, *od_kvn_g, *od_w_ukv, *od_w_out;
    const float *r_w, *r_b, *w_gu, *b_gu, *w_dn, *b_dn;
    float* out; unsigned char* ws;
    int ph_lo, ph_hi;
};
constexpr int PH_PREP = 0, PH_MOD0 = 1, PH_LAYER0 = 2, PH_STRIDE = 16, PH_END = PH_LAYER0 + PH_STRIDE * (DEPTH - 1) + 10;
constexpr int LP_IN = 0, LP_MIX = 1, LP_UP = 2, LP_ATT = 3, LP_OUT = 4, LP_LNR = 5, LP_SCAT = 6, LP_M1 = 7, LP_M2 = 8, LP_LNF = 9;

enum { WM_ID = 0, WM_GU = 1, WM_EIN = 2, WM_OIN = 3, WM_UQ = 4, WM_UKV = 5 };
__device__ __forceinline__ int srccol(int mode, int pr) {
    const int tile = pr >> 8, r = pr & 255;
    switch (mode) {
        case WM_GU: return (r < 128 ? 0 : 1024) + tile * 128 + (r & 127);
        case WM_EIN: return (tile < 2 || tile >= 6) ? pr : ((r < 128 ? 512 : 1024) + (tile - 2) * 128 + (r & 127));
        case WM_OIN: if (tile < 4) return (r < 128 ? 0 : 512) + tile * 128 + (r & 127); if (tile == 4) return 1024 + r; return r < 128 ? 1280 + r : (r < 160 ? 1408 + (r - 128) : -1);
        case WM_UQ: { const int h = pr / 96, d = pr - 96 * h; return d < 64 ? pr : h * 96 + 64 + 16 * ((d - 64) & 1) + ((d - 64) >> 1); }
        case WM_UKV: { const int j = pr & 511, h = j >> 6, d = j & 63; return h * 128 + (pr < 512 ? 0 : 64) + d; }
        default: return pr;
    }
}
__device__ __forceinline__ void transpose_item(const float* W, int ldw, bf16_t* WT, int ldk, int k0, int n0, int mode, LAS float* scr, int lane) {
    if (mode == WM_UQ) {
        const int sc = srccol(mode, n0 + (lane & 31));
#pragma unroll 8
        for (int i = 0; i < 32; ++i) { const int kk = 2 * i + (lane >> 5); scr[kk * 33 + (lane & 31)] = W[(size_t)(k0 + kk) * ldw + sc]; }
    } else {
        const int c4 = (lane & 7) * 4, sc = srccol(mode, n0 + c4);
        f32x4 t[8];
#pragma unroll
        for (int i = 0; i < 8; ++i) { const int kk = 8 * i + (lane >> 3); t[i] = sc >= 0 ? __builtin_nontemporal_load((const f32x4*)(W + (size_t)(k0 + kk) * ldw + sc)) : (f32x4){0.f, 0.f, 0.f, 0.f}; }
#pragma unroll
        for (int i = 0; i < 8; ++i) { const int kk = 8 * i + (lane >> 3); LAS float* d = scr + kk * 33 + c4; d[0] = t[i][0]; d[1] = t[i][1]; d[2] = t[i][2]; d[3] = t[i][3]; }
    }
    asm volatile("s_waitcnt lgkmcnt(0)" ::: "memory");
    const int c = lane & 7;
#pragma unroll
    for (int j = 0; j < 4; ++j) { const int n = (lane >> 3) + 8 * j; const LAS float* s = scr + (8 * c) * 33 + n;
        u32x4 o; o.x = pg8::cvt_pk_bf16(s[0 * 33], s[1 * 33]); o.y = pg8::cvt_pk_bf16(s[2 * 33], s[3 * 33]); o.z = pg8::cvt_pk_bf16(s[4 * 33], s[5 * 33]); o.w = pg8::cvt_pk_bf16(s[6 * 33], s[7 * 33]);
        *(u32x4*)(WT + (size_t)(n0 + n) * ldk + k0 + 8 * c) = o; }
    asm volatile("s_waitcnt lgkmcnt(0)" ::: "memory");
}
__device__ __forceinline__ void transpose_item_f8(const float* W, int ldw, unsigned char* WT, int ldk, int k0, int n0, int mode, float mul, LAS float* scr, int lane) {
    const int c4 = (lane & 7) * 4, sc = srccol(mode, n0 + c4);
    f32x4 t[8];
#pragma unroll
    for (int i = 0; i < 8; ++i) { const int kk = 8 * i + (lane >> 3); t[i] = __builtin_nontemporal_load((const f32x4*)(W + (size_t)(k0 + kk) * ldw + sc)); }
#pragma unroll
    for (int i = 0; i < 8; ++i) { const int kk = 8 * i + (lane >> 3); LAS float* d = scr + kk * 33 + c4; d[0] = t[i][0] * mul; d[1] = t[i][1] * mul; d[2] = t[i][2] * mul; d[3] = t[i][3] * mul; }
    asm volatile("s_waitcnt lgkmcnt(0)" ::: "memory");
    const int c = lane & 3;
#pragma unroll
    for (int j = 0; j < 2; ++j) { const int n = (lane >> 2) + 16 * j; const LAS float* s = scr + (16 * c) * 33 + n;
        u32x4 o; o.x = pk4_fp8(s[0 * 33], s[1 * 33], s[2 * 33], s[3 * 33]); o.y = pk4_fp8(s[4 * 33], s[5 * 33], s[6 * 33], s[7 * 33]);
        o.z = pk4_fp8(s[8 * 33], s[9 * 33], s[10 * 33], s[11 * 33]); o.w = pk4_fp8(s[12 * 33], s[13 * 33], s[14 * 33], s[15 * 33]);
        *(u32x4*)(WT + (size_t)(n0 + n) * ldk + k0 + 16 * c) = o; }
    asm volatile("s_waitcnt lgkmcnt(0)" ::: "memory");
}
__device__ __forceinline__ bool prep_family_f8(int& it, const float* W, size_t wstride, int ldw, int K, int nphys, unsigned char* WT, size_t tstride, int ldk, int nmat, int mode, float mul, LAS float* scr, int lane) {
    const int nblk = nphys / 32, per = (K / 64) * nblk, tot = per * nmat;
    if (it >= tot) { it -= tot; return false; }
    const int mi = it / per, r = it % per, kb = r / nblk, nb = r % nblk;
    transpose_item_f8(W + (size_t)mi * wstride, ldw, WT + (size_t)mi * tstride, ldk, kb * 64, nb * 32, mode, mul, scr, lane);
    return true;
}
__device__ __forceinline__ bool prep_family(int& it, const float* W, size_t wstride, int ldw, int K, int nphys, bf16_t* WT, size_t tstride, int ldk, int koff, int nmat, int mode, LAS float* scr, int lane) {
    const int nblk = nphys / 32, per = (K / 64) * nblk, tot = per * nmat;
    if (it >= tot) { it -= tot; return false; }
    const int mi = it / per, r = it % per, kb = r / nblk, nb = r % nblk;
    transpose_item(W + (size_t)mi * wstride, ldw, WT + (size_t)mi * tstride + koff, ldk, kb * 64, nb * 32, mode, scr, lane);
    return true;
}


struct F8Item { const float* src; unsigned char* dst; float mul; };
constexpr int F8_SCR = 128 * 33 * 4;
__device__ __forceinline__ F8Item f8_item(const Params& P, unsigned char* ws, int it, int lane) {
    F8Item r; const int c4 = (lane & 7) * 4;
    if (it < 128 * 512) { const int mi = it >> 9, q = it & 511, k0 = (q >> 6) * 128, n0 = (q & 63) * 32;
        r.src = P.w_gu + (size_t)mi * DM * 2048 + (size_t)(k0 + (lane >> 3)) * 2048 + srccol(WM_GU, n0 + c4);
        r.dst = ws + WT_GU + (size_t)mi * 2048 * DM + (size_t)(n0 + (lane >> 3)) * DM + k0 + 16 * (lane & 7); r.mul = (float)(1 << W8_GU_SH); }
    else { const int i2 = it - 128 * 512, mi = i2 >> 8, q = i2 & 255, k0 = (q >> 5) * 128, n0 = (q & 31) * 32;
        r.src = P.w_dn + (size_t)mi * DM * DM + (size_t)(k0 + (lane >> 3)) * DM + n0 + c4;
        r.dst = ws + WT_DN + (size_t)mi * DM * DM + (size_t)(n0 + (lane >> 3)) * DM + k0 + 16 * (lane & 7); r.mul = (float)(1 << W8_DN_SH); }
    return r;
}
constexpr int F8_ITEMS_GU = 32 * 512, F8_ITEMS_DN = 32 * 256, F8_ITEMS_LAYER = F8_ITEMS_GU + F8_ITEMS_DN;
__device__ __forceinline__ int f8_item_id(int layer, int j) { return j < F8_ITEMS_GU ? layer * F8_ITEMS_GU + j : DEPTH * F8_ITEMS_GU + layer * F8_ITEMS_DN + (j - F8_ITEMS_GU); }
__device__ __forceinline__ void f8_convert(const Params& P, unsigned char* ws, LAS float* scr, int lane, int it) {
    const F8Item cur = f8_item(P, ws, it, lane);
    const int ldw = it < 128 * 512 ? 2048 : DM;
    f32x4 t[16];
#pragma unroll
    for (int i = 0; i < 16; ++i) t[i] = __builtin_nontemporal_load((const f32x4*)(cur.src + (size_t)(8 * i) * ldw));
    const int c4 = (lane & 7) * 4;
#pragma unroll
    for (int i = 0; i < 16; ++i) { const int kk = 8 * i + (lane >> 3); LAS float* d = scr + kk * 33 + c4; d[0] = t[i][0] * cur.mul; d[1] = t[i][1] * cur.mul; d[2] = t[i][2] * cur.mul; d[3] = t[i][3] * cur.mul; }
    asm volatile("s_waitcnt lgkmcnt(0)" ::: "memory");
#pragma unroll
    for (int j = 0; j < 4; ++j) { const LAS float* sp = scr + (16 * (lane & 7)) * 33 + (lane >> 3) + 8 * j;
        u32x4 o; o.x = pk4_fp8(sp[0 * 33], sp[1 * 33], sp[2 * 33], sp[3 * 33]); o.y = pk4_fp8(sp[4 * 33], sp[5 * 33], sp[6 * 33], sp[7 * 33]);
        o.z = pk4_fp8(sp[8 * 33], sp[9 * 33], sp[10 * 33], sp[11 * 33]); o.w = pk4_fp8(sp[12 * 33], sp[13 * 33], sp[14 * 33], sp[15 * 33]);
        *(u32x4*)(cur.dst + (size_t)(8 * j) * DM) = o; }
    asm volatile("s_waitcnt lgkmcnt(0)" ::: "memory");
}
struct SparePlan { int g1, q1, g2, q2, done; };
__device__ __forceinline__ SparePlan spare_plan(int nM, int G) {
    SparePlan p; const int n1 = nM * 8, r1 = (n1 + G - 1) / G, n2 = nM * 4, r2 = (n2 + G - 1) / G;
    p.g1 = (n1 + r1 - 1) / r1; p.q1 = 32 * r1; p.g2 = (n2 + r2 - 1) / r2; p.q2 = 40 * r2;
    const int d = (G - p.g1) * p.q1 + (G - p.g2) * p.q2; p.done = d < F8_ITEMS_LAYER ? d : F8_ITEMS_LAYER; return p;
}
__device__ __forceinline__ void f8_convert_range(const Params& P, unsigned char* ws, LAS float* scr, int lane, int wave, int layer, int j0, int j1) {
    if (j1 > F8_ITEMS_LAYER) j1 = F8_ITEMS_LAYER;
    for (int j = j0 + wave; j < j1; j += NWAVES) f8_convert(P, ws, scr, lane, f8_item_id(layer, j));
}
#define PH_LOCALS \
    __attribute__((address_space(1))) unsigned char* wsg = (__attribute__((address_space(1))) unsigned char*)P.ws; asm volatile("" : "+s"(wsg)); unsigned char* ws = (unsigned char*)wsg;     \
    const int lane = lane_id_asm(); \
    int wave = wave0; asm volatile("" : "+s"(wave)); const int tid = wave * 64 + lane; \
    int bx = blockIdx.x, G = gridDim.x; asm volatile("" : "+s"(bx), "+s"(G)); \
    const int gw = bx * NWAVES + wave, NW = G * NWAVES; \
    const size_t gtid = (size_t)bx * NTHR + tid, GT = (size_t)G * NTHR; \
    unsigned* ctl = (unsigned*)(ws + WS_CTL); \
    float* MOD = (float*)(ws + WS_MOD); float* CS = (float*)(ws + WS_CS); float* X = (float*)(ws + WS_X); float* V = (float*)(ws + WS_V); \
    bf16_t* U = (bf16_t*)(ws + WS_U); bf16_t* Y = (bf16_t*)(ws + WS_Y); bf16_t* BG = (bf16_t*)(ws + WS_BG); bf16_t* CX = (bf16_t*)(ws + WS_CX); bf16_t* GZU = (bf16_t*)(ws + WS_GZU); bf16_t* GZV = (bf16_t*)(ws + WS_GZV); \
    bf16_t* GLU = (bf16_t*)(ws + WS_GLU); bf16_t* CQKV = (bf16_t*)(ws + WS_CQKV); bf16_t* CQKVN = (bf16_t*)(ws + WS_CQKVN); bf16_t* KRR = (bf16_t*)(ws + WS_KRR); bf16_t* KR = (bf16_t*)(ws + WS_KR); \
    bf16_t* Q = (bf16_t*)(ws + WS_Q); bf16_t* KN = (bf16_t*)(ws + WS_KN); bf16_t* VV = (bf16_t*)(ws + WS_VV); \
    int* TOPE = (int*)(ws + WS_TOPE); float* TOPG = (float*)(ws + WS_TOPG); int* POS = (int*)(ws + WS_POS); int* SLOT = (int*)(ws + WS_SLOT); int* ROWTOK = (int*)(ws + WS_ROWTOK); \
    bf16_t* H = (bf16_t*)(ws + WS_H); unsigned char* YS = (unsigned char*)(ws + WS_YS); \
    (void)lane; (void)wave; (void)gw; (void)NW; (void)gtid; (void)GT; (void)ctl; (void)MOD; (void)CS; (void)X; (void)V; (void)U; (void)Y; (void)BG; (void)CX; (void)GZU; (void)GZV; (void)GLU; (void)CQKV; (void)CQKVN; \
    (void)KRR; (void)KR; (void)Q; (void)KN; (void)VV; (void)TOPE; (void)TOPG; (void)POS; (void)SLOT; (void)ROWTOK; (void)H; (void)YS
#define LY_LOCALS \
    int ly = layer; asm volatile("" : "+s"(ly)); const int li = ly >> 1; \
    const float* mod_l = MOD + (size_t)ly * NB * 6 * DM; const float* mod_n = MOD + (size_t)(ly + 1) * NB * 6 * DM; \
    const float* xres = ly == 0 ? P.x_in : X; \
    unsigned* CNT = ctl + CW_CNT + ly * 32; unsigned* OFFS = ctl + CW_OFFS + ly * 64; \
    (void)li; (void)mod_l; (void)mod_n; (void)xres; (void)CNT; (void)OFFS

__global__ void __launch_bounds__(NTHR, 2) mega(Params P) {
    extern __shared__ __attribute__((aligned(16))) unsigned char lds_raw[];
    LAS unsigned char* lds = (LAS unsigned char*)lds_raw;
    volatile LAS unsigned* MISC = (volatile LAS unsigned*)(lds + MISC_OFF);
    for (int u = threadIdx.x; u < (LDS_BYTES - MISC_OFF) / 4; u += NTHR) ((LAS unsigned*)(lds + MISC_OFF))[u] = 0u;
    __syncthreads();
    const int wave0 = __builtin_amdgcn_readfirstlane((int)(threadIdx.x >> 6));
    XcdBarrier bar = xcd_barrier_post((unsigned*)(P.ws + WS_CTL) + CW_BAR, MISC + 8, wave0);
    const int lo = P.ph_lo, hi = P.ph_hi;
#define IN(k) (lo <= (k) && (k) < hi)
#define SEAM(k) do { if ((k) + 1 < hi) xcd_barrier(bar); } while (0)

    if (IN(PH_PREP)) {
        PH_LOCALS;
        LAS float* scr = (LAS float*)(lds + wave * F8_SCR);
        for (int j = gw; j < F8_ITEMS_LAYER; j += NW) f8_convert(P, ws, scr, lane, f8_item_id(0, j));
        constexpr int NITEMS = 2 * 1280 + 2 * 512 + 2 * 768 + 2 * 96 + 2 * 64 + 2 * 512;
        for (int it0 = gw; it0 < NITEMS; it0 += NW) {
            int it = it0;
            if (prep_family(it, P.ev_w_in, (size_t)DM * 2560, 2560, DM, 2560, (bf16_t*)(ws + WT_EIN), (size_t)2560 * DM, DM, 0, 2, WM_EIN, scr, lane)) continue;
            if (prep_family(it, P.ev_w_out, (size_t)DM * DM, DM, DM, DM, (bf16_t*)(ws + WT_EOUT), (size_t)DM * DM, DM, 0, 2, WM_ID, scr, lane)) continue;
            if (prep_family(it, P.od_w_in, (size_t)DM * 1440, 1440, DM, 1536, (bf16_t*)(ws + WT_OIN), (size_t)1536 * DM, DM, 0, 2, WM_OIN, scr, lane)) continue;
            if (prep_family(it, P.od_w_uq, (size_t)256 * 768, 768, 256, 768, (bf16_t*)(ws + WT_OUP), (size_t)1792 * 256, 256, 0, 2, WM_UQ, scr, lane)) continue;
            if (prep_family(it, P.od_w_ukv, (size_t)128 * 1024, 1024, 128, 1024, (bf16_t*)(ws + WT_OUP) + (size_t)768 * 256, (size_t)1792 * 256, 256, 128, 2, WM_UKV, scr, lane)) continue;
            prep_family(it, P.od_w_out, (size_t)DM * DM, DM, DM, DM, (bf16_t*)(ws + WT_OOUT), (size_t)DM * DM, DM, 0, 2, WM_ID, scr, lane);
        }
        for (size_t i = gtid; i < (size_t)2 * 1792 * 256; i += GT) { const int col = (int)(i & 255), row = (int)((i >> 8) % 1792); if (row >= 768 && col < 128) ((bf16_t*)(ws + WT_OUP))[i] = 0; }
        for (size_t i = gtid; i < (size_t)2 * 8 * 128 * 128; i += GT) { const int jj = (int)(i & 127), ii = (int)((i >> 7) & 127); ((bf16_t*)(ws + WT_SGW))[i] = jj <= ii ? f2bf(P.ev_sg_w[i]) : (bf16_t)0; }
        for (size_t i = gtid; i < (size_t)NT * 16; i += GT) { const int tok = (int)(i >> 4), f = (int)(i & 15); float c, s; sincos_d((double)P.pos_in[tok] * INVF[f], c, s); CS[(size_t)tok * 32 + f] = c; CS[(size_t)tok * 32 + 16 + f] = s; }
        __syncthreads();
        {
            LAS float* sc = (LAS float*)lds;
            LAS float* red = (LAS float*)(lds + 32768);
            for (int i = tid; i < NB * DM; i += NTHR) { const float v = P.c_in[i]; sc[i] = v * sigmoidf_(v); }
            __syncthreads();
            for (int item = bx; item < DEPTH * 6 * DM / 64; item += G) {
                const int col = item * 64 + (tid & 63), l = col / (6 * DM), n = col % (6 * DM), kg = tid >> 6;
                float a[NB];
#pragma unroll
                for (int b = 0; b < NB; ++b) a[b] = 0.f;
                const float* w = P.ada_w + (size_t)l * DM * 6 * DM + (size_t)(kg * 128) * 6 * DM + n;
                for (int k = 0; k < 128; ++k) { const float wv = w[(size_t)k * 6 * DM];
#pragma unroll
                    for (int b = 0; b < NB; ++b) a[b] += sc[b * DM + kg * 128 + k] * wv; }
#pragma unroll
                for (int b = 0; b < NB; ++b) red[(kg * NB + b) * 64 + (tid & 63)] = a[b];
                __syncthreads();
                { const int b = tid >> 6, cc = tid & 63; float s = 0.f;
#pragma unroll
                    for (int k8 = 0; k8 < 8; ++k8) s += red[(k8 * NB + b) * 64 + cc];
                    const int col2 = item * 64 + cc, l2 = col2 / (6 * DM), n2 = col2 % (6 * DM);
                    MOD[((size_t)l2 * NB + b) * 6 * DM + n2] = s + P.ada_b[(size_t)l2 * 6 * DM + n2]; }
                __syncthreads();
            }
        }
        SEAM(PH_PREP);
    }
    if (IN(PH_MOD0)) {
        PH_LOCALS;
        for (size_t i = gtid * 4; i < (size_t)NT * DM; i += GT * 4) { const int tok = (int)(i / DM), col = (int)(i % DM), b = tok / SEQ; const float* m = MOD + (size_t)b * 6 * DM;
            const float4 xv = *(const float4*)(P.x_in + i), sc = *(const float4*)(m + DM + col), sh = *(const float4*)(m + col);
            ushort4 o; o.x = f2bf(xv.x * (1.f + sc.x) + sh.x); o.y = f2bf(xv.y * (1.f + sc.y) + sh.y); o.z = f2bf(xv.z * (1.f + sc.z) + sh.z); o.w = f2bf(xv.w * (1.f + sc.w) + sh.w);
            *(ushort4*)(U + i) = o; }
        SEAM(PH_MOD0);
    }

    for (int layer = 0; layer < DEPTH; ++layer) {
        const int pb = PH_LAYER0 + PH_STRIDE * layer;
        if ((layer & 1) == 0) {
            if (IN(pb + LP_IN)) {
                PH_LOCALS; LY_LOCALS;
                pg8::Gemm g{U, DM, nullptr, (const bf16_t*)(ws + WT_EIN) + (size_t)li * 2560 * DM, DM, 0, DM};
                pg8::Sched S; S.init(NT / 256, 10, G, bx, nullptr);
                pg8::EpiE1 E{BG, CX, GZU, GZV};
                pg8::gemm_phase(lds, wave, g, S, E);
                SEAM(pb + LP_IN);
            }
            if (IN(pb + LP_MIX)) {
                PH_LOCALS; LY_LOCALS;
                even_mix_phase(lds, wave, lane, bx, G, BG, CX, GZU, GZV, (const bf16_t*)(ws + WT_SGW) + (size_t)li * 8 * 128 * 128, P.ev_conv_w + (size_t)li * 3 * 512, P.ev_sg_b + (size_t)li * 8 * 128,
                               P.ev_vn_g + (size_t)li * 512, P.ev_vn_b + (size_t)li * 512, Y);
                SEAM(pb + LP_MIX);
            }
        } else {
            if (IN(pb + LP_IN)) {
                PH_LOCALS; LY_LOCALS;
                pg8::Gemm g{U, DM, nullptr, (const bf16_t*)(ws + WT_OIN) + (size_t)li * 1536 * DM, DM, 0, DM};
                pg8::Sched S; S.init(NT / 256, 6, G, bx, nullptr);
                pg8::EpiO1 E{GLU, CQKV, KRR};
                pg8::gemm_phase(lds, wave, g, S, E);
                SEAM(pb + LP_IN);
            }
            if (IN(pb + LP_MIX)) {
                PH_LOCALS; LY_LOCALS;
                odd_mix_phase(lds, wave, lane, bx, G, GLU, CQKV, KRR, CS, P.od_dw_w + (size_t)li * 31 * 512, P.od_dw_b + (size_t)li * 512, P.od_cn_g + (size_t)li * 512, P.od_cn_b + (size_t)li * 512,
                              P.od_qn_g + (size_t)li * 256, P.od_kvn_g + (size_t)li * 128, Y, CQKVN, KR);
                SEAM(pb + LP_MIX);
            }
            if (IN(pb + LP_UP)) {
                PH_LOCALS; LY_LOCALS;
                pg8::Gemm g{CQKVN, 384, nullptr, (const bf16_t*)(ws + WT_OUP) + (size_t)li * 1792 * 256, 256, 0, 256, 3, 128};
                pg8::Sched S; S.init(NT / 256, 7, G, bx, nullptr);
                pg8::EpiO3 E{Q, KN, VV, CS};
                pg8::gemm_phase(lds, wave, g, S, E);
                SEAM(pb + LP_UP);
            }
            if (IN(pb + LP_ATT)) {
                PH_LOCALS; LY_LOCALS;
                attn_phase(lds, wave, lane, bx, G, Q, KN, KR, VV, Y);
                SEAM(pb + LP_ATT);
            }
        }
        if (IN(pb + LP_OUT)) {
                PH_LOCALS; LY_LOCALS;
            pg8::Gemm g{Y, DM, nullptr, (const bf16_t*)(ws + ((ly & 1) ? WT_OOUT : WT_EOUT)) + (size_t)li * DM * DM, DM, 0, DM};
            pg8::Sched S; S.init(NT / 256, 4, G, bx, nullptr);
            if (ly == 0) { pg8::EpiOut<true> E{P.x_in, mod_l + 2 * DM, (bf16_t*)V}; pg8::gemm_phase(lds, wave, g, S, E); }
            else { pg8::EpiOut<false> E{X, mod_l + 2 * DM, (bf16_t*)V}; pg8::gemm_phase(lds, wave, g, S, E); }
            SEAM(pb + LP_OUT);
        }
        if (IN(pb + LP_LNR)) {
                PH_LOCALS; LY_LOCALS;
            lnr_phase(lds, wave, lane, bx, G, (const bf16_t*)V, P.ln_mix_g + (size_t)ly * DM, P.ln_mix_b + (size_t)ly * DM, mod_l, (float*)(ws + WS_STAT), ws + WS_U8, P.r_w + (size_t)ly * DM * NEXP, P.r_b + (size_t)ly * NEXP, TOPE, TOPG, POS, CNT);
            SEAM(pb + LP_LNR);
        }
        if (IN(pb + LP_SCAT)) {
                PH_LOCALS; LY_LOCALS;
            LAS unsigned char* l2 = lds; asm volatile("" : "+v"(l2));
            volatile LAS unsigned* offs = (volatile LAS unsigned*)(l2 + MISC_OFF) + 64;
            if (tid == 0) { unsigned o = 0; for (int e = 0; e < NEXP; ++e) { const unsigned c = CNT[e]; offs[48 + e] = c; offs[e] = o; o += (c + 255u) & ~255u; } offs[NEXP] = o; }
            __syncthreads();
            if (bx == 0 && tid <= NEXP) OFFS[tid] = offs[tid];
            for (size_t a = gtid; a < (size_t)NASSIGN; a += GT) { const int e = TOPE[a]; const int slot = (int)offs[e] + POS[a]; SLOT[a] = slot; ROWTOK[slot] = (int)(a >> 2); }
            for (int e = 0; e < NEXP; ++e) for (size_t s = offs[e] + offs[48 + e] + gtid; s < offs[e + 1]; s += GT) ROWTOK[s] = 0;
            __syncthreads();
            if (ly > 0) {
                const int nMp = __builtin_amdgcn_readfirstlane((int)(ctl[CW_OFFS + (ly - 1) * 64 + NEXP] >> 8));
                const SparePlan sp = spare_plan(nMp, G);
                LAS float* scr = (LAS float*)(lds + wave * F8_SCR);
                for (int j = sp.done + gw; j < F8_ITEMS_LAYER; j += NW) f8_convert(P, ws, scr, lane, f8_item_id(ly, j));
                __syncthreads();
            }
            SEAM(pb + LP_SCAT);
        }
        if (IN(pb + LP_M1)) {
                PH_LOCALS; LY_LOCALS;
            const int nM = __builtin_amdgcn_readfirstlane((int)(OFFS[NEXP] >> 8));
            LAS int* tile_e = (LAS int*)(lds + MISC_OFF + 1024);
            for (int pm = tid; pm < nM; pm += NTHR) { const unsigned rowb = (unsigned)pm * 256u; int e = 0;
                for (int j = 1; j < NEXP; ++j) e += (rowb >= OFFS[j]) ? 1 : 0;
                tile_e[pm] = e; }
            __syncthreads();
            pg8::Gemm g{(const bf16_t*)(ws + WS_U8), DM / 2, ROWTOK, (const bf16_t*)(ws + WT_GU) + (size_t)ly * NEXP * 2048 * (DM / 2), DM / 2, (size_t)2048 * (DM / 2), DM / 2};
            const SparePlan sp = spare_plan(nM, G);
            if (bx < sp.g1) {
                pg8::Sched S; S.init(nM, 8, sp.g1, bx, tile_e);
                pg8::EpiM1 E{P.b_gu + (size_t)ly * NEXP * 2048, (unsigned char*)H, lds};
                pg8::gemm_phase<pg8::EpiM1, 127 - W8_GU_SH>(lds, wave, g, S, E);
            } else if (ly + 1 < DEPTH) { const int k = bx - sp.g1; f8_convert_range(P, ws, (LAS float*)(lds + wave * F8_SCR), lane, wave, ly + 1, k * sp.q1, (k + 1) * sp.q1); }
            SEAM(pb + LP_M1);
        }
        if (IN(pb + LP_M2)) {
                PH_LOCALS; LY_LOCALS;
            const int nM = __builtin_amdgcn_readfirstlane((int)(OFFS[NEXP] >> 8));
            LAS int* tile_e = (LAS int*)(lds + MISC_OFF + 1024);
            for (int pm = tid; pm < nM; pm += NTHR) { const unsigned rowb = (unsigned)pm * 256u; int e = 0;
                for (int j = 1; j < NEXP; ++j) e += (rowb >= OFFS[j]) ? 1 : 0;
                tile_e[pm] = e; }
            __syncthreads();
            pg8::Gemm g{H, DM / 2, nullptr, (const bf16_t*)(ws + WT_DN) + (size_t)ly * NEXP * DM * (DM / 2), DM / 2, (size_t)DM * (DM / 2), DM / 2};
            const SparePlan sp = spare_plan(nM, G);
            if (bx < sp.g2) {
                pg8::Sched S; S.init(nM, 4, sp.g2, bx, tile_e);
                pg8::EpiM2 E{P.b_dn + (size_t)ly * NEXP * DM, YS, lds};
                pg8::gemm_phase<pg8::EpiM2, 127 - W8_DN_SH>(lds, wave, g, S, E);
            } else if (ly + 1 < DEPTH) { const int k = bx - sp.g2, first = (G - sp.g1) * sp.q1; f8_convert_range(P, ws, (LAS float*)(lds + wave * F8_SCR), lane, wave, ly + 1, first + k * sp.q2, first + (k + 1) * sp.q2); }
            SEAM(pb + LP_M2);
        }
        if (IN(pb + LP_LNF)) {
                PH_LOCALS; LY_LOCALS;
            const float* lng = P.ln_ffn_g + (size_t)ly * DM; const float* lnb = P.ln_ffn_b + (size_t)ly * DM;
            float* out_final = ly == DEPTH - 1 ? P.out : nullptr;
            lnf_phase(wave, lane, bx, G, YS, SLOT, TOPG, lng, lnb, mod_l, mod_n, (const bf16_t*)V, (const float*)(ws + WS_STAT), P.ln_mix_g + (size_t)ly * DM, P.ln_mix_b + (size_t)ly * DM, (bf16_t*)X, U, out_final);
            SEAM(pb + LP_LNF);
        }
    }
#undef IN
#undef SEAM
}

extern "C" void kernel_launch(void* const* d_in, const int* in_sizes, int n_in, void* d_out, int out_size, void* d_ws, size_t ws_size, hipStream_t stream) {
    if (n_in != 32 || in_sizes[0] != NT * DM || out_size != NT * DM || ws_size < WS_END) { fprintf(stderr, "kernel_launch: built for 32 inputs, x / out of %d floats and >= %zu bytes of workspace; got n_in %d, out %d, ws %zu; nothing launched\n", NT * DM, (size_t)WS_END, n_in, out_size, ws_size); return; }
    static int grid = 0;
    if (grid == 0) {
        int dev = 0, cus = 0;
        if (hipGetDevice(&dev) != hipSuccess || hipDeviceGetAttribute(&cus, hipDeviceAttributeMultiprocessorCount, dev) != hipSuccess) { fprintf(stderr, "kernel_launch: device query failed; nothing launched\n"); grid = -1; return; }
        if (hipFuncSetAttribute((const void*)mega, hipFuncAttributeMaxDynamicSharedMemorySize, LDS_BYTES) != hipSuccess) { fprintf(stderr, "kernel_launch: hipFuncSetAttribute(%d B of dynamic LDS) failed; nothing launched\n", LDS_BYTES); grid = -1; return; }
        int per_cu = 0;
        if (hipOccupancyMaxActiveBlocksPerMultiprocessor(&per_cu, (const void*)mega, NTHR, LDS_BYTES) != hipSuccess || per_cu < 1) { fprintf(stderr, "kernel_launch: the occupancy query reports %d workgroups per CU; nothing launched\n", per_cu); (void)hipGetLastError(); grid = -1; return; }
        (void)hipGetLastError();
        grid = cus;
    }
    if (grid < 0) return;
    (void)hipMemsetAsync((unsigned char*)d_ws + WS_CTL, 0, 1 * MiB, stream);
    Params P{};
    P.x_in = (const float*)d_in[0]; P.c_in = (const float*)d_in[1]; P.pos_in = (const int*)d_in[2]; P.ada_w = (const float*)d_in[3]; P.ada_b = (const float*)d_in[4];
    P.ln_mix_g = (const float*)d_in[5]; P.ln_mix_b = (const float*)d_in[6]; P.ln_ffn_g = (const float*)d_in[7]; P.ln_ffn_b = (const float*)d_in[8];
    P.ev_w_in = (const float*)d_in[9]; P.ev_conv_w = (const float*)d_in[10]; P.ev_sg_w = (const float*)d_in[11]; P.ev_sg_b = (const float*)d_in[12]; P.ev_vn_g = (const float*)d_in[13]; P.ev_vn_b = (const float*)d_in[14]; P.ev_w_out = (const float*)d_in[15];
    P.od_w_in = (const float*)d_in[16]; P.od_dw_w = (const float*)d_in[17]; P.od_dw_b = (const float*)d_in[18]; P.od_cn_g = (const float*)d_in[19]; P.od_cn_b = (const float*)d_in[20]; P.od_qn_g = (const float*)d_in[21];
    P.od_w_uq = (const float*)d_in[22]; P.od_kvn_g = (const float*)d_in[23]; P.od_w_ukv = (const float*)d_in[24]; P.od_w_out = (const float*)d_in[25];
    P.r_w = (const float*)d_in[26]; P.r_b = (const float*)d_in[27]; P.w_gu = (const float*)d_in[28]; P.b_gu = (const float*)d_in[29]; P.w_dn = (const float*)d_in[30]; P.b_dn = (const float*)d_in[31];
    P.out = (float*)d_out; P.ws = (unsigned char*)d_ws; P.ph_lo = 0; P.ph_hi = PH_END;
    hipLaunchKernelGGL(mega, dim3(grid), dim3(NTHR), LDS_BYTES, stream, P);
}
```

```cpp
#include <hip/hip_runtime.h>
#include <cstdio>
#include <cstdint>

constexpr int NB = 8, SEQ = 4096, DM = 1024, NT = NB * SEQ, DEPTH = 4;
constexpr int NEXP = 32, TOPK = 4, NASSIGN = NT * TOPK;
constexpr int NSLOT = NASSIGN + NEXP * 256;
constexpr float ALPHA = 1.681792830507429f;
constexpr float LN_EPS = 1e-5f, RMS_EPS = 1e-6f;
constexpr float QSCALE = 0.1472444460259031f;

typedef unsigned short bf16_t;
__device__ __forceinline__ float bf2f(bf16_t v) { return __uint_as_float(((unsigned)v) << 16); }
__device__ __forceinline__ bf16_t f2bf(float f) { unsigned u = __float_as_uint(f); u += 0x7fffu + ((u >> 16) & 1u); return (bf16_t)(u >> 16); }
__device__ __forceinline__ float wave_sum(float v) {
#pragma unroll
    for (int o = 1; o < 64; o <<= 1) v += __shfl_xor(v, o);
    return v;
}
__device__ __forceinline__ float gelu_erf(float x) { return 0.5f * x * (1.0f + erff(x * 0.70710678118654752f)); }
__device__ __forceinline__ float sigmoidf_(float x) { return 1.0f / (1.0f + __expf(-x)); }

constexpr size_t MiB = 1ull << 20;
constexpr size_t WS_CTL = 0;
constexpr size_t WS_MOD = 1 * MiB;
constexpr size_t WS_CS = 2 * MiB;
constexpr size_t WS_X = 8 * MiB;
constexpr size_t WS_V = 136 * MiB;
constexpr size_t WS_U = 264 * MiB;
constexpr size_t WS_Y = 328 * MiB;
constexpr size_t WS_BG = 392 * MiB;
constexpr size_t WS_CX = 424 * MiB;
constexpr size_t WS_GZU = 456 * MiB;
constexpr size_t WS_GZV = 488 * MiB;
constexpr size_t WS_GLU = 520 * MiB;
constexpr size_t WS_CQKV = 552 * MiB;
constexpr size_t WS_CQKVN = 584 * MiB;
constexpr size_t WS_KRR = 616 * MiB;
constexpr size_t WS_KR = 620 * MiB;
constexpr size_t WS_Q = 624 * MiB;
constexpr size_t WS_KN = 672 * MiB;
constexpr size_t WS_VV = 704 * MiB;
constexpr size_t WS_TOPE = 736 * MiB;
constexpr size_t WS_TOPG = 737 * MiB;
constexpr size_t WS_POS = 738 * MiB;
constexpr size_t WS_SLOT = 739 * MiB;
constexpr size_t WS_ROWTOK = 740 * MiB;
constexpr size_t WS_STAT = 741 * MiB;
constexpr size_t WS_H = 744 * MiB;
constexpr size_t WS_YS = 1016 * MiB;
constexpr size_t WS_WT = 1288 * MiB;
constexpr size_t WS_U8 = 3176 * MiB;
constexpr size_t WS_END = 3208 * MiB;
constexpr int CW_CNT = 1024;
constexpr int CW_OFFS = 2048;

__device__ __constant__ double INVF[16] = {1.0, 0.5623413251903491, 0.31622776601683794, 0.1778279410038923, 0.1, 0.05623413251903491, 0.03162277660168379, 0.01778279410038923,
                                            0.01, 0.005623413251903491, 0.0031622776601683794, 0.0017782794100389228, 0.001, 0.0005623413251903491, 0.00031622776601683794, 0.00017782794100389227};

__device__ __forceinline__ void sincos_d(double a, float& c, float& s) {
    const double TWO_PI = 6.283185307179586476925286766559;
    double r = a - rint(a / TWO_PI) * TWO_PI;
    r *= 0.25;
    const double r2 = r * r;
    double sn = r * (1.0 + r2 * (-1.0 / 6 + r2 * (1.0 / 120 + r2 * (-1.0 / 5040 + r2 * (1.0 / 362880 + r2 * (-1.0 / 39916800 + r2 * (1.0 / 6227020800.0 + r2 * (-1.0 / 1307674368000.0))))))));
    double cs = 1.0 + r2 * (-0.5 + r2 * (1.0 / 24 + r2 * (-1.0 / 720 + r2 * (1.0 / 40320 + r2 * (-1.0 / 3628800 + r2 * (1.0 / 479001600.0 + r2 * (-1.0 / 87178291200.0 + r2 * (1.0 / 20922789888000.0))))))));
#pragma unroll
    for (int i = 0; i < 2; ++i) { const double s2 = 2.0 * sn * cs, c2 = 1.0 - 2.0 * sn * sn; sn = s2; cs = c2; }
    c = (float)cs; s = (float)sn;
}
#define LAS __attribute__((address_space(3)))
typedef short bf16x8 __attribute__((ext_vector_type(8)));
typedef float f32x4 __attribute__((ext_vector_type(4)));
typedef unsigned u32x4 __attribute__((ext_vector_type(4)));
constexpr int NWAVES = 8, NTHR = 512;
constexpr int RING_BYTES = 131072;
constexpr int MISC_OFF = 139264;
constexpr int MISC_OFF_OLD_UNUSED = RING_BYTES;
constexpr int LDS_BYTES = 147456;
constexpr size_t WT_GU = WS_WT, WT_DN = WS_WT + 512 * MiB, WT_EIN = WS_WT + 768 * MiB, WT_EOUT = WS_WT + 778 * MiB, WT_OIN = WS_WT + 782 * MiB, WT_OUP = WS_WT + 788 * MiB, WT_OOUT = WS_WT + 791 * MiB, WT_SGW = WS_WT + 795 * MiB;
constexpr int BIASSLOT_OFF = MISC_OFF + 5120;
constexpr int ROWSLOT_OFF = MISC_OFF + 4096;
constexpr int CW_BAR = 4096;

__device__ __forceinline__ int lane_id_asm() { int l; asm volatile("v_mbcnt_lo_u32_b32 %0, -1, 0\n\tv_mbcnt_hi_u32_b32 %0, -1, %0" : "=v"(l)); return l; }
__device__ __forceinline__ float shfl_xor_l(float v, int o, int lane) { return __int_as_float(__builtin_amdgcn_ds_bpermute((lane ^ o) << 2, __float_as_int(v))); }
__device__ __forceinline__ float wave_sum_l(float v, int lane) {
#pragma unroll
    for (int o = 1; o < 64; o <<= 1) v += shfl_xor_l(v, o, lane);
    return v;
}
#define XB_TMO      128
#define XB_XCNT(j)  (256  + 64 * (j))
#define XB_XSUB(j)  (1280 + 64 * (j))
#define XB_XGEN(j)  (2304 + 64 * (j))
#define XB_TOP      3328
#define XB_TOPGEN   3392
#define XCD_BAR_WORDS 3456
#define XB_SPIN_CAP (1u << 18)
__device__ __forceinline__ unsigned xb_ld(unsigned* p)              { return __hip_atomic_load(p, __ATOMIC_RELAXED, __HIP_MEMORY_SCOPE_AGENT); }
__device__ __forceinline__ unsigned xb_add(unsigned* p, unsigned v) { return __hip_atomic_fetch_add(p, v, __ATOMIC_RELAXED, __HIP_MEMORY_SCOPE_AGENT); }
__device__ __forceinline__ unsigned xb_xcc_id() { return (unsigned)__builtin_amdgcn_s_getreg((3 << 11) | 20) & 0xFu; }
#define XB_SPIN(cond, bar) do { unsigned _sp = 0; while (cond) { __builtin_amdgcn_s_sleep(1); \
    if ((++_sp & 255u) == 0u) { if (xb_ld(&(bar)[XB_TMO])) break; if (_sp > XB_SPIN_CAP) { atomicAdd(&(bar)[XB_TMO], 1u); break; } } } } while (0)
struct XcdBarrier { unsigned* bar; unsigned x; volatile LAS unsigned* st; int wave; };
__device__ __forceinline__ XcdBarrier xcd_barrier_post(unsigned* bar, volatile LAS unsigned* st, int wave) {
    XcdBarrier b; b.bar = bar; b.x = xb_xcc_id(); b.st = st; b.wave = wave;
    if (threadIdx.x == 0) (void)xb_add(&bar[XB_XCNT(b.x)], 1u);
    return b;
}
__device__ __forceinline__ void xcd_barrier_complete(unsigned* bar, unsigned x, unsigned& nloc, unsigned& nx) {
    const unsigned G = gridDim.x * gridDim.y * gridDim.z;
    unsigned sum, cnt, mine, sp = 0u;
    for (;;) {
        sum = 0u; cnt = 0u; mine = 0u;
#pragma unroll
        for (unsigned j = 0; j < 16; ++j) { const unsigned c = xb_ld(&bar[XB_XCNT(j)]); sum += c; cnt += (c > 0u) ? 1u : 0u; mine = (j == x) ? c : mine; }
        if (sum == G) break;
        __builtin_amdgcn_s_sleep(1);
        if ((++sp & 255u) == 0u) { if (xb_ld(&bar[XB_TMO])) break; if (sp > XB_SPIN_CAP) { atomicAdd(&bar[XB_TMO], 1u); break; } }
    }
    nloc = mine > 0u ? mine : 1u; nx = cnt > 0u ? cnt : 1u;
}
__device__ __forceinline__ void xcd_barrier(const XcdBarrier& b) {
    asm volatile("s_waitcnt vmcnt(0)" ::: "memory");
    __syncthreads();
    if (b.wave == 0 && lane_id_asm() == 0) {
        unsigned* bar = b.bar; asm volatile("" : "+s"(bar));
        __builtin_amdgcn_s_waitcnt(0);
        unsigned nloc = b.st[0], nx = b.st[1];
        if (nloc == 0u) { xcd_barrier_complete(bar, b.x, nloc, nx); b.st[0] = nloc; b.st[1] = nx; }
        const unsigned old = xb_add(&bar[XB_XSUB(b.x)], 1u);
        const unsigned gen = old / nloc;
        if (old + 1u == (gen + 1u) * nloc) {
            __builtin_amdgcn_fence(__ATOMIC_RELEASE, "agent");
            asm volatile("s_waitcnt vmcnt(0)" ::: "memory");
            const unsigned og = xb_add(&bar[XB_TOP], 1u);
            const unsigned tg = og / nx;
            if (og + 1u == (tg + 1u) * nx) xb_add(&bar[XB_TOPGEN], 1u);
            else XB_SPIN(xb_ld(&bar[XB_TOPGEN]) == tg, bar);
            __builtin_amdgcn_fence(__ATOMIC_ACQUIRE, "agent");
            xb_add(&bar[XB_XGEN(b.x)], 1u);
            asm volatile("s_waitcnt vmcnt(0)" ::: "memory");
        } else {
            XB_SPIN(xb_ld(&bar[XB_XGEN(b.x)]) == gen, bar);
            __builtin_amdgcn_fence(__ATOMIC_ACQUIRE, "agent");
            asm volatile("s_waitcnt vmcnt(0)" ::: "memory");
        }
    }
    __syncthreads();
}

constexpr int W8_GU_SH = 4, W8_DN_SH = 5;
typedef int v8i_t __attribute__((ext_vector_type(8)));
typedef int u32x4i __attribute__((ext_vector_type(4)));
__device__ __forceinline__ unsigned pk4_fp8(float a, float b, float c, float d) { int w = __builtin_amdgcn_cvt_pk_fp8_f32(a, b, 0, false); w = __builtin_amdgcn_cvt_pk_fp8_f32(c, d, w, true); return (unsigned)w; }
namespace pg8 {
constexpr int BM = 256, BK = 64, HALF = 128, HTB = HALF * BK * 2, STAGE_BYTES = 8 * HTB, NXCD = 8, WGM = 8;
__device__ __forceinline__ int lds_byte(int r, int c) { const int st = (r >> 4) * 2 + (c >> 5), rr = r & 15, cc = c & 31, ob = rr * 64 + cc * 2; return st * 1024 + (ob ^ (((ob >> 9) & 1) << 5)); }
__device__ __forceinline__ void stage_rc(int b, int& R, int& C) { const int st = b / 1024, sb = b % 1024, swz = sb ^ (((sb >> 9) & 1) << 5); R = (st >> 1) * 16 + swz / 64; C = (st & 1) * 32 + (swz % 64) / 2; }
__device__ __forceinline__ int perm32(int rho) { const int n = rho >> 4, i = rho & 15; return 8 * (i >> 2) + 4 * n + (i & 3); }
struct Unit { int pm, pn, e; };
struct Gemm { const bf16_t* A; int lda; const int* rowmap; const bf16_t* Bt; int ldb; size_t strideB; int K; int asplit = 1 << 30, aoff = 0; };
struct Sched {
    int nM, nN, nwg, G, c; const LAS int* tile_e;
    __device__ __forceinline__ void init(int nM_, int nN_, int G_, int c_, const LAS int* tile_e_) { nM = nM_; nN = nN_; nwg = nM * nN; G = G_; c = c_; tile_e = tile_e_; }
    __device__ __forceinline__ bool next(int i, Unit& u) const {
        const int L = i * G + c; if (L >= nwg) return false;
        int wgid = L; { const int q = nwg / NXCD, r = nwg % NXCD, xcd = wgid % NXCD, off = wgid / NXCD; wgid = (xcd < r ? xcd * (q + 1) : r * (q + 1) + (xcd - r) * q) + off; }
        const int nig = WGM * nN, gid = wgid / nig, fm = gid * WGM, gsz = (nM - fm) < WGM ? (nM - fm) : WGM;
        u.pm = fm + ((wgid % nig) % gsz); u.pn = (wgid % nig) / gsz; u.e = 0;
        if (tile_e) u.e = __builtin_amdgcn_readfirstlane(tile_e[u.pm]);
        return true;
    }
};
__device__ __forceinline__ unsigned cvt_pk_bf16(float lo, float hi) { unsigned r; asm volatile("v_cvt_pk_bf16_f32 %0, %1, %2" : "=v"(r) : "v"(lo), "v"(hi)); return r; }
__device__ __forceinline__ u32x4 pack8(const f32x4 a, const f32x4 b) { u32x4 w; w.x = cvt_pk_bf16(a[0], a[1]); w.y = cvt_pk_bf16(a[2], a[3]); w.z = cvt_pk_bf16(b[0], b[1]); w.w = cvt_pk_bf16(b[2], b[3]); return w; }
typedef float f32x2 __attribute__((ext_vector_type(2)));
typedef unsigned u32x2 __attribute__((ext_vector_type(2)));
__device__ __forceinline__ f32x2 gelu_pk(f32x2 v) {
    const f32x2 av = __builtin_elementwise_abs(v), d = av * 0.2316418882f + 1.0f;
    f32x2 t; t.x = __builtin_amdgcn_rcpf(d.x); t.y = __builtin_amdgcn_rcpf(d.y);
    f32x2 q = t * 0.5307027145f + (-0.7265760135f); q = q * t + 0.7107068705f; q = q * t + (-0.142248368f); q = q * t + 0.127414796f; q = q * t;
    const f32x2 s = (v * v) * (-0.72134752044f);
    f32x2 e; e.x = __builtin_amdgcn_exp2f(s.x); e.y = __builtin_amdgcn_exp2f(s.y);
    const f32x2 m = v * (q * e), r = v - m;
    f32x2 o; o.x = v.x < 0.f ? m.x : r.x; o.y = v.y < 0.f ? m.y : r.y; return o;
}
__device__ __forceinline__ f32x4 gelu4(const f32x4 v) { const f32x2 a = gelu_pk((f32x2){v[0], v[1]}), b = gelu_pk((f32x2){v[2], v[3]}); return (f32x4){a.x, a.y, b.x, b.y}; }
__device__ __forceinline__ float fsig(float x) { return __builtin_amdgcn_rcpf(1.0f + __builtin_amdgcn_exp2f(-1.4426950408889634f * x)); }

#define EPI_ROWS for (int ai = 0; ai < 2; ++ai) _Pragma("unroll") for (int m = 0; m < 4; ++m)

struct EpiE1 {
    static constexpr bool LDS_BIAS = false;
    bf16_t *BG, *CX, *GZU, *GZV;
    __device__ __forceinline__ void operator()(const f32x4 (&acc)[2][2][4][2], const Unit& u, int wr, int wc, int fr, int fq) const {
        const int row0 = u.pm * BM + wr * 64 + fr, cl = wc * 32 + 8 * fq, t = u.pn;
        if (t < 2) {
#pragma unroll
            EPI_ROWS { bf16_t* rp = BG + (size_t)(row0 + ai * HALF + m * 16) * 512 + t * 256 + cl;
#pragma unroll
                for (int bj = 0; bj < 2; ++bj) *(u32x4*)(rp + bj * HALF) = pack8(acc[ai][bj][m][0], acc[ai][bj][m][1]); }
        } else if (t < 6) {
#pragma unroll
            EPI_ROWS { bf16_t* rp = CX + (size_t)(row0 + ai * HALF + m * 16) * 512 + (t - 2) * 128 + cl;
                *(u32x4*)rp = pack8(acc[ai][0][m][0] * acc[ai][1][m][0], acc[ai][0][m][1] * acc[ai][1][m][1]); }
        } else {
            bf16_t* O = t < 8 ? GZU : GZV; const int tc = (t & 1) * 256 + cl;
#pragma unroll
            EPI_ROWS { bf16_t* rp = O + (size_t)(row0 + ai * HALF + m * 16) * 512 + tc;
#pragma unroll
                for (int bj = 0; bj < 2; ++bj) *(u32x4*)(rp + bj * HALF) = pack8(gelu4(acc[ai][bj][m][0]), gelu4(acc[ai][bj][m][1])); }
        }
    }
};
struct EpiO1 {
    static constexpr bool LDS_BIAS = false;
    bf16_t *GLU, *CQKV, *KRR;
    __device__ __forceinline__ void operator()(const f32x4 (&acc)[2][2][4][2], const Unit& u, int wr, int wc, int fr, int fq) const {
        const int row0 = u.pm * BM + wr * 64 + fr, cl = wc * 32 + 8 * fq, t = u.pn;
        if (t < 4) {
#pragma unroll
            EPI_ROWS { bf16_t* rp = GLU + (size_t)(row0 + ai * HALF + m * 16) * 512 + t * 128 + cl; f32x4 o[2];
#pragma unroll
                for (int n = 0; n < 2; ++n) {
                    const f32x4 ga = acc[ai][0][m][n], tb = acc[ai][1][m][n] * (-1.4426950408889634f);
                    f32x4 e; e[0] = __builtin_amdgcn_exp2f(tb[0]); e[1] = __builtin_amdgcn_exp2f(tb[1]); e[2] = __builtin_amdgcn_exp2f(tb[2]); e[3] = __builtin_amdgcn_exp2f(tb[3]);
                    const f32x4 d = e + 1.0f;
                    f32x4 r; r[0] = __builtin_amdgcn_rcpf(d[0]); r[1] = __builtin_amdgcn_rcpf(d[1]); r[2] = __builtin_amdgcn_rcpf(d[2]); r[3] = __builtin_amdgcn_rcpf(d[3]);
                    o[n] = ga * r; }
                *(u32x4*)rp = pack8(o[0], o[1]); }
        } else if (t == 4) {
#pragma unroll
            EPI_ROWS { bf16_t* rp = CQKV + (size_t)(row0 + ai * HALF + m * 16) * 384 + cl;
#pragma unroll
                for (int bj = 0; bj < 2; ++bj) *(u32x4*)(rp + bj * HALF) = pack8(acc[ai][bj][m][0], acc[ai][bj][m][1]); }
        } else {
#pragma unroll
            EPI_ROWS { const size_t r = (size_t)(row0 + ai * HALF + m * 16);
                *(u32x4*)(CQKV + r * 384 + 256 + cl) = pack8(acc[ai][0][m][0], acc[ai][0][m][1]);
                if (wc == 0) *(u32x4*)(KRR + r * 32 + 8 * fq) = pack8(acc[ai][1][m][0], acc[ai][1][m][1]); }
        }
    }
};
struct EpiO3 {
    static constexpr bool LDS_BIAS = false;
    bf16_t *Q, *KN, *VV; const float* CS;
    __device__ __forceinline__ void operator()(const f32x4 (&acc)[2][2][4][2], const Unit& u, int wr, int wc, int fr, int fq) const {
        const int row0 = u.pm * BM + wr * 64 + fr, cl = wc * 32 + 8 * fq, t = u.pn;
        if (t < 3) {
#pragma unroll
            for (int bj = 0; bj < 2; ++bj) { const int c0 = t * 256 + bj * HALF + cl, h = c0 / 96, d0 = c0 - 96 * h;
                if (d0 < 64) {
#pragma unroll
                    EPI_ROWS *(u32x4*)(Q + (size_t)(row0 + ai * HALF + m * 16) * 768 + c0) = pack8(acc[ai][bj][m][0] * QSCALE, acc[ai][bj][m][1] * QSCALE);
                } else { const int i0 = (d0 - 64) >> 1;
#pragma unroll
                    EPI_ROWS { const size_t r = (size_t)(row0 + ai * HALF + m * 16); const f32x4 cs = *(const f32x4*)(CS + r * 32 + i0), sn = *(const f32x4*)(CS + r * 32 + 16 + i0);
                        const f32x4 a = acc[ai][bj][m][0], b = acc[ai][bj][m][1]; f32x4 o0, o1;
                        o0[0] = (a[0] * cs[0] - a[1] * sn[0]) * QSCALE; o0[1] = (a[1] * cs[0] + a[0] * sn[0]) * QSCALE; o0[2] = (a[2] * cs[1] - a[3] * sn[1]) * QSCALE; o0[3] = (a[3] * cs[1] + a[2] * sn[1]) * QSCALE;
                        o1[0] = (b[0] * cs[2] - b[1] * sn[2]) * QSCALE; o1[1] = (b[1] * cs[2] + b[0] * sn[2]) * QSCALE; o1[2] = (b[2] * cs[3] - b[3] * sn[3]) * QSCALE; o1[3] = (b[3] * cs[3] + b[2] * sn[3]) * QSCALE;
                        *(u32x4*)(Q + r * 768 + c0) = pack8(o0, o1); }
                } }
        } else {
            bf16_t* O = t < 5 ? KN : VV; const int tc = ((t - 3) & 1) * 256 + cl;
#pragma unroll
            EPI_ROWS { bf16_t* rp = O + (size_t)(row0 + ai * HALF + m * 16) * 512 + tc;
#pragma unroll
                for (int bj = 0; bj < 2; ++bj) *(u32x4*)(rp + bj * HALF) = pack8(acc[ai][bj][m][0], acc[ai][bj][m][1]); }
        }
    }
};
template <bool XF32> struct EpiOut {
    static constexpr bool LDS_BIAS = false;
    const void* xres; const float* gate; bf16_t* V;
    __device__ __forceinline__ void operator()(const f32x4 (&acc)[2][2][4][2], const Unit& u, int wr, int wc, int fr, int fq) const {
        const int row0 = u.pm * BM + wr * 64 + fr, b = (u.pm * BM) / SEQ;
        f32x4 g[2][2];
#pragma unroll
        for (int bj = 0; bj < 2; ++bj)
#pragma unroll
            for (int n = 0; n < 2; ++n) g[bj][n] = *(const f32x4*)(gate + (size_t)b * 6 * DM + u.pn * BM + bj * HALF + wc * 32 + 8 * fq + 4 * n) + 1.0f;
        const size_t cb = (size_t)u.pn * BM + wc * 32 + 8 * fq;
        if constexpr (!XF32) {
#pragma unroll
            for (int ai = 0; ai < 2; ++ai) {
                u32x4 xb[4][2];
#pragma unroll
                for (int m = 0; m < 4; ++m)
#pragma unroll
                    for (int bj = 0; bj < 2; ++bj) xb[m][bj] = *(const u32x4*)((const bf16_t*)xres + (size_t)(row0 + ai * HALF + m * 16) * DM + cb + bj * HALF);
#pragma unroll
                for (int m = 0; m < 4; ++m)
#pragma unroll
                    for (int bj = 0; bj < 2; ++bj) { const u32x4 t = xb[m][bj];
                        const f32x4 x0 = (f32x4){__uint_as_float(t.x << 16), __uint_as_float(t.x & 0xffff0000u), __uint_as_float(t.y << 16), __uint_as_float(t.y & 0xffff0000u)};
                        const f32x4 x1 = (f32x4){__uint_as_float(t.z << 16), __uint_as_float(t.z & 0xffff0000u), __uint_as_float(t.w << 16), __uint_as_float(t.w & 0xffff0000u)};
                        *(u32x4*)(V + (size_t)(row0 + ai * HALF + m * 16) * DM + cb + bj * HALF) = pack8(x0 * ALPHA + g[bj][0] * acc[ai][bj][m][0], x1 * ALPHA + g[bj][1] * acc[ai][bj][m][1]); }
            }
        } else {
#pragma unroll
            for (int ai = 0; ai < 2; ++ai)
#pragma unroll
                for (int mh = 0; mh < 2; ++mh) {
                    f32x4 xf[2][2][2];
#pragma unroll
                    for (int m2 = 0; m2 < 2; ++m2)
#pragma unroll
                        for (int bj = 0; bj < 2; ++bj) { const float* xp = (const float*)xres + (size_t)(row0 + ai * HALF + (2 * mh + m2) * 16) * DM + cb + bj * HALF; xf[m2][bj][0] = *(const f32x4*)xp; xf[m2][bj][1] = *(const f32x4*)(xp + 4); }
#pragma unroll
                    for (int m2 = 0; m2 < 2; ++m2)
#pragma unroll
                        for (int bj = 0; bj < 2; ++bj) { const int m = 2 * mh + m2;
                            *(u32x4*)(V + (size_t)(row0 + ai * HALF + m * 16) * DM + cb + bj * HALF) = pack8(xf[m2][bj][0] * ALPHA + g[bj][0] * acc[ai][bj][m][0], xf[m2][bj][1] * ALPHA + g[bj][1] * acc[ai][bj][m][1]); }
                }
        }
    }
};
struct EpiM1 {
    const float* bgu; unsigned char* H; LAS unsigned char* lds;
    static constexpr bool LDS_BIAS = true;
    __device__ __forceinline__ const float* bias_src(const Unit& u, int lane) const { return bgu + (size_t)u.e * 2048 + (lane >> 5) * 1024 + u.pn * 128 + (lane & 31) * 4; }
    static __device__ __forceinline__ f32x2 act2(f32x2 g, f32x2 u) {
        f32x2 gg, uu; gg.x = fminf(g.x, 7.0f); gg.y = fminf(g.y, 7.0f); uu.x = __builtin_amdgcn_fmed3f(u.x, -6.0f, 8.0f); uu.y = __builtin_amdgcn_fmed3f(u.y, -6.0f, 8.0f);
        const f32x2 t = gg * (-1.702f * 1.4426950408889634f);
        f32x2 e; e.x = __builtin_amdgcn_exp2f(t.x); e.y = __builtin_amdgcn_exp2f(t.y);
        const f32x2 d = e + 1.0f;
        f32x2 r; r.x = __builtin_amdgcn_rcpf(d.x); r.y = __builtin_amdgcn_rcpf(d.y);
        return (uu * gg) * r;
    }
    __device__ __forceinline__ void operator()(const f32x4 (&acc)[2][2][4][2], const Unit& u, int wr, int wc, int fr, int fq) const {
        const int row0 = u.pm * BM + wr * 64 + fr, col = u.pn * 128 + wc * 32 + 8 * fq;
        const LAS float* bp = (const LAS float*)(lds + BIASSLOT_OFF) + wc * 32 + 8 * fq;
        f32x4 bg[2], bu[2];
#pragma unroll
        for (int n = 0; n < 2; ++n) { bg[n] = *(const LAS f32x4*)(bp + 4 * n); bu[n] = *(const LAS f32x4*)(bp + 128 + 4 * n) + 1.0f; }
#pragma unroll
        EPI_ROWS { f32x2 o[2][2];
#pragma unroll
            for (int n = 0; n < 2; ++n) { const f32x4 gv = acc[ai][0][m][n] + bg[n], uv = acc[ai][1][m][n] + bu[n];
                o[n][0] = act2((f32x2){gv[0], gv[1]}, (f32x2){uv[0], uv[1]}); o[n][1] = act2((f32x2){gv[2], gv[3]}, (f32x2){uv[2], uv[3]}); }
            u32x2 w; w.x = pk4_fp8(o[0][0].x, o[0][0].y, o[0][1].x, o[0][1].y); w.y = pk4_fp8(o[1][0].x, o[1][0].y, o[1][1].x, o[1][1].y);
            *(u32x2*)(H + (size_t)(row0 + ai * HALF + m * 16) * DM + col) = w; }
    }
};
struct EpiM2 {
    const float* bdn; unsigned char* YS; LAS unsigned char* lds;
    static constexpr bool LDS_BIAS = true;
    __device__ __forceinline__ const float* bias_src(const Unit& u, int lane) const { return bdn + (size_t)u.e * DM + u.pn * BM + lane * 4; }
    __device__ __forceinline__ void operator()(const f32x4 (&acc)[2][2][4][2], const Unit& u, int wr, int wc, int fr, int fq) const {
        const int row0 = u.pm * BM + wr * 64 + fr, col = u.pn * BM + wc * 32 + 8 * fq;
        f32x4 bv[2][2];
#pragma unroll
        for (int bj = 0; bj < 2; ++bj)
#pragma unroll
            for (int n = 0; n < 2; ++n) bv[bj][n] = *(const LAS f32x4*)((const LAS float*)(lds + BIASSLOT_OFF) + wc * 32 + 8 * fq + bj * HALF + 4 * n);
#pragma unroll
        EPI_ROWS { unsigned char* rp = YS + (size_t)(row0 + ai * HALF + m * 16) * DM + col;
#pragma unroll
            for (int bj = 0; bj < 2; ++bj) { const f32x4 a = (acc[ai][bj][m][0] + bv[bj][0]) * 16.0f, b = (acc[ai][bj][m][1] + bv[bj][1]) * 16.0f;
                u32x2 w; w.x = pk4_fp8(a[0], a[1], a[2], a[3]); w.y = pk4_fp8(b[0], b[1], b[2], b[3]); *(u32x2*)(rp + bj * HALF) = w; } }
    }
};

template <class Epi, int F8SCALE = -1>
__device__ __forceinline__ void gemm_phase(LAS unsigned char* lds, const int wave_id, const Gemm g, const Sched& S, const Epi& E) {
    const int lane = lane_id_asm();
    const int wid = wave_id, wr = wid >> 2, wc = wid & 3, fr = lane & 15, fq = lane >> 4;
    const int K = g.K, nt = K / BK;
    const int swz = (lane * 16) ^ ((((lane * 16) >> 9) & 1) << 5);
#define PG8_STR(i) ((((wid + 8 * (i)) >> 1) * 16) + (swz >> 6))
#define PG8_STC ((wid & 1) * 32 + ((swz & 63) >> 1))
    unsigned voffB[2];
#pragma unroll
    for (int i = 0; i < 2; ++i) { const int R = PG8_STR(i), Rb = (R & ~31) + perm32(R & 31); voffB[i] = (unsigned)(Rb * g.ldb + PG8_STC) * 2u; }
    const size_t kstep = (size_t)(BK * 2);
    const size_t hstepB = (size_t)HALF * g.ldb * 2;
    const unsigned ldsw = (unsigned)wid * 1024u;
    const int aoff = lds_byte(wr * 64 + fr, fq * 8), boff = lds_byte(wc * 32 + fr, fq * 8);
    const char* const abase = (const char*)g.A;
#define PG8_SA(b, h) (((b) * 2 + (h)) * HTB)
#define PG8_SB(b, h) ((4 + (b) * 2 + (h)) * HTB)
#define PG8_STAGEB(bufoff, gbase) do { _Pragma("unroll") for (int _i = 0; _i < 2; ++_i) \
        __builtin_amdgcn_global_load_lds((const unsigned*)((const char*)(gbase) + voffB[_i]), (LAS unsigned*)(lds + (bufoff) + ldsw + _i * 8192), 16, 0, 0); } while (0)
#define PG8_STAGEA(bufoff, koff, VO, h) do { _Pragma("unroll") for (int _i = 0; _i < 2; ++_i) \
        __builtin_amdgcn_global_load_lds((const unsigned*)(abase + (size_t)(koff) + (VO)[h][_i]), (LAS unsigned*)(lds + (bufoff) + ldsw + _i * 8192), 16, 0, 0); } while (0)
#define PG8_LDA(dst, b, h) do { _Pragma("unroll") for (int m = 0; m < 4; ++m) _Pragma("unroll") for (int k = 0; k < 2; ++k) dst[m][k] = *(const LAS bf16x8*)(lds + PG8_SA(b, h) + aoff + m * 2048 + k * 1024); } while (0)
#define PG8_LDB(dst, b, h) do { _Pragma("unroll") for (int n = 0; n < 2; ++n) _Pragma("unroll") for (int k = 0; k < 2; ++k) dst[n][k] = *(const LAS bf16x8*)(lds + PG8_SB(b, h) + boff + n * 2048 + k * 1024); } while (0)
#define PG8_MMA(ai, bj, At, Bt) do { __builtin_amdgcn_s_setprio(1); \
        if constexpr (F8SCALE < 0) { _Pragma("unroll") for (int m = 0; m < 4; ++m) _Pragma("unroll") for (int n = 0; n < 2; ++n) _Pragma("unroll") for (int k = 0; k < 2; ++k) \
            acc[ai][bj][m][n] = __builtin_amdgcn_mfma_f32_16x16x32_bf16(Bt[n][k], At[m][k], acc[ai][bj][m][n], 0, 0, 0); } \
        else { _Pragma("unroll") for (int m = 0; m < 4; ++m) _Pragma("unroll") for (int n = 0; n < 2; ++n) { \
            const v8i_t _b8 = __builtin_shufflevector(__builtin_bit_cast(u32x4i, Bt[n][0]), __builtin_bit_cast(u32x4i, Bt[n][1]), 0, 1, 2, 3, 4, 5, 6, 7); \
            const v8i_t _a8 = __builtin_shufflevector(__builtin_bit_cast(u32x4i, At[m][0]), __builtin_bit_cast(u32x4i, At[m][1]), 0, 1, 2, 3, 4, 5, 6, 7); \
            acc[ai][bj][m][n] = __builtin_amdgcn_mfma_scale_f32_16x16x128_f8f6f4(_b8, _a8, acc[ai][bj][m][n], 0, 0, 0, f8_sb, 0, f8_sa); } \
            _Pragma("unroll") for (int m = 0; m < 4; ++m) _Pragma("unroll") for (int n = 0; n < 2; ++n) asm volatile("" : "+v"(acc[ai][bj][m][n])); }     \
        __builtin_amdgcn_s_setprio(0); } while (0)
#define PG8_WAIT_V(n) asm volatile("s_waitcnt vmcnt(" #n ")" ::: "memory")
#define PG8_WAIT_L(n) asm volatile("s_waitcnt lgkmcnt(" #n ")" ::: "memory")
#define PG8_BAR __builtin_amdgcn_s_barrier()
#define PG8_SCHED __builtin_amdgcn_sched_barrier(0)
#define PG8_LOADROWS(U, RW) do { _Pragma("unroll") for (int _h = 0; _h < 2; ++_h) _Pragma("unroll") for (int _i = 0; _i < 2; ++_i) { const int _row = (U).pm * BM + _h * HALF + PG8_STR(_i); \
        (RW)[_h][_i] = g.rowmap ? ((const __attribute__((address_space(1))) int*)g.rowmap)[_row] : _row; } } while (0)
#define PG8_ROWS2OFF(U, RW, VO) do { const int _ao = (U).pn >= g.asplit ? g.aoff : 0; _Pragma("unroll") for (int _h = 0; _h < 2; ++_h) _Pragma("unroll") for (int _i = 0; _i < 2; ++_i) (VO)[_h][_i] = (unsigned)((RW)[_h][_i] * g.lda + _ao + PG8_STC) * 2u; } while (0)
#define PG8_CALCA(U, VO) do { int _rw[2][2]; PG8_LOADROWS(U, _rw); PG8_ROWS2OFF(U, _rw, VO); } while (0)
    int f8_sb = (F8SCALE) * 0x01010101, f8_sa = 0x7f7f7f7f; asm volatile("" : "+v"(f8_sb), "+v"(f8_sa));
    Unit cur, nxt; int ui = 0;
    if (!S.next(0, cur)) return;
    f32x4 acc[2][2][4][2];
#pragma unroll
    for (int a = 0; a < 2; ++a)
#pragma unroll
        for (int b = 0; b < 2; ++b)
#pragma unroll
            for (int m = 0; m < 4; ++m)
#pragma unroll
                for (int n = 0; n < 2; ++n) acc[a][b][m][n] = (f32x4){0.f, 0.f, 0.f, 0.f};
    bf16x8 At[4][2], B0[2][2], B1[2][2];
    unsigned voC[2][2];
    PG8_CALCA(cur, voC);
    const char* cB = (const char*)g.Bt + ((size_t)cur.e * g.strideB + (size_t)cur.pn * BM * g.ldb) * 2;
    PG8_STAGEB(PG8_SB(0, 0), cB); PG8_STAGEB(PG8_SB(0, 1), cB + hstepB); PG8_STAGEA(PG8_SA(0, 0), 0, voC, 0); PG8_STAGEA(PG8_SA(0, 1), 0, voC, 1);
    if (wr == 1) PG8_BAR;
    PG8_WAIT_V(2); PG8_BAR;
    PG8_STAGEB(PG8_SB(1, 0), cB + kstep); PG8_STAGEA(PG8_SA(1, 0), kstep, voC, 0); PG8_STAGEB(PG8_SB(1, 1), cB + hstepB + kstep);
    PG8_WAIT_V(6); PG8_BAR;
    for (;;) {
        const bool has_next = S.next(ui + 1, nxt);
        const char* nB = has_next ? (const char*)g.Bt + ((size_t)nxt.e * g.strideB + (size_t)nxt.pn * BM * g.ldb) * 2 : cB;
        int rwN[2][2];
#pragma unroll 1
        for (int t = 0; t < nt; t += 2) {
            const bool last = (t == nt - 2);
            const size_t k1 = (size_t)(t + 1) * kstep;
            const size_t k2 = last ? 0 : (size_t)(t + 2) * kstep, k3 = k2 + kstep;
            const char* b2 = last ? nB : cB + (size_t)(t + 2) * kstep; const char* b3 = b2 + kstep;
            if constexpr (Epi::LDS_BIAS) { if (t == 2 && wid == 0) { const int ln = lane_id_asm(); __builtin_amdgcn_global_load_lds((const unsigned*)E.bias_src(cur, ln), (LAS unsigned*)(lds + BIASSLOT_OFF), 16, 0, 0); } }
            if (t == nt - 4 && has_next) {
                if (g.rowmap) { if (wid == 0) __builtin_amdgcn_global_load_lds((const unsigned*)(g.rowmap + (size_t)nxt.pm * BM + lane * 4), (LAS unsigned*)(lds + ROWSLOT_OFF), 16, 0, 0); }
                else PG8_LOADROWS(nxt, rwN);
            }
            PG8_LDB(B0, 0, 0); PG8_LDB(B1, 0, 1); PG8_SCHED; PG8_LDA(At, 0, 0); PG8_STAGEA(PG8_SA(1, 1), k1, voC, 1);
            PG8_WAIT_V(8); PG8_WAIT_L(0); PG8_BAR; PG8_MMA(0, 0, At, B0); PG8_MMA(0, 1, At, B1); PG8_BAR; PG8_SCHED;
            if (last && has_next) {
                if (g.rowmap) {
#pragma unroll
                    for (int h = 0; h < 2; ++h)
#pragma unroll
                        for (int i = 0; i < 2; ++i) rwN[h][i] = *(const LAS int*)(lds + ROWSLOT_OFF + 4 * (h * HALF + PG8_STR(i)));
                }
                PG8_ROWS2OFF(nxt, rwN, voC);
            }
            PG8_LDA(At, 0, 1); PG8_STAGEB(PG8_SB(0, 0), b2); PG8_STAGEB(PG8_SB(0, 1), b2 + hstepB); PG8_STAGEA(PG8_SA(0, 0), k2, voC, 0);
            PG8_WAIT_V(8); PG8_WAIT_L(0); PG8_BAR; PG8_MMA(1, 0, At, B0); PG8_MMA(1, 1, At, B1); PG8_BAR; PG8_SCHED;
            PG8_LDB(B0, 1, 0); PG8_LDB(B1, 1, 1); PG8_SCHED; PG8_LDA(At, 1, 0); PG8_STAGEA(PG8_SA(0, 1), k2, voC, 1);
            PG8_WAIT_V(8); PG8_WAIT_L(0); PG8_BAR; PG8_MMA(0, 0, At, B0); PG8_MMA(0, 1, At, B1); PG8_BAR; PG8_SCHED;
            PG8_LDA(At, 1, 1); PG8_STAGEB(PG8_SB(1, 0), b3); PG8_STAGEB(PG8_SB(1, 1), b3 + hstepB); PG8_STAGEA(PG8_SA(1, 0), k3, voC, 0);
            PG8_WAIT_V(8); PG8_WAIT_L(0); PG8_BAR; PG8_MMA(1, 0, At, B0); PG8_MMA(1, 1, At, B1); PG8_BAR; PG8_SCHED;
        }
        if (wr == 0) PG8_BAR;
        E(acc, cur, wr, wc, fr, fq);
        if (!has_next) break;
#pragma unroll
        for (int a = 0; a < 2; ++a)
#pragma unroll
            for (int b = 0; b < 2; ++b)
#pragma unroll
                for (int m = 0; m < 4; ++m)
#pragma unroll
                    for (int n = 0; n < 2; ++n) acc[a][b][m][n] = (f32x4){0.f, 0.f, 0.f, 0.f};
        cur = nxt; cB = nB; ++ui;
        if (wr == 1) PG8_BAR;
    }
    PG8_WAIT_V(0);
    PG8_BAR;
#undef PG8_SA
#undef PG8_SB
#undef PG8_STAGEA
#undef PG8_STAGEB
#undef PG8_LDA
#undef PG8_LDB
#undef PG8_MMA
#undef PG8_WAIT_V
#undef PG8_WAIT_L
#undef PG8_BAR
#undef PG8_SCHED
#undef PG8_CALCA
#undef PG8_LOADROWS
#undef PG8_ROWS2OFF
#undef PG8_STR
#undef PG8_STC
}
}


typedef float f32x16 __attribute__((ext_vector_type(16)));
__device__ __forceinline__ float max3f_(float a, float b, float c) { float r; asm("v_max3_f32 %0, %1, %2, %3" : "=v"(r) : "v"(a), "v"(b), "v"(c)); return r; }
__device__ __forceinline__ float max2f_(float a, float b) { float r; asm("v_max_f32_e32 %0, %1, %2" : "=v"(r) : "v"(a), "v"(b)); return r; }
typedef short v4i16_t __attribute__((ext_vector_type(4)));
using pg8::u32x2;
constexpr int AT_KROW = 208, AT_KBYTES = 64 * AT_KROW, AT_VBYTES = 8192, AT_BUF = AT_KBYTES + AT_VBYTES;
__device__ __forceinline__ void attn_phase(LAS unsigned char* lds, const int wave, const int lane, const int bx, const int G,
                                           const bf16_t* __restrict__ Q, const bf16_t* __restrict__ KN, const bf16_t* __restrict__ KR, const bf16_t* __restrict__ VV, bf16_t* __restrict__ Y) {
    const int hi = lane >> 5, r32 = lane & 31, tid = wave * 64 + lane;
    const int g1 = (lane >> 4) & 1, i16 = lane & 15, tq = i16 >> 2, tp = i16 & 3;
    const int vlane_off = (4 * hi + tq) * 64 + (16 * g1 + 4 * tp) * 2;
    const int vbx = (G % 8 == 0) ? (bx % 8) * (G / 8) + bx / 8 : bx;
    for (int pidx = vbx; pidx < 512; pidx += G) {
#pragma unroll 1
        for (int jj = 0; jj < 2; ++jj) {
            const int bh = pidx >> 3, x = pidx & 7, qb = jj ? 15 - x : x, b = bh >> 3, h = bh & 7;
            const size_t tb = (size_t)b * SEQ;
            const int q0 = qb * 256 + wave * 32;
            const bf16_t* kn = KN + tb * 512 + h * 64; const bf16_t* kr = KR + tb * 32; const bf16_t* vv = VV + tb * 512 + h * 64;
            bf16x8 qf[6];
#pragma unroll
            for (int s = 0; s < 6; ++s) qf[s] = *(const bf16x8*)(Q + (tb + q0 + r32) * 768 + h * 96 + 16 * s + 8 * hi);
            f32x16 o0, o1;
#pragma unroll
            for (int r = 0; r < 16; ++r) { o0[r] = 0.f; o1[r] = 0.f; }
            float mrow = 0.f, lsum = 0.f;
            const int nt = 4 * (qb + 1);
            u32x4 pfa[3], pfb[3];
            bf16x8 pb[2][2];
            const unsigned offKV = (unsigned)((tid >> 3) * 512 + (tid & 7) * 8) * 2u, offKR = (unsigned)((tid >> 2) * 32 + (tid & 3) * 8) * 2u;
            const unsigned ldsK = (unsigned)((tid >> 3) * AT_KROW + (tid & 7) * 16), ldsR = (unsigned)((tid >> 2) * AT_KROW + 128 + (tid & 3) * 16), ldsV = (unsigned)(((tid & 7) >> 2) * 4096 + (tid >> 3) * 64 + (tid & 3) * 16);
            typedef const __attribute__((address_space(1))) unsigned char* gcp_t; typedef const __attribute__((address_space(1))) u32x4* gv4_t;
#define AT_LOAD(kt, pf) do { const size_t _k0 = (size_t)(kt) * 64; \
                pf[0] = *(gv4_t)((gcp_t)(kn + _k0 * 512) + offKV); pf[1] = *(gv4_t)((gcp_t)(vv + _k0 * 512) + offKV); \
                if (tid < 256) pf[2] = *(gv4_t)((gcp_t)(kr + _k0 * 32) + offKR); } while (0)
#define AT_STORE(par, pf) do { LAS unsigned char* _kb = lds + (par) * AT_KBYTES; LAS unsigned char* _vb = lds + 2 * AT_KBYTES + (par) * AT_VBYTES; \
                *(LAS u32x4*)(_kb + ldsK) = pf[0]; *(LAS u32x4*)(_vb + ldsV) = pf[1]; if (tid < 256) *(LAS u32x4*)(_kb + ldsR) = pf[2]; } while (0)
#define AT_PV(vbuf) do { LAS unsigned char* vlane = lds + 2 * AT_KBYTES + (vbuf) * AT_VBYTES + vlane_off; \
                bf16x8 vf[2][2][2]; \
                _Pragma("unroll") for (int kb2 = 0; kb2 < 2; ++kb2) _Pragma("unroll") for (int s2 = 0; s2 < 2; ++s2) _Pragma("unroll") for (int db = 0; db < 2; ++db) { \
                    LAS unsigned char* va = vlane + db * 4096 + (32 * kb2 + 16 * s2) * 64; \
                    const v4i16_t lo = __builtin_amdgcn_ds_read_tr16_b64_v4i16((LAS v4i16_t*)va); \
                    const v4i16_t hh = __builtin_amdgcn_ds_read_tr16_b64_v4i16((LAS v4i16_t*)(va + 8 * 64)); \
                    vf[kb2][s2][db] = (bf16x8){lo[0], lo[1], lo[2], lo[3], hh[0], hh[1], hh[2], hh[3]}; } \
                __builtin_amdgcn_sched_barrier(0); \
                _Pragma("unroll") for (int kb2 = 0; kb2 < 2; ++kb2) _Pragma("unroll") for (int s2 = 0; s2 < 2; ++s2) { \
                    o0 = __builtin_amdgcn_mfma_f32_32x32x16_bf16(vf[kb2][s2][0], pb[kb2][s2], o0, 0, 0, 0); \
                    o1 = __builtin_amdgcn_mfma_f32_32x32x16_bf16(vf[kb2][s2][1], pb[kb2][s2], o1, 0, 0, 0); } } while (0)
#define AT_ITER(KT, PAR, PFL, PFS) do { const int kt = (KT); \
                if (kt + 2 < nt) AT_LOAD(kt + 2, PFL); \
                const int kbase = kt * 64; \
                if (kbase <= q0 + 31) { \
                    LAS unsigned char* kb = lds + (PAR) * AT_KBYTES; \
                    f32x16 p0, p1; \
                _Pragma("unroll") \
                    for (int r = 0; r < 16; ++r) { p0[r] = -mrow; p1[r] = -mrow; } \
                _Pragma("unroll") \
                    for (int s = 0; s < 6; ++s) { \
                        const bf16x8 k0 = *(const LAS bf16x8*)(kb + r32 * AT_KROW + (16 * s + 8 * hi) * 2); \
                        const bf16x8 k1 = *(const LAS bf16x8*)(kb + (32 + r32) * AT_KROW + (16 * s + 8 * hi) * 2); \
                        p0 = __builtin_amdgcn_mfma_f32_32x32x16_bf16(k0, qf[s], p0, 0, 0, 0); \
                        p1 = __builtin_amdgcn_mfma_f32_32x32x16_bf16(k1, qf[s], p1, 0, 0, 0); \
                    } \
                    if (kbase + 63 > q0) { \
                        const int qrel = q0 + r32 - kbase - 4 * hi; \
                _Pragma("unroll") \
                        for (int r = 0; r < 16; ++r) { if ((r & 3) + 8 * (r >> 2) > qrel) p0[r] = -INFINITY; if ((r & 3) + 8 * (r >> 2) + 32 > qrel) p1[r] = -INFINITY; } \
                    } \
                    float mxa = max3f_(p0[0], p0[1], p1[0]), mxb = max3f_(p0[2], p0[3], p1[1]); mxa = max3f_(mxa, p1[2], p1[3]); \
                _Pragma("unroll") \
                    for (int r = 4; r < 16; r += 4) { mxa = max3f_(mxa, p0[r], p0[r + 1]); mxb = max3f_(mxb, p0[r + 2], p0[r + 3]); mxa = max3f_(mxa, p1[r], p1[r + 1]); mxb = max3f_(mxb, p1[r + 2], p1[r + 3]); } \
                    float mx = max2f_(mxa, mxb); \
                    mx = max2f_(mx, shfl_xor_l(mx, 32, lane)); \
                    if (__builtin_amdgcn_ballot_w64(mx > 0.f) != 0ull) { \
                        const float d = max2f_(mx, 0.f), sc = __builtin_amdgcn_exp2f(-d); \
                        lsum *= sc; \
                _Pragma("unroll") \
                        for (int r = 0; r < 16; ++r) { o0[r] *= sc; o1[r] *= sc; p0[r] -= d; p1[r] -= d; } \
                        mrow += d; \
                    } \
                    float ps = 0.f; \
                _Pragma("unroll") \
                    for (int r = 0; r < 16; ++r) { p0[r] = __builtin_amdgcn_exp2f(p0[r]); p1[r] = __builtin_amdgcn_exp2f(p1[r]); ps += p0[r] + p1[r]; } \
                    lsum += ps; \
                _Pragma("unroll") \
                    for (int s2 = 0; s2 < 2; ++s2) { \
                        u32x4 w0, w1; \
                        w0.x = pg8::cvt_pk_bf16(p0[8 * s2 + 0], p0[8 * s2 + 1]); w0.y = pg8::cvt_pk_bf16(p0[8 * s2 + 2], p0[8 * s2 + 3]); w0.z = pg8::cvt_pk_bf16(p0[8 * s2 + 4], p0[8 * s2 + 5]); w0.w = pg8::cvt_pk_bf16(p0[8 * s2 + 6], p0[8 * s2 + 7]); \
                        w1.x = pg8::cvt_pk_bf16(p1[8 * s2 + 0], p1[8 * s2 + 1]); w1.y = pg8::cvt_pk_bf16(p1[8 * s2 + 2], p1[8 * s2 + 3]); w1.z = pg8::cvt_pk_bf16(p1[8 * s2 + 4], p1[8 * s2 + 5]); w1.w = pg8::cvt_pk_bf16(p1[8 * s2 + 6], p1[8 * s2 + 7]); \
                        pb[0][s2] = __builtin_bit_cast(bf16x8, w0); pb[1][s2] = __builtin_bit_cast(bf16x8, w1); \
                    } \
                    AT_PV(PAR); \
                } \
                if (kt + 1 < nt) AT_STORE(1 - (PAR), PFS); \
                asm volatile("s_waitcnt lgkmcnt(0)\n\ts_barrier" ::: "memory");     \
            } while (0)
            AT_LOAD(0, pfa);
            AT_STORE(0, pfa);
            AT_LOAD(1, pfb);
            __syncthreads();
            for (int kt2 = 0; kt2 < nt; kt2 += 2) { AT_ITER(kt2, 0, pfa, pfb); AT_ITER(kt2 + 1, 1, pfb, pfa); }
#undef AT_ITER
            __syncthreads();
#undef AT_LOAD
#undef AT_STORE
#undef AT_PV
            const float inv = 1.0f / (lsum + shfl_xor_l(lsum, 32, lane));
            bf16_t* yrow = Y + (tb + q0 + r32) * DM + 512 + h * 64 + 4 * hi;
#pragma unroll
            for (int g4 = 0; g4 < 4; ++g4) {
                u32x2 w; w.x = pg8::cvt_pk_bf16(o0[4 * g4] * inv, o0[4 * g4 + 1] * inv); w.y = pg8::cvt_pk_bf16(o0[4 * g4 + 2] * inv, o0[4 * g4 + 3] * inv);
                *(u32x2*)(yrow + 8 * g4) = w;
                u32x2 w2; w2.x = pg8::cvt_pk_bf16(o1[4 * g4] * inv, o1[4 * g4 + 1] * inv); w2.y = pg8::cvt_pk_bf16(o1[4 * g4 + 2] * inv, o1[4 * g4 + 3] * inv);
                *(u32x2*)(yrow + 32 + 8 * g4) = w2;
            }
        }
    }
}

__device__ __forceinline__ void even_mix_phase(LAS unsigned char* lds, const int wave, const int lane, const int bx, const int G,
                                               const bf16_t* __restrict__ BG, const bf16_t* __restrict__ CX, const bf16_t* __restrict__ GZU, const bf16_t* __restrict__ GZV, const bf16_t* __restrict__ SGW,
                                               const float* __restrict__ conv_w, const float* __restrict__ sg_b, const float* __restrict__ vn_g, const float* __restrict__ vn_b, bf16_t* __restrict__ Y) {
    const int hi = lane >> 5, r32 = lane & 31;
    for (int chunk = bx; chunk < NT / 128; chunk += G) {
        const int tok0 = chunk * 128, t0 = tok0 % SEQ;
        {
            float gch[8], bch[8], w0[8], w1[8], w2[8];
#pragma unroll
            for (int c = 0; c < 8; ++c) { gch[c] = vn_g[lane * 8 + c]; bch[c] = vn_b[lane * 8 + c]; w0[c] = conv_w[lane * 8 + c]; w1[c] = conv_w[512 + lane * 8 + c]; w2[c] = conv_w[1024 + lane * 8 + c]; }
            float p1[8], p2[8];
            { const int j0 = wave * 16; const int tq = t0 + j0;
              const u32x4 a1 = tq >= 1 ? *(const u32x4*)(CX + (size_t)(tok0 + j0 - 1) * 512 + lane * 8) : (u32x4){0u, 0u, 0u, 0u};
              const u32x4 a2 = tq >= 2 ? *(const u32x4*)(CX + (size_t)(tok0 + j0 - 2) * 512 + lane * 8) : (u32x4){0u, 0u, 0u, 0u};
#pragma unroll
              for (int c = 0; c < 8; ++c) { p1[c] = __uint_as_float((c & 1) ? (a1[c >> 1] & 0xffff0000u) : (a1[c >> 1] << 16)); p2[c] = __uint_as_float((c & 1) ? (a2[c >> 1] & 0xffff0000u) : (a2[c >> 1] << 16)); } }
            u32x4 zvn[4], cxn[4], bgn[4];
#pragma unroll
            for (int r4 = 0; r4 < 4; ++r4) { const size_t rowoff = (size_t)(tok0 + wave * 16 + r4) * 512 + lane * 8; zvn[r4] = *(const u32x4*)(GZV + rowoff); cxn[r4] = *(const u32x4*)(CX + rowoff); bgn[r4] = *(const u32x4*)(BG + rowoff); }
#pragma unroll
            for (int jb = 0; jb < 16; jb += 4) {
                u32x4 zv4[4], cx4[4], bg4[4];
#pragma unroll
                for (int r4 = 0; r4 < 4; ++r4) { zv4[r4] = zvn[r4]; cx4[r4] = cxn[r4]; bg4[r4] = bgn[r4]; }
                if (jb + 4 < 16) {
#pragma unroll
                    for (int r4 = 0; r4 < 4; ++r4) { const size_t rowoff = (size_t)(tok0 + wave * 16 + jb + 4 + r4) * 512 + lane * 8; zvn[r4] = *(const u32x4*)(GZV + rowoff); cxn[r4] = *(const u32x4*)(CX + rowoff); bgn[r4] = *(const u32x4*)(BG + rowoff); }
                }
#pragma unroll
                for (int r4 = 0; r4 < 4; ++r4) {
                const int j = wave * 16 + jb + r4;
                const u32x4 zv = zv4[r4], cxv = cx4[r4], bgv = bg4[r4];
                float v[8]; float s = 0.f;
#pragma unroll
                for (int c = 0; c < 8; ++c) { v[c] = __uint_as_float((c & 1) ? (zv[c >> 1] & 0xffff0000u) : (zv[c >> 1] << 16)); s += v[c]; }
                const float mean = wave_sum_l(s, lane) * (1.f / 512.f); float q = 0.f;
#pragma unroll
                for (int c = 0; c < 8; ++c) { v[c] -= mean; q += v[c] * v[c]; }
                const float rstd = rsqrtf(wave_sum_l(q, lane) * (1.f / 512.f) + LN_EPS);
                float z[8];
#pragma unroll
                for (int c = 0; c < 8; ++c) z[c] = v[c] * rstd * gch[c] + bch[c];
                *(LAS u32x4*)(lds + (lane >> 2) * 8192 + j * 64 + (lane & 3) * 16) = pg8::pack8((f32x4){z[0], z[1], z[2], z[3]}, (f32x4){z[4], z[5], z[6], z[7]});
                float ya[8];
#pragma unroll
                for (int c = 0; c < 8; ++c) { const float cxc = __uint_as_float((c & 1) ? (cxv[c >> 1] & 0xffff0000u) : (cxv[c >> 1] << 16)), bgc = __uint_as_float((c & 1) ? (bgv[c >> 1] & 0xffff0000u) : (bgv[c >> 1] << 16));
                    ya[c] = bgc * (w0[c] * p2[c] + w1[c] * p1[c] + w2[c] * cxc); p2[c] = p1[c]; p1[c] = cxc; }
                *(u32x4*)(Y + (size_t)(tok0 + j) * DM + lane * 8) = pg8::pack8((f32x4){ya[0], ya[1], ya[2], ya[3]}, (f32x4){ya[4], ya[5], ya[6], ya[7]});
                }
            }
        }
        __syncthreads();
        {
            const int h = wave;
            const int g1 = (lane >> 4) & 1, i16 = lane & 15, tq = i16 >> 2, tp = i16 & 3;
            LAS unsigned char* zl = lds + (2 * h) * 8192 + (8 * hi + tq) * 64 + (16 * g1 + 4 * tp) * 2;
            const bf16_t* wh = SGW + (size_t)h * 128 * 128;
#pragma unroll 1
            for (int ib = 0; ib < 4; ++ib) {
                f32x16 a0, a1;
#pragma unroll
                for (int r = 0; r < 16; ++r) { a0[r] = 0.f; a1[r] = 0.f; }
                const bf16_t* wrow = wh + (size_t)(32 * ib + r32) * 128 + 8 * hi;
                for (int ks = 0; ks < 2 * ib + 2; ++ks) {
                    const bf16x8 bfr = *(const bf16x8*)(wrow + 16 * ks);
                    LAS unsigned char* za = zl + (16 * ks) * 64;
                    const v4i16_t l0 = __builtin_amdgcn_ds_read_tr16_b64_v4i16((LAS v4i16_t*)za), h0 = __builtin_amdgcn_ds_read_tr16_b64_v4i16((LAS v4i16_t*)(za + 4 * 64));
                    const v4i16_t l1 = __builtin_amdgcn_ds_read_tr16_b64_v4i16((LAS v4i16_t*)(za + 8192)), h1 = __builtin_amdgcn_ds_read_tr16_b64_v4i16((LAS v4i16_t*)(za + 8192 + 4 * 64));
                    a0 = __builtin_amdgcn_mfma_f32_32x32x16_bf16((bf16x8){l0[0], l0[1], l0[2], l0[3], h0[0], h0[1], h0[2], h0[3]}, bfr, a0, 0, 0, 0);
                    a1 = __builtin_amdgcn_mfma_f32_32x32x16_bf16((bf16x8){l1[0], l1[1], l1[2], l1[3], h1[0], h1[1], h1[2], h1[3]}, bfr, a1, 0, 0, 0);
                }
                const int irow = 32 * ib + r32; const float bias = sg_b[h * 128 + irow];
                const size_t trow = (size_t)(tok0 + irow);
#pragma unroll
                for (int cb = 0; cb < 2; ++cb)
#pragma unroll
                    for (int g4 = 0; g4 < 4; ++g4) {
                        const int ch = h * 64 + cb * 32 + 8 * g4 + 4 * hi;
                        const u32x2 zu = *(const u32x2*)(GZU + trow * 512 + ch);
                        float o[4];
#pragma unroll
                        for (int c = 0; c < 4; ++c) { const float acc = cb ? a1[4 * g4 + c] : a0[4 * g4 + c]; const float zuf = __uint_as_float((c & 1) ? (zu[c >> 1] & 0xffff0000u) : (zu[c >> 1] << 16)); o[c] = zuf * (acc + bias); }
                        u32x2 w; w.x = pg8::cvt_pk_bf16(o[0], o[1]); w.y = pg8::cvt_pk_bf16(o[2], o[3]);
                        *(u32x2*)(Y + trow * DM + 512 + ch) = w;
                    }
            }
        }
        __syncthreads();
    }
}

typedef __bf16 bf16x2_t __attribute__((ext_vector_type(2)));
constexpr int OM_WBYTES = 31 * 512 * 4, OM_TILE = 32, OM_ROWS = OM_TILE + 30;
__device__ __forceinline__ void odd_mix_phase(LAS unsigned char* lds, const int wave, const int lane, const int bx, const int G,
                                              const bf16_t* __restrict__ GLU, const bf16_t* __restrict__ CQKV, const bf16_t* __restrict__ KRR, const float* __restrict__ CS,
                                              const float* __restrict__ dw_w, const float* __restrict__ dw_b, const float* __restrict__ cn_g, const float* __restrict__ cn_b,
                                              const float* __restrict__ qn_g, const float* __restrict__ kvn_g, bf16_t* __restrict__ Y, bf16_t* __restrict__ CQKVN, bf16_t* __restrict__ KR) {
    const int tid = wave * 64 + lane;
    LAS unsigned char* gl = lds + OM_WBYTES;
    LAS unsigned* wpl = (LAS unsigned*)lds;
    for (int i = tid; i < 16 * 512 / 4; i += NTHR) { const int k2 = i >> 7, c4 = (i & 127) * 4; const f32x4 w0 = *(const f32x4*)(dw_w + (size_t)(2 * k2) * 512 + c4);
        const f32x4 w1 = (2 * k2 + 1 < 31) ? *(const f32x4*)(dw_w + (size_t)(2 * k2 + 1) * 512 + c4) : (f32x4){0.f, 0.f, 0.f, 0.f};
        *(LAS u32x4*)(wpl + 4 * i) = (u32x4){pg8::cvt_pk_bf16(w0[0], w1[0]), pg8::cvt_pk_bf16(w0[1], w1[1]), pg8::cvt_pk_bf16(w0[2], w1[2]), pg8::cvt_pk_bf16(w0[3], w1[3])}; }
    if (tid < 64) { unsigned z = 0u; asm volatile("" : "+v"(z)); *(LAS u32x4*)(gl + OM_ROWS * 1024 + tid * 16) = (u32x4){z, z, z, z}; }
    float bch[8], gch[8], cch[8];
#pragma unroll
    for (int c = 0; c < 8; ++c) { bch[c] = dw_b[lane * 8 + c]; gch[c] = cn_g[lane * 8 + c]; cch[c] = cn_b[lane * 8 + c]; }
    const f32x4 qg = *(const f32x4*)(qn_g + lane * 4); const float kg0 = kvn_g[lane * 2], kg1 = kvn_g[lane * 2 + 1];
    u32x4 pf[8];
#define OM_LOAD(tile_) do { const int _tok0 = (tile_) * OM_TILE, _t0 = _tok0 % SEQ; _Pragma("unroll") for (int i = 0; i < 8; ++i) { const int c = tid + NTHR * i, rr = c >> 6, cc = c & 63; \
        pf[i] = (c < OM_ROWS * 64 && _t0 - 30 + rr >= 0) ? *(const u32x4*)(GLU + (size_t)(_tok0 - 30 + rr) * 512 + cc * 8) : (u32x4){0u, 0u, 0u, 0u}; } } while (0)
    int tile = bx;
    if (tile < NT / OM_TILE) OM_LOAD(tile);
    for (; tile < NT / OM_TILE; tile += G) {
        const int tok0 = tile * OM_TILE;
        __syncthreads();
#pragma unroll
        for (int i = 0; i < 8; ++i) { const int c = tid + NTHR * i, rr = c >> 6, cc = c & 63; if (c < OM_ROWS * 64) *(LAS u32x4*)(gl + rr * 1024 + cc * 16) = pf[i]; }
        __syncthreads();
        if (tile + G < NT / OM_TILE) OM_LOAD(tile + G);
        u32x2 cqv[4]; unsigned ckv[4]; float kx1[4], kx2[4], kcs[4], ksn[4];
#pragma unroll
        for (int tt = 0; tt < 4; ++tt) { const size_t row = (size_t)(tok0 + wave * 4 + tt);
            cqv[tt] = *(const u32x2*)(CQKV + row * 384 + lane * 4); ckv[tt] = *(const unsigned*)(CQKV + row * 384 + 256 + lane * 2);
            kx1[tt] = bf2f(KRR[row * 32 + (lane & 15)]); kx2[tt] = bf2f(KRR[row * 32 + 16 + (lane & 15)]); kcs[tt] = CS[row * 32 + (lane & 15)]; ksn[tt] = CS[row * 32 + 16 + (lane & 15)]; }
        float acc[4][8];
#pragma unroll
        for (int tt = 0; tt < 4; ++tt)
#pragma unroll
            for (int c = 0; c < 8; ++c) acc[tt][c] = bch[c];
#pragma unroll 1
        for (int k2 = 0; k2 < 16; ++k2) {
            const u32x4 wa = *(const LAS u32x4*)(wpl + k2 * 512 + lane * 8), wb = *(const LAS u32x4*)(wpl + k2 * 512 + lane * 8 + 4);
            u32x4 gr[5];
#pragma unroll
            for (int j = 0; j < 5; ++j) gr[j] = *(const LAS u32x4*)(gl + (wave * 4 + 2 * k2 + j) * 1024 + lane * 16);
#pragma unroll
            for (int tt = 0; tt < 4; ++tt)
#pragma unroll
                for (int i = 0; i < 4; ++i) {
                    const unsigned p0 = __builtin_amdgcn_perm(gr[tt + 1][i], gr[tt][i], 0x05040100u), p1 = __builtin_amdgcn_perm(gr[tt + 1][i], gr[tt][i], 0x07060302u);
                    const unsigned wq0 = i < 2 ? wa[2 * i] : wb[2 * i - 4], wq1 = i < 2 ? wa[2 * i + 1] : wb[2 * i - 3];
                    acc[tt][2 * i] = __builtin_amdgcn_fdot2_f32_bf16(__builtin_bit_cast(bf16x2_t, p0), __builtin_bit_cast(bf16x2_t, wq0), acc[tt][2 * i], false);
                    acc[tt][2 * i + 1] = __builtin_amdgcn_fdot2_f32_bf16(__builtin_bit_cast(bf16x2_t, p1), __builtin_bit_cast(bf16x2_t, wq1), acc[tt][2 * i + 1], false);
                }
        }
#pragma unroll
        for (int tt = 0; tt < 4; ++tt) {
            const int row = tok0 + wave * 4 + tt;
            float s = 0.f;
#pragma unroll
            for (int c = 0; c < 8; ++c) s += acc[tt][c];
            const float mean = wave_sum_l(s, lane) * (1.f / 512.f); float q = 0.f;
#pragma unroll
            for (int c = 0; c < 8; ++c) { acc[tt][c] -= mean; q += acc[tt][c] * acc[tt][c]; }
            const float rstd = rsqrtf(wave_sum_l(q, lane) * (1.f / 512.f) + LN_EPS);
            float o8[8];
#pragma unroll
            for (int c = 0; c < 8; ++c) { const float z = acc[tt][c] * rstd * gch[c] + cch[c]; o8[c] = z * pg8::fsig(z); }
            *(u32x4*)(Y + (size_t)row * DM + lane * 8) = pg8::pack8((f32x4){o8[0], o8[1], o8[2], o8[3]}, (f32x4){o8[4], o8[5], o8[6], o8[7]});
            float cq[4], ck[2]; float sq = 0.f, sk = 0.f;
#pragma unroll
            for (int c = 0; c < 4; ++c) { cq[c] = __uint_as_float((c & 1) ? (cqv[tt][c >> 1] & 0xffff0000u) : (cqv[tt][c >> 1] << 16)); sq += cq[c] * cq[c]; }
            ck[0] = __uint_as_float(ckv[tt] << 16); ck[1] = __uint_as_float(ckv[tt] & 0xffff0000u); sk = ck[0] * ck[0] + ck[1] * ck[1];
            const float rq = rsqrtf(wave_sum_l(sq, lane) * (1.f / 256.f) + RMS_EPS), rk = rsqrtf(wave_sum_l(sk, lane) * (1.f / 128.f) + RMS_EPS);
            u32x2 wq; wq.x = pg8::cvt_pk_bf16(cq[0] * rq * qg[0], cq[1] * rq * qg[1]); wq.y = pg8::cvt_pk_bf16(cq[2] * rq * qg[2], cq[3] * rq * qg[3]);
            *(u32x2*)(CQKVN + (size_t)row * 384 + lane * 4) = wq;
            *(unsigned*)(CQKVN + (size_t)row * 384 + 256 + lane * 2) = pg8::cvt_pk_bf16(ck[0] * rk * kg0, ck[1] * rk * kg1);
            if (lane < 16) *(unsigned*)(KR + (size_t)row * 32 + 2 * lane) = pg8::cvt_pk_bf16(kx1[tt] * kcs[tt] - kx2[tt] * ksn[tt], kx2[tt] * kcs[tt] + kx1[tt] * ksn[tt]);
        }
    }
#undef OM_LOAD
    __syncthreads();
}

constexpr int LR_USTRIDE = 2048 + 32;
constexpr int LR_UH = 0, LR_UL = 16 * LR_USTRIDE, LR_PART = 2 * 16 * LR_USTRIDE, LR_LOG = LR_PART + 8 * 16 * 32 * 4, LR_CNT = LR_LOG + 16 * 32 * 4 + 16 * 4 * 4, LR_REC = LR_CNT + 256, LR_PAR = LR_REC + 4096, LR_END = LR_PAR + 4 * DM * 4;
static_assert(LR_END <= MISC_OFF, "lnr LDS map");
__device__ __forceinline__ void lnr_phase(LAS unsigned char* lds, const int wave, const int lane, const int bx, const int G,
                                          const bf16_t* __restrict__ V, const float* __restrict__ lng, const float* __restrict__ lnb, const float* __restrict__ mod_l, float* __restrict__ STAT, unsigned char* __restrict__ U8,
                                          const float* __restrict__ rw, const float* __restrict__ rb, int* __restrict__ TOPE, float* __restrict__ TOPG, int* __restrict__ POS, unsigned* CNT) {
    const int tid = wave * 64 + lane, fr = lane & 15, fq = lane >> 4;
    LAS unsigned* lcnt = (LAS unsigned*)(lds + LR_CNT);
    LAS unsigned* lrec = (LAS unsigned*)(lds + LR_REC);
    LAS float* part = (LAS float*)(lds + LR_PART); LAS float* logit = (LAS float*)(lds + LR_LOG);
    bf16x8 wh[4][2], wl[4][2];
#pragma unroll
    for (int s4 = 0; s4 < 4; ++s4)
#pragma unroll
        for (int nt = 0; nt < 2; ++nt) {
            float wv[8], wr[8];
#pragma unroll
            for (int j = 0; j < 8; ++j) { wv[j] = rw[(size_t)(128 * wave + 32 * s4 + 8 * fq + j) * NEXP + 16 * nt + fr]; wr[j] = wv[j] - bf2f(f2bf(wv[j])); }
            wh[s4][nt] = __builtin_bit_cast(bf16x8, pg8::pack8((f32x4){wv[0], wv[1], wv[2], wv[3]}, (f32x4){wv[4], wv[5], wv[6], wv[7]}));
            wl[s4][nt] = __builtin_bit_cast(bf16x8, pg8::pack8((f32x4){wr[0], wr[1], wr[2], wr[3]}, (f32x4){wr[4], wr[5], wr[6], wr[7]}));
        }
    const int Gb = G / NB, bb = bx / Gb, kb = bx - bb * Gb;
    const bool act = bb < NB;
    LAS float* par = (LAS float*)(lds + LR_PAR);
    if (act) { const float* m = mod_l + (size_t)bb * 6 * DM;
        for (int i = tid; i < DM / 4; i += NTHR) { *(LAS f32x4*)(par + 4 * i) = *(const f32x4*)(lng + 4 * i); *(LAS f32x4*)(par + DM + 4 * i) = *(const f32x4*)(lnb + 4 * i);
            *(LAS f32x4*)(par + 2 * DM + 4 * i) = *(const f32x4*)(m + 4 * DM + 4 * i) + 1.0f; *(LAS f32x4*)(par + 3 * DM + 4 * i) = *(const f32x4*)(m + 3 * DM + 4 * i); } }
    if (tid < 64) lcnt[tid] = 0u;
    __syncthreads();
    u32x2 vpre[2][4];
    const int sb0 = bb * (SEQ / 16) + kb;
    if (act && kb < SEQ / 16) {
#pragma unroll
        for (int rr = 0; rr < 2; ++rr)
#pragma unroll
            for (int j = 0; j < 4; ++j) vpre[rr][j] = *(const u32x2*)(V + (size_t)(sb0 * 16 + 2 * wave + rr) * DM + j * 256 + lane * 4);
    }
    int li = 0;
    for (int sq = act ? kb : SEQ / 16; sq < SEQ / 16; sq += Gb, ++li) {
        const int sb = bb * (SEQ / 16) + sq, rbase = sb * 16;
        int l4 = lane * 4; asm volatile("" : "+v"(l4));
#pragma unroll
        for (int rr = 0; rr < 2; ++rr) {
            const int r16 = 2 * wave + rr; const size_t row = (size_t)(rbase + r16);
            float v[16]; float s = 0.f;
#pragma unroll
            for (int j = 0; j < 4; ++j) { const u32x2 tb = vpre[rr][j]; const f32x4 t4 = (f32x4){__uint_as_float(tb.x << 16), __uint_as_float(tb.x & 0xffff0000u), __uint_as_float(tb.y << 16), __uint_as_float(tb.y & 0xffff0000u)};
                v[4 * j] = t4[0]; v[4 * j + 1] = t4[1]; v[4 * j + 2] = t4[2]; v[4 * j + 3] = t4[3]; s += (t4[0] + t4[1]) + (t4[2] + t4[3]); }
            const float mean = wave_sum_l(s, lane) * (1.f / DM); float q = 0.f;
#pragma unroll
            for (int i = 0; i < 16; ++i) { v[i] -= mean; q += v[i] * v[i]; }
            const float rstd = rsqrtf(wave_sum_l(q, lane) * (1.f / DM) + LN_EPS);
            if (lane == 0) *(pg8::f32x2*)(STAT + row * 2) = (pg8::f32x2){mean, rstd};
#pragma unroll
            for (int j = 0; j < 4; ++j) {
                const f32x4 g4 = *(const LAS f32x4*)(par + j * 256 + l4), b4 = *(const LAS f32x4*)(par + DM + j * 256 + l4), sc4 = *(const LAS f32x4*)(par + 2 * DM + j * 256 + l4), sh4 = *(const LAS f32x4*)(par + 3 * DM + j * 256 + l4);
                f32x4 xn, uu, ur;
#pragma unroll
                for (int c = 0; c < 4; ++c) { xn[c] = v[4 * j + c] * rstd * g4[c] + b4[c]; uu[c] = xn[c] * sc4[c] + sh4[c]; }
                u32x2 ub; ub.x = pg8::cvt_pk_bf16(uu[0], uu[1]); ub.y = pg8::cvt_pk_bf16(uu[2], uu[3]);
                *(unsigned*)(U8 + row * DM + j * 256 + l4) = pk4_fp8(uu[0], uu[1], uu[2], uu[3]);
                ur[0] = uu[0] - __uint_as_float(ub.x << 16); ur[1] = uu[1] - __uint_as_float(ub.x & 0xffff0000u); ur[2] = uu[2] - __uint_as_float(ub.y << 16); ur[3] = uu[3] - __uint_as_float(ub.y & 0xffff0000u);
                u32x2 ul; ul.x = pg8::cvt_pk_bf16(ur[0], ur[1]); ul.y = pg8::cvt_pk_bf16(ur[2], ur[3]);
                *(LAS u32x2*)(lds + LR_UH + r16 * LR_USTRIDE + (j * 256 + l4) * 2) = ub;
                *(LAS u32x2*)(lds + LR_UL + r16 * LR_USTRIDE + (j * 256 + l4) * 2) = ul;
            }
        }
        if (sq + Gb < SEQ / 16) {
#pragma unroll
            for (int rr = 0; rr < 2; ++rr)
#pragma unroll
                for (int j = 0; j < 4; ++j) vpre[rr][j] = *(const u32x2*)(V + (size_t)((sb + Gb) * 16 + 2 * wave + rr) * DM + j * 256 + l4);
        }
        __syncthreads();
        f32x4 acc0 = (f32x4){0.f, 0.f, 0.f, 0.f}, acc1 = (f32x4){0.f, 0.f, 0.f, 0.f};
#pragma unroll
        for (int s4 = 0; s4 < 4; ++s4) {
            const bf16x8 uh = *(const LAS bf16x8*)(lds + LR_UH + fr * LR_USTRIDE + (128 * wave + 32 * s4 + 8 * fq) * 2);
            const bf16x8 ul = *(const LAS bf16x8*)(lds + LR_UL + fr * LR_USTRIDE + (128 * wave + 32 * s4 + 8 * fq) * 2);
            acc0 = __builtin_amdgcn_mfma_f32_16x16x32_bf16(uh, wh[s4][0], acc0, 0, 0, 0); acc1 = __builtin_amdgcn_mfma_f32_16x16x32_bf16(uh, wh[s4][1], acc1, 0, 0, 0);
            acc0 = __builtin_amdgcn_mfma_f32_16x16x32_bf16(ul, wh[s4][0], acc0, 0, 0, 0); acc1 = __builtin_amdgcn_mfma_f32_16x16x32_bf16(ul, wh[s4][1], acc1, 0, 0, 0);
            acc0 = __builtin_amdgcn_mfma_f32_16x16x32_bf16(uh, wl[s4][0], acc0, 0, 0, 0); acc1 = __builtin_amdgcn_mfma_f32_16x16x32_bf16(uh, wl[s4][1], acc1, 0, 0, 0);
        }
#pragma unroll
        for (int r = 0; r < 4; ++r) { part[(wave * 16 + 4 * fq + r) * 32 + fr] = acc0[r]; part[(wave * 16 + 4 * fq + r) * 32 + 16 + fr] = acc1[r]; }
        __syncthreads();
        { const int rr = lane >> 5, e = lane & 31, r16 = 2 * wave + rr; const size_t row = (size_t)(rbase + r16);
            float sv = rb[e];
#pragma unroll
            for (int w8 = 0; w8 < 8; ++w8) sv += part[(w8 * 16 + r16) * 32 + e];
            logit[r16 * 32 + e] = sv;
            asm volatile("s_waitcnt lgkmcnt(0)" ::: "memory");
            int rank = 0;
#pragma unroll
            for (int e4 = 0; e4 < 8; ++e4) { const f32x4 t4 = *(const LAS f32x4*)(logit + r16 * 32 + 4 * e4);
#pragma unroll
                for (int c = 0; c < 4; ++c) { const int j = 4 * e4 + c; rank += (t4[c] > sv || (t4[c] == sv && j < e)) ? 1 : 0; } }
            LAS float* sel = logit + 512 + r16 * 4;
            if (rank < 4) sel[rank] = sv;
            asm volatile("s_waitcnt lgkmcnt(0)" ::: "memory");
            if (rank < 4) {
                const f32x4 t4 = *(const LAS f32x4*)sel;
                const float ex1 = __expf(t4[1] - t4[0]), ex2 = __expf(t4[2] - t4[0]), ex3 = __expf(t4[3] - t4[0]), inv = 1.0f / ((1.0f + ex1) + (ex2 + ex3));
                const unsigned k = __hip_atomic_fetch_add(lcnt + e, 1u, __ATOMIC_RELAXED, __HIP_MEMORY_SCOPE_WORKGROUP);
                lrec[(li * 16 + r16) * 4 + rank] = ((unsigned)e << 16) | k;
                TOPE[row * 4 + rank] = e; TOPG[row * 4 + rank] = __expf(sv - t4[0]) * inv;
            }
        }
        __syncthreads();
    }
    if (tid < NEXP) lcnt[32 + tid] = atomicAdd(&CNT[tid], lcnt[tid]);
    __syncthreads();
    for (int i = tid; i < li * 64; i += NTHR) { const unsigned rec = lrec[i]; const int sb = sb0 + (i >> 6) * Gb; POS[(size_t)sb * 64 + (i & 63)] = (int)(lcnt[32 + (rec >> 16)] + (rec & 0xffffu)); }
    __syncthreads();
}

__device__ __forceinline__ void unpack8(const u32x4 w, float (&f)[8]) {
#pragma unroll
    for (int c = 0; c < 4; ++c) { f[2 * c] = __uint_as_float(w[c] << 16); f[2 * c + 1] = __uint_as_float(w[c] & 0xffff0000u); }
}
__device__ __forceinline__ void unpack8_fp8(const u32x2 w, float (&f)[8]) {
#pragma unroll
    for (int c = 0; c < 2; ++c) { const auto lo = __builtin_amdgcn_cvt_pk_f32_fp8((int)w[c], false), hi = __builtin_amdgcn_cvt_pk_f32_fp8((int)w[c], true);
        f[4 * c] = lo[0]; f[4 * c + 1] = lo[1]; f[4 * c + 2] = hi[0]; f[4 * c + 3] = hi[1]; }
}
__device__ __forceinline__ void lnf_phase(LAS unsigned char* lds, const int wave, const int lane, const int bx, const int G, const unsigned char* __restrict__ YS, const int* __restrict__ SLOT, const float* __restrict__ TOPG,
                                          const float* __restrict__ lng, const float* __restrict__ lnb, const float* __restrict__ mod_l, const float* __restrict__ mod_n,
                                          const bf16_t* __restrict__ V, const float* __restrict__ STAT, const float* __restrict__ lmg, const float* __restrict__ lmb,
                                          bf16_t* __restrict__ X, bf16_t* __restrict__ U, float* __restrict__ out_final) {
    const int Gb = G / NB, bb = bx / Gb, kb = bx - bb * Gb, tid = wave * 64 + lane;
    if (bb >= NB) return;
    LAS float* par = (LAS float*)lds;
    { const float* m = mod_l + (size_t)bb * 6 * DM; const float* mn = mod_n + (size_t)bb * 6 * DM;
        for (int i = tid; i < DM / 4; i += NTHR) { *(LAS f32x4*)(par + 4 * i) = *(const f32x4*)(m + 5 * DM + 4 * i) + 1.0f; *(LAS f32x4*)(par + DM + 4 * i) = *(const f32x4*)(lng + 4 * i); *(LAS f32x4*)(par + 2 * DM + 4 * i) = *(const f32x4*)(lnb + 4 * i);
            *(LAS f32x4*)(par + 3 * DM + 4 * i) = *(const f32x4*)(lmg + 4 * i); *(LAS f32x4*)(par + 4 * DM + 4 * i) = *(const f32x4*)(lmb + 4 * i);
            if (!out_final) { *(LAS f32x4*)(par + 5 * DM + 4 * i) = *(const f32x4*)(mn + DM + 4 * i) + 1.0f; *(LAS f32x4*)(par + 6 * DM + 4 * i) = *(const f32x4*)(mn + 4 * i); } } }
    __syncthreads();
    for (int p = kb * NWAVES + wave; p < SEQ / 2; p += Gb * NWAVES) {
        const int row0 = bb * SEQ + 2 * p;
        int l8 = lane * 8; asm volatile("" : "+v"(l8));
        u32x4 sl[2]; f32x4 gk[2]; pg8::f32x2 st[2];
#pragma unroll
        for (int rr = 0; rr < 2; ++rr) { sl[rr] = *(const u32x4*)(SLOT + (size_t)(row0 + rr) * 4); gk[rr] = *(const f32x4*)(TOPG + (size_t)(row0 + rr) * 4) * 0.0625f; st[rr] = *(const pg8::f32x2*)(STAT + (size_t)(row0 + rr) * 2); }
        u32x2 yv[2][4][2]; u32x4 xv[2][2];
#pragma unroll
        for (int rr = 0; rr < 2; ++rr) {
#pragma unroll
            for (int k = 0; k < 4; ++k)
#pragma unroll
                for (int j = 0; j < 2; ++j) yv[rr][k][j] = *(const u32x2*)(YS + (size_t)sl[rr][k] * DM + j * 512 + l8);
#pragma unroll
            for (int j = 0; j < 2; ++j) xv[rr][j] = *(const u32x4*)(V + (size_t)(row0 + rr) * DM + j * 512 + l8);
        }
#pragma unroll
        for (int rr = 0; rr < 2; ++rr) {
            const size_t row = (size_t)(row0 + rr);
            float v[16]; float s = 0.f;
#pragma unroll
            for (int j = 0; j < 2; ++j) {
                float y[8], t[8], xs[8];
#pragma unroll
                for (int c = 0; c < 8; ++c) y[c] = 0.f;
#pragma unroll
                for (int k = 0; k < 4; ++k) { unpack8_fp8(yv[rr][k][j], t);
#pragma unroll
                    for (int c = 0; c < 8; ++c) y[c] += gk[rr][k] * t[c]; }
                unpack8(xv[rr][j], xs);
                { const f32x4 a0 = *(const LAS f32x4*)(par + 3 * DM + j * 512 + l8), a1 = *(const LAS f32x4*)(par + 3 * DM + j * 512 + l8 + 4), b0 = *(const LAS f32x4*)(par + 4 * DM + j * 512 + l8), b1 = *(const LAS f32x4*)(par + 4 * DM + j * 512 + l8 + 4);
#pragma unroll
                  for (int c = 0; c < 8; ++c) xs[c] = (xs[c] - st[rr].x) * st[rr].y * (c < 4 ? a0[c & 3] : a1[c & 3]) + (c < 4 ? b0[c & 3] : b1[c & 3]); }
                const f32x4 g0 = *(const LAS f32x4*)(par + j * 512 + l8), g1 = *(const LAS f32x4*)(par + j * 512 + l8 + 4);
#pragma unroll
                for (int c = 0; c < 8; ++c) { v[8 * j + c] = ALPHA * xs[c] + (c < 4 ? g0[c & 3] : g1[c & 3]) * y[c]; s += v[8 * j + c]; }
            }
            const float mean = wave_sum_l(s, lane) * (1.f / DM); float q = 0.f;
#pragma unroll
            for (int i = 0; i < 16; ++i) { v[i] -= mean; q += v[i] * v[i]; }
            const float rstd = rsqrtf(wave_sum_l(q, lane) * (1.f / DM) + LN_EPS);
#pragma unroll
            for (int j = 0; j < 2; ++j) {
                const f32x4 a0 = *(const LAS f32x4*)(par + DM + j * 512 + l8), a1 = *(const LAS f32x4*)(par + DM + j * 512 + l8 + 4), b0 = *(const LAS f32x4*)(par + 2 * DM + j * 512 + l8), b1 = *(const LAS f32x4*)(par + 2 * DM + j * 512 + l8 + 4);
                f32x4 x0, x1;
#pragma unroll
                for (int c = 0; c < 4; ++c) { x0[c] = v[8 * j + c] * rstd * a0[c] + b0[c]; x1[c] = v[8 * j + 4 + c] * rstd * a1[c] + b1[c]; }
                if (out_final) { *(f32x4*)(out_final + row * DM + j * 512 + l8) = x0; *(f32x4*)(out_final + row * DM + j * 512 + l8 + 4) = x1; }
                else {
                    *(u32x4*)(X + row * DM + j * 512 + l8) = pg8::pack8(x0, x1);
                    const f32x4 sc0 = *(const LAS f32x4*)(par + 5 * DM + j * 512 + l8), sc1 = *(const LAS f32x4*)(par + 5 * DM + j * 512 + l8 + 4), sh0 = *(const LAS f32x4*)(par + 6 * DM + j * 512 + l8), sh1 = *(const LAS f32x4*)(par + 6 * DM + j * 512 + l8 + 4);
                    *(u32x4*)(U + row * DM + j * 512 + l8) = pg8::pack8(x0 * sc0 + sh0, x1 * sc1 + sh1);
                }
            }
        }
    }
}

struct Params {
    const float *x_in, *c_in; const int* pos_in;
    const float *ada_w, *ada_b, *ln_mix_g, *ln_mix_b, *ln_ffn_g, *ln_ffn_b;
    const float *ev_w_in, *ev_conv_w, *ev_sg_w, *ev_sg_b, *ev_vn_g, *ev_vn_b, *ev_w_out;
    const float *od_w_in, *od_dw_w, *od_dw_b, *od_cn_g, *od_cn_b, *od_qn_g, *od_w_uq, *od_kvn_g, *od_w_ukv, *od_w_out;
    const float *r_w, *r_b, *w_gu, *b_gu, *w_dn, *b_dn;
    float* out; unsigned char* ws;
    int ph_lo, ph_hi;
};
constexpr int PH_PREP = 0, PH_MOD0 = 1, PH_LAYER0 = 2, PH_STRIDE = 16, PH_END = PH_LAYER0 + PH_STRIDE * (DEPTH - 1) + 10;
constexpr int LP_IN = 0, LP_MIX = 1, LP_UP = 2, LP_ATT = 3, LP_OUT = 4, LP_LNR = 5, LP_SCAT = 6, LP_M1 = 7, LP_M2 = 8, LP_LNF = 9;

enum { WM_ID = 0, WM_GU = 1, WM_EIN = 2, WM_OIN = 3, WM_UQ = 4, WM_UKV = 5 };
__device__ __forceinline__ int srccol(int mode, int pr) {
    const int tile = pr >> 8, r = pr & 255;
    switch (mode) {
        case WM_GU: return (r < 128 ? 0 : 1024) + tile * 128 + (r & 127);
        case WM_EIN: return (tile < 2 || tile >= 6) ? pr : ((r < 128 ? 512 : 1024) + (tile - 2) * 128 + (r & 127));
        case WM_OIN: if (tile < 4) return (r < 128 ? 0 : 512) + tile * 128 + (r & 127); if (tile == 4) return 1024 + r; return r < 128 ? 1280 + r : (r < 160 ? 1408 + (r - 128) : -1);
        case WM_UQ: { const int h = pr / 96, d = pr - 96 * h; return d < 64 ? pr : h * 96 + 64 + 16 * ((d - 64) & 1) + ((d - 64) >> 1); }
        case WM_UKV: { const int j = pr & 511, h = j >> 6, d = j & 63; return h * 128 + (pr < 512 ? 0 : 64) + d; }
        default: return pr;
    }
}
__device__ __forceinline__ void transpose_item(const float* W, int ldw, bf16_t* WT, int ldk, int k0, int n0, int mode, LAS float* scr, int lane) {
    if (mode == WM_UQ) {
        const int sc = srccol(mode, n0 + (lane & 31));
#pragma unroll 8
        for (int i = 0; i < 32; ++i) { const int kk = 2 * i + (lane >> 5); scr[kk * 33 + (lane & 31)] = W[(size_t)(k0 + kk) * ldw + sc]; }
    } else {
        const int c4 = (lane & 7) * 4, sc = srccol(mode, n0 + c4);
        f32x4 t[8];
#pragma unroll
        for (int i = 0; i < 8; ++i) { const int kk = 8 * i + (lane >> 3); t[i] = sc >= 0 ? __builtin_nontemporal_load((const f32x4*)(W + (size_t)(k0 + kk) * ldw + sc)) : (f32x4){0.f, 0.f, 0.f, 0.f}; }
#pragma unroll
        for (int i = 0; i < 8; ++i) { const int kk = 8 * i + (lane >> 3); LAS float* d = scr + kk * 33 + c4; d[0] = t[i][0]; d[1] = t[i][1]; d[2] = t[i][2]; d[3] = t[i][3]; }
    }
    asm volatile("s_waitcnt lgkmcnt(0)" ::: "memory");
    const int c = lane & 7;
#pragma unroll
    for (int j = 0; j < 4; ++j) { const int n = (lane >> 3) + 8 * j; const LAS float* s = scr + (8 * c) * 33 + n;
        u32x4 o; o.x = pg8::cvt_pk_bf16(s[0 * 33], s[1 * 33]); o.y = pg8::cvt_pk_bf16(s[2 * 33], s[3 * 33]); o.z = pg8::cvt_pk_bf16(s[4 * 33], s[5 * 33]); o.w = pg8::cvt_pk_bf16(s[6 * 33], s[7 * 33]);
        *(u32x4*)(WT + (size_t)(n0 + n) * ldk + k0 + 8 * c) = o; }
    asm volatile("s_waitcnt lgkmcnt(0)" ::: "memory");
}
__device__ __forceinline__ void transpose_item_f8(const float* W, int ldw, unsigned char* WT, int ldk, int k0, int n0, int mode, float mul, LAS float* scr, int lane) {
    const int c4 = (lane & 7) * 4, sc = srccol(mode, n0 + c4);
    f32x4 t[8];
#pragma unroll
    for (int i = 0; i < 8; ++i) { const int kk = 8 * i + (lane >> 3); t[i] = __builtin_nontemporal_load((const f32x4*)(W + (size_t)(k0 + kk) * ldw + sc)); }
#pragma unroll
    for (int i = 0; i < 8; ++i) { const int kk = 8 * i + (lane >> 3); LAS float* d = scr + kk * 33 + c4; d[0] = t[i][0] * mul; d[1] = t[i][1] * mul; d[2] = t[i][2] * mul; d[3] = t[i][3] * mul; }
    asm volatile("s_waitcnt lgkmcnt(0)" ::: "memory");
    const int c = lane & 3;
#pragma unroll
    for (int j = 0; j < 2; ++j) { const int n = (lane >> 2) + 16 * j; const LAS float* s = scr + (16 * c) * 33 + n;
        u32x4 o; o.x = pk4_fp8(s[0 * 33], s[1 * 33], s[2 * 33], s[3 * 33]); o.y = pk4_fp8(s[4 * 33], s[5 * 33], s[6 * 33], s[7 * 33]);
        o.z = pk4_fp8(s[8 * 33], s[9 * 33], s[10 * 33], s[11 * 33]); o.w = pk4_fp8(s[12 * 33], s[13 * 33], s[14 * 33], s[15 * 33]);
        *(u32x4*)(WT + (size_t)(n0 + n) * ldk + k0 + 16 * c) = o; }
    asm volatile("s_waitcnt lgkmcnt(0)" ::: "memory");
}
__device__ __forceinline__ bool prep_family_f8(int& it, const float* W, size_t wstride, int ldw, int K, int nphys, unsigned char* WT, size_t tstride, int ldk, int nmat, int mode, float mul, LAS float* scr, int lane) {
    const int nblk = nphys / 32, per = (K / 64) * nblk, tot = per * nmat;
    if (it >= tot) { it -= tot; return false; }
    const int mi = it / per, r = it % per, kb = r / nblk, nb = r % nblk;
    transpose_item_f8(W + (size_t)mi * wstride, ldw, WT + (size_t)mi * tstride, ldk, kb * 64, nb * 32, mode, mul, scr, lane);
    return true;
}
__device__ __forceinline__ bool prep_family(int& it, const float* W, size_t wstride, int ldw, int K, int nphys, bf16_t* WT, size_t tstride, int ldk, int koff, int nmat, int mode, LAS float* scr, int lane) {
    const int nblk = nphys / 32, per = (K / 64) * nblk, tot = per * nmat;
    if (it >= tot) { it -= tot; return false; }
    const int mi = it / per, r = it % per, kb = r / nblk, nb = r % nblk;
    transpose_item(W + (size_t)mi * wstride, ldw, WT + (size_t)mi * tstride + koff, ldk, kb * 64, nb * 32, mode, scr, lane);
    return true;
}


struct F8Item { const float* src; unsigned char* dst; float mul; };
constexpr int F8_SCR = 128 * 33 * 4;
__device__ __forceinline__ F8Item f8_item(const Params& P, unsigned char* ws, int it, int lane) {
    F8Item r; const int c4 = (lane & 7) * 4;
    if (it < 128 * 512) { const int mi = it >> 9, q = it & 511, k0 = (q >> 6) * 128, n0 = (q & 63) * 32;
        r.src = P.w_gu + (size_t)mi * DM * 2048 + (size_t)(k0 + (lane >> 3)) * 2048 + srccol(WM_GU, n0 + c4);
        r.dst = ws + WT_GU + (size_t)mi * 2048 * DM + (size_t)(n0 + (lane >> 3)) * DM + k0 + 16 * (lane & 7); r.mul = (float)(1 << W8_GU_SH); }
    else { const int i2 = it - 128 * 512, mi = i2 >> 8, q = i2 & 255, k0 = (q >> 5) * 128, n0 = (q & 31) * 32;
        r.src = P.w_dn + (size_t)mi * DM * DM + (size_t)(k0 + (lane >> 3)) * DM + n0 + c4;
        r.dst = ws + WT_DN + (size_t)mi * DM * DM + (size_t)(n0 + (lane >> 3)) * DM + k0 + 16 * (lane & 7); r.mul = (float)(1 << W8_DN_SH); }
    return r;
}
constexpr int F8_ITEMS_GU = 32 * 512, F8_ITEMS_DN = 32 * 256, F8_ITEMS_LAYER = F8_ITEMS_GU + F8_ITEMS_DN;
__device__ __forceinline__ int f8_item_id(int layer, int j) { return j < F8_ITEMS_GU ? layer * F8_ITEMS_GU + j : DEPTH * F8_ITEMS_GU + layer * F8_ITEMS_DN + (j - F8_ITEMS_GU); }
__device__ __forceinline__ void f8_convert(const Params& P, unsigned char* ws, LAS float* scr, int lane, int it) {
    const F8Item cur = f8_item(P, ws, it, lane);
    const int ldw = it < 128 * 512 ? 2048 : DM;
    f32x4 t[16];
#pragma unroll
    for (int i = 0; i < 16; ++i) t[i] = __builtin_nontemporal_load((const f32x4*)(cur.src + (size_t)(8 * i) * ldw));
    const int c4 = (lane & 7) * 4;
#pragma unroll
    for (int i = 0; i < 16; ++i) { const int kk = 8 * i + (lane >> 3); LAS float* d = scr + kk * 33 + c4; d[0] = t[i][0] * cur.mul; d[1] = t[i][1] * cur.mul; d[2] = t[i][2] * cur.mul; d[3] = t[i][3] * cur.mul; }
    asm volatile("s_waitcnt lgkmcnt(0)" ::: "memory");
#pragma unroll
    for (int j = 0; j < 4; ++j) { const LAS float* sp = scr + (16 * (lane & 7)) * 33 + (lane >> 3) + 8 * j;
        u32x4 o; o.x = pk4_fp8(sp[0 * 33], sp[1 * 33], sp[2 * 33], sp[3 * 33]); o.y = pk4_fp8(sp[4 * 33], sp[5 * 33], sp[6 * 33], sp[7 * 33]);
        o.z = pk4_fp8(sp[8 * 33], sp[9 * 33], sp[10 * 33], sp[11 * 33]); o.w = pk4_fp8(sp[12 * 33], sp[13 * 33], sp[14 * 33], sp[15 * 33]);
        *(u32x4*)(cur.dst + (size_t)(8 * j) * DM) = o; }
    asm volatile("s_waitcnt lgkmcnt(0)" ::: "memory");
}
struct SparePlan { int g1, q1, g2, q2, done; };
__device__ __forceinline__ SparePlan spare_plan(int nM, int G) {
    SparePlan p; const int n1 = nM * 8, r1 = (n1 + G - 1) / G, n2 = nM * 4, r2 = (n2 + G - 1) / G;
    p.g1 = (n1 + r1 - 1) / r1; p.q1 = 32 * r1; p.g2 = (n2 + r2 - 1) / r2; p.q2 = 40 * r2;
    const int d = (G - p.g1) * p.q1 + (G - p.g2) * p.q2; p.done = d < F8_ITEMS_LAYER ? d : F8_ITEMS_LAYER; return p;
}
__device__ __forceinline__ void f8_convert_range(const Params& P, unsigned char* ws, LAS float* scr, int lane, int wave, int layer, int j0, int j1) {
    if (j1 > F8_ITEMS_LAYER) j1 = F8_ITEMS_LAYER;
    for (int j = j0 + wave; j < j1; j += NWAVES) f8_convert(P, ws, scr, lane, f8_item_id(layer, j));
}
#define PH_LOCALS \
    __attribute__((address_space(1))) unsigned char* wsg = (__attribute__((address_space(1))) unsigned char*)P.ws; asm volatile("" : "+s"(wsg)); unsigned char* ws = (unsigned char*)wsg;     \
    const int lane = lane_id_asm(); \
    int wave = wave0; asm volatile("" : "+s"(wave)); const int tid = wave * 64 + lane; \
    int bx = blockIdx.x, G = gridDim.x; asm volatile("" : "+s"(bx), "+s"(G)); \
    const int gw = bx * NWAVES + wave, NW = G * NWAVES; \
    const size_t gtid = (size_t)bx * NTHR + tid, GT = (size_t)G * NTHR; \
    unsigned* ctl = (unsigned*)(ws + WS_CTL); \
    float* MOD = (float*)(ws + WS_MOD); float* CS = (float*)(ws + WS_CS); float* X = (float*)(ws + WS_X); float* V = (float*)(ws + WS_V); \
    bf16_t* U = (bf16_t*)(ws + WS_U); bf16_t* Y = (bf16_t*)(ws + WS_Y); bf16_t* BG = (bf16_t*)(ws + WS_BG); bf16_t* CX = (bf16_t*)(ws + WS_CX); bf16_t* GZU = (bf16_t*)(ws + WS_GZU); bf16_t* GZV = (bf16_t*)(ws + WS_GZV); \
    bf16_t* GLU = (bf16_t*)(ws + WS_GLU); bf16_t* CQKV = (bf16_t*)(ws + WS_CQKV); bf16_t* CQKVN = (bf16_t*)(ws + WS_CQKVN); bf16_t* KRR = (bf16_t*)(ws + WS_KRR); bf16_t* KR = (bf16_t*)(ws + WS_KR); \
    bf16_t* Q = (bf16_t*)(ws + WS_Q); bf16_t* KN = (bf16_t*)(ws + WS_KN); bf16_t* VV = (bf16_t*)(ws + WS_VV); \
    int* TOPE = (int*)(ws + WS_TOPE); float* TOPG = (float*)(ws + WS_TOPG); int* POS = (int*)(ws + WS_POS); int* SLOT = (int*)(ws + WS_SLOT); int* ROWTOK = (int*)(ws + WS_ROWTOK); \
    bf16_t* H = (bf16_t*)(ws + WS_H); unsigned char* YS = (unsigned char*)(ws + WS_YS); \
    (void)lane; (void)wave; (void)gw; (void)NW; (void)gtid; (void)GT; (void)ctl; (void)MOD; (void)CS; (void)X; (void)V; (void)U; (void)Y; (void)BG; (void)CX; (void)GZU; (void)GZV; (void)GLU; (void)CQKV; (void)CQKVN; \
    (void)KRR; (void)KR; (void)Q; (void)KN; (void)VV; (void)TOPE; (void)TOPG; (void)POS; (void)SLOT; (void)ROWTOK; (void)H; (void)YS
#define LY_LOCALS \
    int ly = layer; asm volatile("" : "+s"(ly)); const int li = ly >> 1; \
    const float* mod_l = MOD + (size_t)ly * NB * 6 * DM; const float* mod_n = MOD + (size_t)(ly + 1) * NB * 6 * DM; \
    const float* xres = ly == 0 ? P.x_in : X; \
    unsigned* CNT = ctl + CW_CNT + ly * 32; unsigned* OFFS = ctl + CW_OFFS + ly * 64; \
    (void)li; (void)mod_l; (void)mod_n; (void)xres; (void)CNT; (void)OFFS

__global__ void __launch_bounds__(NTHR, 2) mega(Params P) {
    extern __shared__ __attribute__((aligned(16))) unsigned char lds_raw[];
    LAS unsigned char* lds = (LAS unsigned char*)lds_raw;
    volatile LAS unsigned* MISC = (volatile LAS unsigned*)(lds + MISC_OFF);
    for (int u = threadIdx.x; u < (LDS_BYTES - MISC_OFF) / 4; u += NTHR) ((LAS unsigned*)(lds + MISC_OFF))[u] = 0u;
    __syncthreads();
    const int wave0 = __builtin_amdgcn_readfirstlane((int)(threadIdx.x >> 6));
    XcdBarrier bar = xcd_barrier_post((unsigned*)(P.ws + WS_CTL) + CW_BAR, MISC + 8, wave0);
    const int lo = P.ph_lo, hi = P.ph_hi;
#define IN(k) (lo <= (k) && (k) < hi)
#define SEAM(k) do { if ((k) + 1 < hi) xcd_barrier(bar); } while (0)

    if (IN(PH_PREP)) {
        PH_LOCALS;
        LAS float* scr = (LAS float*)(lds + wave * F8_SCR);
        for (int j = gw; j < F8_ITEMS_LAYER; j += NW) f8_convert(P, ws, scr, lane, f8_item_id(0, j));
        constexpr int NITEMS = 2 * 1280 + 2 * 512 + 2 * 768 + 2 * 96 + 2 * 64 + 2 * 512;
        for (int it0 = gw; it0 < NITEMS; it0 += NW) {
            int it = it0;
            if (prep_family(it, P.ev_w_in, (size_t)DM * 2560, 2560, DM, 2560, (bf16_t*)(ws + WT_EIN), (size_t)2560 * DM, DM, 0, 2, WM_EIN, scr, lane)) continue;
            if (prep_family(it, P.ev_w_out, (size_t)DM * DM, DM, DM, DM, (bf16_t*)(ws + WT_EOUT), (size_t)DM * DM, DM, 0, 2, WM_ID, scr, lane)) continue;
            if (prep_family(it, P.od_w_in, (size_t)DM * 1440, 1440, DM, 1536, (bf16_t*)(ws + WT_OIN), (size_t)1536 * DM, DM, 0, 2, WM_OIN, scr, lane)) continue;
            if (prep_family(it, P.od_w_uq, (size_t)256 * 768, 768, 256, 768, (bf16_t*)(ws + WT_OUP), (size_t)1792 * 256, 256, 0, 2, WM_UQ, scr, lane)) continue;
            if (prep_family(it, P.od_w_ukv, (size_t)128 * 1024, 1024, 128, 1024, (bf16_t*)(ws + WT_OUP) + (size_t)768 * 256, (size_t)1792 * 256, 256, 128, 2, WM_UKV, scr, lane)) continue;
            prep_family(it, P.od_w_out, (size_t)DM * DM, DM, DM, DM, (bf16_t*)(ws + WT_OOUT), (size_t)DM * DM, DM, 0, 2, WM_ID, scr, lane);
        }
        for (size_t i = gtid; i < (size_t)2 * 1792 * 256; i += GT) { const int col = (int)(i & 255), row = (int)((i >> 8) % 1792); if (row >= 768 && col < 128) ((bf16_t*)(ws + WT_OUP))[i] = 0; }
        for (size_t i = gtid; i < (size_t)2 * 8 * 128 * 128; i += GT) { const int jj = (int)(i & 127), ii = (int)((i >> 7) & 127); ((bf16_t*)(ws + WT_SGW))[i] = jj <= ii ? f2bf(P.ev_sg_w[i]) : (bf16_t)0; }
        for (size_t i = gtid; i < (size_t)NT * 16; i += GT) { const int tok = (int)(i >> 4), f = (int)(i & 15); float c, s; sincos_d((double)P.pos_in[tok] * INVF[f], c, s); CS[(size_t)tok * 32 + f] = c; CS[(size_t)tok * 32 + 16 + f] = s; }
        __syncthreads();
        {
            LAS float* sc = (LAS float*)lds;
            LAS float* red = (LAS float*)(lds + 32768);
            for (int i = tid; i < NB * DM; i += NTHR) { const float v = P.c_in[i]; sc[i] = v * sigmoidf_(v); }
            __syncthreads();
            for (int item = bx; item < DEPTH * 6 * DM / 64; item += G) {
                const int col = item * 64 + (tid & 63), l = col / (6 * DM), n = col % (6 * DM), kg = tid >> 6;
                float a[NB];
#pragma unroll
                for (int b = 0; b < NB; ++b) a[b] = 0.f;
                const float* w = P.ada_w + (size_t)l * DM * 6 * DM + (size_t)(kg * 128) * 6 * DM + n;
                for (int k = 0; k < 128; ++k) { const float wv = w[(size_t)k * 6 * DM];
#pragma unroll
                    for (int b = 0; b < NB; ++b) a[b] += sc[b * DM + kg * 128 + k] * wv; }
#pragma unroll
                for (int b = 0; b < NB; ++b) red[(kg * NB + b) * 64 + (tid & 63)] = a[b];
                __syncthreads();
                { const int b = tid >> 6, cc = tid & 63; float s = 0.f;
#pragma unroll
                    for (int k8 = 0; k8 < 8; ++k8) s += red[(k8 * NB + b) * 64 + cc];
                    const int col2 = item * 64 + cc, l2 = col2 / (6 * DM), n2 = col2 % (6 * DM);
                    MOD[((size_t)l2 * NB + b) * 6 * DM + n2] = s + P.ada_b[(size_t)l2 * 6 * DM + n2]; }
                __syncthreads();
            }
        }
        SEAM(PH_PREP);
    }
    if (IN(PH_MOD0)) {
        PH_LOCALS;
        for (size_t i = gtid * 4; i < (size_t)NT * DM; i += GT * 4) { const int tok = (int)(i / DM), col = (int)(i % DM), b = tok / SEQ; const float* m = MOD + (size_t)b * 6 * DM;
            const float4 xv = *(const float4*)(P.x_in + i), sc = *(const float4*)(m + DM + col), sh = *(const float4*)(m + col);
            ushort4 o; o.x = f2bf(xv.x * (1.f + sc.x) + sh.x); o.y = f2bf(xv.y * (1.f + sc.y) + sh.y); o.z = f2bf(xv.z * (1.f + sc.z) + sh.z); o.w = f2bf(xv.w * (1.f + sc.w) + sh.w);
            *(ushort4*)(U + i) = o; }
        SEAM(PH_MOD0);
    }

    for (int layer = 0; layer < DEPTH; ++layer) {
        const int pb = PH_LAYER0 + PH_STRIDE * layer;
        if ((layer & 1) == 0) {
            if (IN(pb + LP_IN)) {
                PH_LOCALS; LY_LOCALS;
                pg8::Gemm g{U, DM, nullptr, (const bf16_t*)(ws + WT_EIN) + (size_t)li * 2560 * DM, DM, 0, DM};
                pg8::Sched S; S.init(NT / 256, 10, G, bx, nullptr);
                pg8::EpiE1 E{BG, CX, GZU, GZV};
                pg8::gemm_phase(lds, wave, g, S, E);
                SEAM(pb + LP_IN);
            }
            if (IN(pb + LP_MIX)) {
                PH_LOCALS; LY_LOCALS;
                even_mix_phase(lds, wave, lane, bx, G, BG, CX, GZU, GZV, (const bf16_t*)(ws + WT_SGW) + (size_t)li * 8 * 128 * 128, P.ev_conv_w + (size_t)li * 3 * 512, P.ev_sg_b + (size_t)li * 8 * 128,
                               P.ev_vn_g + (size_t)li * 512, P.ev_vn_b + (size_t)li * 512, Y);
                SEAM(pb + LP_MIX);
            }
        } else {
            if (IN(pb + LP_IN)) {
                PH_LOCALS; LY_LOCALS;
                pg8::Gemm g{U, DM, nullptr, (const bf16_t*)(ws + WT_OIN) + (size_t)li * 1536 * DM, DM, 0, DM};
                pg8::Sched S; S.init(NT / 256, 6, G, bx, nullptr);
                pg8::EpiO1 E{GLU, CQKV, KRR};
                pg8::gemm_phase(lds, wave, g, S, E);
                SEAM(pb + LP_IN);
            }
            if (IN(pb + LP_MIX)) {
                PH_LOCALS; LY_LOCALS;
                odd_mix_phase(lds, wave, lane, bx, G, GLU, CQKV, KRR, CS, P.od_dw_w + (size_t)li * 31 * 512, P.od_dw_b + (size_t)li * 512, P.od_cn_g + (size_t)li * 512, P.od_cn_b + (size_t)li * 512,
                              P.od_qn_g + (size_t)li * 256, P.od_kvn_g + (size_t)li * 128, Y, CQKVN, KR);
                SEAM(pb + LP_MIX);
            }
            if (IN(pb + LP_UP)) {
                PH_LOCALS; LY_LOCALS;
                pg8::Gemm g{CQKVN, 384, nullptr, (const bf16_t*)(ws + WT_OUP) + (size_t)li * 1792 * 256, 256, 0, 256, 3, 128};
                pg8::Sched S; S.init(NT / 256, 7, G, bx, nullptr);
                pg8::EpiO3 E{Q, KN, VV, CS};
                pg8::gemm_phase(lds, wave, g, S, E);
                SEAM(pb + LP_UP);
            }
            if (IN(pb + LP_ATT)) {
                PH_LOCALS; LY_LOCALS;
                attn_phase(lds, wave, lane, bx, G, Q, KN, KR, VV, Y);
                SEAM(pb + LP_ATT);
            }
        }
        if (IN(pb + LP_OUT)) {
                PH_LOCALS; LY_LOCALS;
            pg8::Gemm g{Y, DM, nullptr, (const bf16_t*)(ws + ((ly & 1) ? WT_OOUT : WT_EOUT)) + (size_t)li * DM * DM, DM, 0, DM};
            pg8::Sched S; S.init(NT / 256, 4, G, bx, nullptr);
            if (ly == 0) { pg8::EpiOut<true> E{P.x_in, mod_l + 2 * DM, (bf16_t*)V}; pg8::gemm_phase(lds, wave, g, S, E); }
            else { pg8::EpiOut<false> E{X, mod_l + 2 * DM, (bf16_t*)V}; pg8::gemm_phase(lds, wave, g, S, E); }
            SEAM(pb + LP_OUT);
        }
        if (IN(pb + LP_LNR)) {
                PH_LOCALS; LY_LOCALS;
            lnr_phase(lds, wave, lane, bx, G, (const bf16_t*)V, P.ln_mix_g + (size_t)ly * DM, P.ln_mix_b + (size_t)ly * DM, mod_l, (float*)(ws + WS_STAT), ws + WS_U8, P.r_w + (size_t)ly * DM * NEXP, P.r_b + (size_t)ly * NEXP, TOPE, TOPG, POS, CNT);
            SEAM(pb + LP_LNR);
        }
        if (IN(pb + LP_SCAT)) {
                PH_LOCALS; LY_LOCALS;
            LAS unsigned char* l2 = lds; asm volatile("" : "+v"(l2));
            volatile LAS unsigned* offs = (volatile LAS unsigned*)(l2 + MISC_OFF) + 64;
            if (tid == 0) { unsigned o = 0; for (int e = 0; e < NEXP; ++e) { const unsigned c = CNT[e]; offs[48 + e] = c; offs[e] = o; o += (c + 255u) & ~255u; } offs[NEXP] = o; }
            __syncthreads();
            if (bx == 0 && tid <= NEXP) OFFS[tid] = offs[tid];
            for (size_t a = gtid; a < (size_t)NASSIGN; a += GT) { const int e = TOPE[a]; const int slot = (int)offs[e] + POS[a]; SLOT[a] = slot; ROWTOK[slot] = (int)(a >> 2); }
            for (int e = 0; e < NEXP; ++e) for (size_t s = offs[e] + offs[48 + e] + gtid; s < offs[e + 1]; s += GT) ROWTOK[s] = 0;
            __syncthreads();
            if (ly > 0) {
                const int nMp = __builtin_amdgcn_readfirstlane((int)(ctl[CW_OFFS + (ly - 1) * 64 + NEXP] >> 8));
                const SparePlan sp = spare_plan(nMp, G);
                LAS float* scr = (LAS float*)(lds + wave * F8_SCR);
                for (int j = sp.done + gw; j < F8_ITEMS_LAYER; j += NW) f8_convert(P, ws, scr, lane, f8_item_id(ly, j));
                __syncthreads();
            }
            SEAM(pb + LP_SCAT);
        }
        if (IN(pb + LP_M1)) {
                PH_LOCALS; LY_LOCALS;
            const int nM = __builtin_amdgcn_readfirstlane((int)(OFFS[NEXP] >> 8));
            LAS int* tile_e = (LAS int*)(lds + MISC_OFF + 1024);
            for (int pm = tid; pm < nM; pm += NTHR) { const unsigned rowb = (unsigned)pm * 256u; int e = 0;
                for (int j = 1; j < NEXP; ++j) e += (rowb >= OFFS[j]) ? 1 : 0;
                tile_e[pm] = e; }
            __syncthreads();
            pg8::Gemm g{(const bf16_t*)(ws + WS_U8), DM / 2, ROWTOK, (const bf16_t*)(ws + WT_GU) + (size_t)ly * NEXP * 2048 * (DM / 2), DM / 2, (size_t)2048 * (DM / 2), DM / 2};
            const SparePlan sp = spare_plan(nM, G);
            if (bx < sp.g1) {
                pg8::Sched S; S.init(nM, 8, sp.g1, bx, tile_e);
                pg8::EpiM1 E{P.b_gu + (size_t)ly * NEXP * 2048, (unsigned char*)H, lds};
                pg8::gemm_phase<pg8::EpiM1, 127 - W8_GU_SH>(lds, wave, g, S, E);
            } else if (ly + 1 < DEPTH) { const int k = bx - sp.g1; f8_convert_range(P, ws, (LAS float*)(lds + wave * F8_SCR), lane, wave, ly + 1, k * sp.q1, (k + 1) * sp.q1); }
            SEAM(pb + LP_M1);
        }
        if (IN(pb + LP_M2)) {
                PH_LOCALS; LY_LOCALS;
            const int nM = __builtin_amdgcn_readfirstlane((int)(OFFS[NEXP] >> 8));
            LAS int* tile_e = (LAS int*)(lds + MISC_OFF + 1024);
            for (int pm = tid; pm < nM; pm += NTHR) { const unsigned rowb = (unsigned)pm * 256u; int e = 0;
                for (int j = 1; j < NEXP; ++j) e += (rowb >= OFFS[j]) ? 1 : 0;
                tile_e[pm] = e; }
            __syncthreads();
            pg8::Gemm g{H, DM / 2, nullptr, (const bf16_t*)(ws + WT_DN) + (size_t)ly * NEXP * DM * (DM / 2), DM / 2, (size_t)DM * (DM / 2), DM / 2};
            const SparePlan sp = spare_plan(nM, G);
            if (bx < sp.g2) {
                pg8::Sched S; S.init(nM, 4, sp.g2, bx, tile_e);
                pg8::EpiM2 E{P.b_dn + (size_t)ly * NEXP * DM, YS, lds};
                pg8::gemm_phase<pg8::EpiM2, 127 - W8_DN_SH>(lds, wave, g, S, E);
            } else if (ly + 1 < DEPTH) { const int k = bx - sp.g2, first = (G - sp.g1) * sp.q1; f8_convert_range(P, ws, (LAS float*)(lds + wave * F8_SCR), lane, wave, ly + 1, first + k * sp.q2, first + (k + 1) * sp.q2); }
            SEAM(pb + LP_M2);
        }
        if (IN(pb + LP_LNF)) {
                PH_LOCALS; LY_LOCALS;
            const float* lng = P.ln_ffn_g + (size_t)ly * DM; const float* lnb = P.ln_ffn_b + (size_t)ly * DM;
            float* out_final = ly == DEPTH - 1 ? P.out : nullptr;
            lnf_phase(lds, wave, lane, bx, G, YS, SLOT, TOPG, lng, lnb, mod_l, mod_n, (const bf16_t*)V, (const float*)(ws + WS_STAT), P.ln_mix_g + (size_t)ly * DM, P.ln_mix_b + (size_t)ly * DM, (bf16_t*)X, U, out_final);
            SEAM(pb + LP_LNF);
        }
    }
#undef IN
#undef SEAM
}

extern "C" void kernel_launch(void* const* d_in, const int* in_sizes, int n_in, void* d_out, int out_size, void* d_ws, size_t ws_size, hipStream_t stream) {
    if (n_in != 32 || in_sizes[0] != NT * DM || out_size != NT * DM || ws_size < WS_END) { fprintf(stderr, "kernel_launch: built for 32 inputs, x / out of %d floats and >= %zu bytes of workspace; got n_in %d, out %d, ws %zu; nothing launched\n", NT * DM, (size_t)WS_END, n_in, out_size, ws_size); return; }
    static int grid = 0;
    if (grid == 0) {
        int dev = 0, cus = 0;
        if (hipGetDevice(&dev) != hipSuccess || hipDeviceGetAttribute(&cus, hipDeviceAttributeMultiprocessorCount, dev) != hipSuccess) { fprintf(stderr, "kernel_launch: device query failed; nothing launched\n"); grid = -1; return; }
        if (hipFuncSetAttribute((const void*)mega, hipFuncAttributeMaxDynamicSharedMemorySize, LDS_BYTES) != hipSuccess) { fprintf(stderr, "kernel_launch: hipFuncSetAttribute(%d B of dynamic LDS) failed; nothing launched\n", LDS_BYTES); grid = -1; return; }
        int per_cu = 0;
        if (hipOccupancyMaxActiveBlocksPerMultiprocessor(&per_cu, (const void*)mega, NTHR, LDS_BYTES) != hipSuccess || per_cu < 1) { fprintf(stderr, "kernel_launch: the occupancy query reports %d workgroups per CU; nothing launched\n", per_cu); (void)hipGetLastError(); grid = -1; return; }
        (void)hipGetLastError();
        grid = cus;
    }
    if (grid < 0) return;
    (void)hipMemsetAsync((unsigned char*)d_ws + WS_CTL, 0, 1 * MiB, stream);
    Params P{};
    P.x_in = (const float*)d_in[0]; P.c_in = (const float*)d_in[1]; P.pos_in = (const int*)d_in[2]; P.ada_w = (const float*)d_in[3]; P.ada_b = (const float*)d_in[4];
    P.ln_mix_g = (const float*)d_in[5]; P.ln_mix_b = (const float*)d_in[6]; P.ln_ffn_g = (const float*)d_in[7]; P.ln_ffn_b = (const float*)d_in[8];
    P.ev_w_in = (const float*)d_in[9]; P.ev_conv_w = (const float*)d_in[10]; P.ev_sg_w = (const float*)d_in[11]; P.ev_sg_b = (const float*)d_in[12]; P.ev_vn_g = (const float*)d_in[13]; P.ev_vn_b = (const float*)d_in[14]; P.ev_w_out = (const float*)d_in[15];
    P.od_w_in = (const float*)d_in[16]; P.od_dw_w = (const float*)d_in[17]; P.od_dw_b = (const float*)d_in[18]; P.od_cn_g = (const float*)d_in[19]; P.od_cn_b = (const float*)d_in[20]; P.od_qn_g = (const float*)d_in[21];
    P.od_w_uq = (const float*)d_in[22]; P.od_kvn_g = (const float*)d_in[23]; P.od_w_ukv = (const float*)d_in[24]; P.od_w_out = (const float*)d_in[25];
    P.r_w = (const float*)d_in[26]; P.r_b = (const float*)d_in[27]; P.w_gu = (const float*)d_in[28]; P.b_gu = (const float*)d_in[29]; P.w_dn = (const float*)d_in[30]; P.b_dn = (const float*)d_in[31];
    P.out = (float*)d_out; P.ws = (unsigned char*)d_ws; P.ph_lo = 0; P.ph_hi = PH_END;
    hipLaunchKernelGGL(mega, dim3(grid), dim3(NTHR), LDS_BYTES, stream, P);
}
```

```cpp
#include <hip/hip_runtime.h>
#include <cstdio>
#include <cstdint>

constexpr int NB = 8, SEQ = 4096, DM = 1024, NT = NB * SEQ, DEPTH = 4;
constexpr int NEXP = 32, TOPK = 4, NASSIGN = NT * TOPK;
constexpr int NSLOT = NASSIGN + NEXP * 256;
constexpr float ALPHA = 1.681792830507429f;
constexpr float LN_EPS = 1e-5f, RMS_EPS = 1e-6f;
constexpr float QSCALE = 0.1472444460259031f;

typedef unsigned short bf16_t;
__device__ __forceinline__ float bf2f(bf16_t v) { return __uint_as_float(((unsigned)v) << 16); }
__device__ __forceinline__ bf16_t f2bf(float f) { unsigned u = __float_as_uint(f); u += 0x7fffu + ((u >> 16) & 1u); return (bf16_t)(u >> 16); }
__device__ __forceinline__ float wave_sum(float v) {
#pragma unroll
    for (int o = 1; o < 64; o <<= 1) v += __shfl_xor(v, o);
    return v;
}
__device__ __forceinline__ float gelu_erf(float x) { return 0.5f * x * (1.0f + erff(x * 0.70710678118654752f)); }
__device__ __forceinline__ float sigmoidf_(float x) { return 1.0f / (1.0f + __expf(-x)); }

constexpr size_t MiB = 1ull << 20;
constexpr size_t WS_CTL = 0;
constexpr size_t WS_MOD = 1 * MiB;
constexpr size_t WS_CS = 2 * MiB;
constexpr size_t WS_X = 8 * MiB;
constexpr size_t WS_V = 136 * MiB;
constexpr size_t WS_U = 264 * MiB;
constexpr size_t WS_Y = 328 * MiB;
constexpr size_t WS_BG = 392 * MiB;
constexpr size_t WS_CX = 424 * MiB;
constexpr size_t WS_GZU = 456 * MiB;
constexpr size_t WS_GZV = 488 * MiB;
constexpr size_t WS_GLU = 520 * MiB;
constexpr size_t WS_CQKV = 552 * MiB;
constexpr size_t WS_CQKVN = 584 * MiB;
constexpr size_t WS_KRR = 616 * MiB;
constexpr size_t WS_KR = 620 * MiB;
constexpr size_t WS_Q = 624 * MiB;
constexpr size_t WS_KN = 672 * MiB;
constexpr size_t WS_VV = 704 * MiB;
constexpr size_t WS_TOPE = 736 * MiB;
constexpr size_t WS_TOPG = 737 * MiB;
constexpr size_t WS_POS = 738 * MiB;
constexpr size_t WS_SLOT = 739 * MiB;
constexpr size_t WS_ROWTOK = 740 * MiB;
constexpr size_t WS_STAT = 741 * MiB;
constexpr size_t WS_H = 744 * MiB;
constexpr size_t WS_YS = 1016 * MiB;
constexpr size_t WS_WT = 1288 * MiB;
constexpr size_t WS_U8 = 3176 * MiB;
constexpr size_t WS_END = 3208 * MiB;
constexpr int CW_CNT = 1024;
constexpr int CW_OFFS = 2048;

__device__ __constant__ double INVF[16] = {1.0, 0.5623413251903491, 0.31622776601683794, 0.1778279410038923, 0.1, 0.05623413251903491, 0.03162277660168379, 0.01778279410038923,
                                            0.01, 0.005623413251903491, 0.0031622776601683794, 0.0017782794100389228, 0.001, 0.0005623413251903491, 0.00031622776601683794, 0.00017782794100389227};

__device__ __forceinline__ void sincos_d(double a, float& c, float& s) {
    const double TWO_PI = 6.283185307179586476925286766559;
    double r = a - rint(a / TWO_PI) * TWO_PI;
    r *= 0.25;
    const double r2 = r * r;
    double sn = r * (1.0 + r2 * (-1.0 / 6 + r2 * (1.0 / 120 + r2 * (-1.0 / 5040 + r2 * (1.0 / 362880 + r2 * (-1.0 / 39916800 + r2 * (1.0 / 6227020800.0 + r2 * (-1.0 / 1307674368000.0))))))));
    double cs = 1.0 + r2 * (-0.5 + r2 * (1.0 / 24 + r2 * (-1.0 / 720 + r2 * (1.0 / 40320 + r2 * (-1.0 / 3628800 + r2 * (1.0 / 479001600.0 + r2 * (-1.0 / 87178291200.0 + r2 * (1.0 / 20922789888000.0))))))));
#pragma unroll
    for (int i = 0; i < 2; ++i) { const double s2 = 2.0 * sn * cs, c2 = 1.0 - 2.0 * sn * sn; sn = s2; cs = c2; }
    c = (float)cs; s = (float)sn;
}
#define LAS __attribute__((address_space(3)))
typedef short bf16x8 __attribute__((ext_vector_type(8)));
typedef float f32x4 __attribute__((ext_vector_type(4)));
typedef unsigned u32x4 __attribute__((ext_vector_type(4)));
constexpr int NWAVES = 8, NTHR = 512;
constexpr int RING_BYTES = 131072;
constexpr int MISC_OFF = 139264;
constexpr int MISC_OFF_OLD_UNUSED = RING_BYTES;
constexpr int LDS_BYTES = 147456;
constexpr size_t WT_GU = WS_WT, WT_DN = WS_WT + 512 * MiB, WT_EIN = WS_WT + 768 * MiB, WT_EOUT = WS_WT + 778 * MiB, WT_OIN = WS_WT + 782 * MiB, WT_OUP = WS_WT + 788 * MiB, WT_OOUT = WS_WT + 791 * MiB, WT_SGW = WS_WT + 795 * MiB;
constexpr int BIASSLOT_OFF = MISC_OFF + 5120;
constexpr int ROWSLOT_OFF = MISC_OFF + 4096;
constexpr int CW_BAR = 4096;

__device__ __forceinline__ int lane_id_asm() { int l; asm volatile("v_mbcnt_lo_u32_b32 %0, -1, 0\n\tv_mbcnt_hi_u32_b32 %0, -1, %0" : "=v"(l)); return l; }
__device__ __forceinline__ float shfl_xor_l(float v, int o, int lane) { return __int_as_float(__builtin_amdgcn_ds_bpermute((lane ^ o) << 2, __float_as_int(v))); }
__device__ __forceinline__ float wave_sum_l(float v, int lane) {
#pragma unroll
    for (int o = 1; o < 64; o <<= 1) v += shfl_xor_l(v, o, lane);
    return v;
}
#define XB_TMO      128
#define XB_XCNT(j)  (256  + 64 * (j))
#define XB_XSUB(j)  (1280 + 64 * (j))
#define XB_XGEN(j)  (2304 + 64 * (j))
#define XB_TOP      3328
#define XB_TOPGEN   3392
#define XCD_BAR_WORDS 3456
#define XB_SPIN_CAP (1u << 18)
__device__ __forceinline__ unsigned xb_ld(unsigned* p)              { return __hip_atomic_load(p, __ATOMIC_RELAXED, __HIP_MEMORY_SCOPE_AGENT); }
__device__ __forceinline__ unsigned xb_add(unsigned* p, unsigned v) { return __hip_atomic_fetch_add(p, v, __ATOMIC_RELAXED, __HIP_MEMORY_SCOPE_AGENT); }
__device__ __forceinline__ unsigned xb_xcc_id() { return (unsigned)__builtin_amdgcn_s_getreg((3 << 11) | 20) & 0xFu; }
#define XB_SPIN(cond, bar) do { unsigned _sp = 0; while (cond) { __builtin_amdgcn_s_sleep(1); \
    if ((++_sp & 255u) == 0u) { if (xb_ld(&(bar)[XB_TMO])) break; if (_sp > XB_SPIN_CAP) { atomicAdd(&(bar)[XB_TMO], 1u); break; } } } } while (0)
struct XcdBarrier { unsigned* bar; unsigned x; volatile LAS unsigned* st; int wave; };
__device__ __forceinline__ XcdBarrier xcd_barrier_post(unsigned* bar, volatile LAS unsigned* st, int wave) {
    XcdBarrier b; b.bar = bar; b.x = xb_xcc_id(); b.st = st; b.wave = wave;
    if (threadIdx.x == 0) (void)xb_add(&bar[XB_XCNT(b.x)], 1u);
    return b;
}
__device__ __forceinline__ void xcd_barrier_complete(unsigned* bar, unsigned x, unsigned& nloc, unsigned& nx) {
    const unsigned G = gridDim.x * gridDim.y * gridDim.z;
    unsigned sum, cnt, mine, sp = 0u;
    for (;;) {
        sum = 0u; cnt = 0u; mine = 0u;
#pragma unroll
        for (unsigned j = 0; j < 16; ++j) { const unsigned c = xb_ld(&bar[XB_XCNT(j)]); sum += c; cnt += (c > 0u) ? 1u : 0u; mine = (j == x) ? c : mine; }
        if (sum == G) break;
        __builtin_amdgcn_s_sleep(1);
        if ((++sp & 255u) == 0u) { if (xb_ld(&bar[XB_TMO])) break; if (sp > XB_SPIN_CAP) { atomicAdd(&bar[XB_TMO], 1u); break; } }
    }
    nloc = mine > 0u ? mine : 1u; nx = cnt > 0u ? cnt : 1u;
}
__device__ __forceinline__ void xcd_barrier(const XcdBarrier& b) {
    asm volatile("s_waitcnt vmcnt(0)" ::: "memory");
    __syncthreads();
    if (b.wave == 0 && lane_id_asm() == 0) {
        unsigned* bar = b.bar; asm volatile("" : "+s"(bar));
        __builtin_amdgcn_s_waitcnt(0);
        unsigned nloc = b.st[0], nx = b.st[1];
        if (nloc == 0u) { xcd_barrier_complete(bar, b.x, nloc, nx); b.st[0] = nloc; b.st[1] = nx; }
        const unsigned old = xb_add(&bar[XB_XSUB(b.x)], 1u);
        const unsigned gen = old / nloc;
        if (old + 1u == (gen + 1u) * nloc) {
            __builtin_amdgcn_fence(__ATOMIC_RELEASE, "agent");
            asm volatile("s_waitcnt vmcnt(0)" ::: "memory");
            const unsigned og = xb_add(&bar[XB_TOP], 1u);
            const unsigned tg = og / nx;
            if (og + 1u == (tg + 1u) * nx) xb_add(&bar[XB_TOPGEN], 1u);
            else XB_SPIN(xb_ld(&bar[XB_TOPGEN]) == tg, bar);
            __builtin_amdgcn_fence(__ATOMIC_ACQUIRE, "agent");
            xb_add(&bar[XB_XGEN(b.x)], 1u);
            asm volatile("s_waitcnt vmcnt(0)" ::: "memory");
        } else {
            XB_SPIN(xb_ld(&bar[XB_XGEN(b.x)]) == gen, bar);
            __builtin_amdgcn_fence(__ATOMIC_ACQUIRE, "agent");
            asm volatile("s_waitcnt vmcnt(0)" ::: "memory");
        }
    }
    __syncthreads();
}

constexpr int W8_GU_SH = 4, W8_DN_SH = 5;
typedef int v8i_t __attribute__((ext_vector_type(8)));
typedef int u32x4i __attribute__((ext_vector_type(4)));
__device__ __forceinline__ unsigned pk4_fp8(float a, float b, float c, float d) { int w = __builtin_amdgcn_cvt_pk_fp8_f32(a, b, 0, false); w = __builtin_amdgcn_cvt_pk_fp8_f32(c, d, w, true); return (unsigned)w; }
namespace pg8 {
constexpr int BM = 256, BK = 64, HALF = 128, HTB = HALF * BK * 2, STAGE_BYTES = 8 * HTB, NXCD = 8, WGM = 8;
__device__ __forceinline__ int lds_byte(int r, int c) { const int st = (r >> 4) * 2 + (c >> 5), rr = r & 15, cc = c & 31, ob = rr * 64 + cc * 2; return st * 1024 + (ob ^ (((ob >> 9) & 1) << 5)); }
__device__ __forceinline__ void stage_rc(int b, int& R, int& C) { const int st = b / 1024, sb = b % 1024, swz = sb ^ (((sb >> 9) & 1) << 5); R = (st >> 1) * 16 + swz / 64; C = (st & 1) * 32 + (swz % 64) / 2; }
__device__ __forceinline__ int perm32(int rho) { const int n = rho >> 4, i = rho & 15; return 8 * (i >> 2) + 4 * n + (i & 3); }
struct Unit { int pm, pn, e; };
struct Gemm { const bf16_t* A; int lda; const int* rowmap; const bf16_t* Bt; int ldb; size_t strideB; int K; int asplit = 1 << 30, aoff = 0; };
struct Sched {
    int nM, nN, nwg, G, c; const LAS int* tile_e;
    __device__ __forceinline__ void init(int nM_, int nN_, int G_, int c_, const LAS int* tile_e_) { nM = nM_; nN = nN_; nwg = nM * nN; G = G_; c = c_; tile_e = tile_e_; }
    __device__ __forceinline__ bool next(int i, Unit& u) const {
        const int L = i * G + c; if (L >= nwg) return false;
        int wgid = L; { const int q = nwg / NXCD, r = nwg % NXCD, xcd = wgid % NXCD, off = wgid / NXCD; wgid = (xcd < r ? xcd * (q + 1) : r * (q + 1) + (xcd - r) * q) + off; }
        const int nig = WGM * nN, gid = wgid / nig, fm = gid * WGM, gsz = (nM - fm) < WGM ? (nM - fm) : WGM;
        u.pm = fm + ((wgid % nig) % gsz); u.pn = (wgid % nig) / gsz; u.e = 0;
        if (tile_e) u.e = __builtin_amdgcn_readfirstlane(tile_e[u.pm]);
        return true;
    }
};
__device__ __forceinline__ unsigned cvt_pk_bf16(float lo, float hi) { unsigned r; asm volatile("v_cvt_pk_bf16_f32 %0, %1, %2" : "=v"(r) : "v"(lo), "v"(hi)); return r; }
__device__ __forceinline__ u32x4 pack8(const f32x4 a, const f32x4 b) { u32x4 w; w.x = cvt_pk_bf16(a[0], a[1]); w.y = cvt_pk_bf16(a[2], a[3]); w.z = cvt_pk_bf16(b[0], b[1]); w.w = cvt_pk_bf16(b[2], b[3]); return w; }
typedef float f32x2 __attribute__((ext_vector_type(2)));
typedef unsigned u32x2 __attribute__((ext_vector_type(2)));
__device__ __forceinline__ f32x2 gelu_pk(f32x2 v) {
    const f32x2 av = __builtin_elementwise_abs(v), d = av * 0.2316418882f + 1.0f;
    f32x2 t; t.x = __builtin_amdgcn_rcpf(d.x); t.y = __builtin_amdgcn_rcpf(d.y);
    f32x2 q = t * 0.5307027145f + (-0.7265760135f); q = q * t + 0.7107068705f; q = q * t + (-0.142248368f); q = q * t + 0.127414796f; q = q * t;
    const f32x2 s = (v * v) * (-0.72134752044f);
    f32x2 e; e.x = __builtin_amdgcn_exp2f(s.x); e.y = __builtin_amdgcn_exp2f(s.y);
    const f32x2 m = v * (q * e), r = v - m;
    f32x2 o; o.x = v.x < 0.f ? m.x : r.x; o.y = v.y < 0.f ? m.y : r.y; return o;
}
__device__ __forceinline__ f32x4 gelu4(const f32x4 v) { const f32x2 a = gelu_pk((f32x2){v[0], v[1]}), b = gelu_pk((f32x2){v[2], v[3]}); return (f32x4){a.x, a.y, b.x, b.y}; }
__device__ __forceinline__ float fsig(float x) { return __builtin_amdgcn_rcpf(1.0f + __builtin_amdgcn_exp2f(-1.4426950408889634f * x)); }

#define EPI_ROWS for (int ai = 0; ai < 2; ++ai) _Pragma("unroll") for (int m = 0; m < 4; ++m)

struct EpiE1 {
    static constexpr bool LDS_BIAS = false;
    bf16_t *BG, *CX, *GZU, *GZV;
    __device__ __forceinline__ void operator()(const f32x4 (&acc)[2][2][4][2], const Unit& u, int wr, int wc, int fr, int fq) const {
        const int row0 = u.pm * BM + wr * 64 + fr, cl = wc * 32 + 8 * fq, t = u.pn;
        if (t < 2) {
#pragma unroll
            EPI_ROWS { bf16_t* rp = BG + (size_t)(row0 + ai * HALF + m * 16) * 512 + t * 256 + cl;
#pragma unroll
                for (int bj = 0; bj < 2; ++bj) *(u32x4*)(rp + bj * HALF) = pack8(acc[ai][bj][m][0], acc[ai][bj][m][1]); }
        } else if (t < 6) {
#pragma unroll
            EPI_ROWS { bf16_t* rp = CX + (size_t)(row0 + ai * HALF + m * 16) * 512 + (t - 2) * 128 + cl;
                *(u32x4*)rp = pack8(acc[ai][0][m][0] * acc[ai][1][m][0], acc[ai][0][m][1] * acc[ai][1][m][1]); }
        } else {
            bf16_t* O = t < 8 ? GZU : GZV; const int tc = (t & 1) * 256 + cl;
#pragma unroll
            EPI_ROWS { bf16_t* rp = O + (size_t)(row0 + ai * HALF + m * 16) * 512 + tc;
#pragma unroll
                for (int bj = 0; bj < 2; ++bj) *(u32x4*)(rp + bj * HALF) = pack8(gelu4(acc[ai][bj][m][0]), gelu4(acc[ai][bj][m][1])); }
        }
    }
};
struct EpiO1 {
    static constexpr bool LDS_BIAS = false;
    bf16_t *GLU, *CQKV, *KRR;
    __device__ __forceinline__ void operator()(const f32x4 (&acc)[2][2][4][2], const Unit& u, int wr, int wc, int fr, int fq) const {
        const int row0 = u.pm * BM + wr * 64 + fr, cl = wc * 32 + 8 * fq, t = u.pn;
        if (t < 4) {
#pragma unroll
            EPI_ROWS { bf16_t* rp = GLU + (size_t)(row0 + ai * HALF + m * 16) * 512 + t * 128 + cl; f32x4 o[2];
#pragma unroll
                for (int n = 0; n < 2; ++n) {
                    const f32x4 ga = acc[ai][0][m][n], tb = acc[ai][1][m][n] * (-1.4426950408889634f);
                    f32x4 e; e[0] = __builtin_amdgcn_exp2f(tb[0]); e[1] = __builtin_amdgcn_exp2f(tb[1]); e[2] = __builtin_amdgcn_exp2f(tb[2]); e[3] = __builtin_amdgcn_exp2f(tb[3]);
                    const f32x4 d = e + 1.0f;
                    f32x4 r; r[0] = __builtin_amdgcn_rcpf(d[0]); r[1] = __builtin_amdgcn_rcpf(d[1]); r[2] = __builtin_amdgcn_rcpf(d[2]); r[3] = __builtin_amdgcn_rcpf(d[3]);
                    o[n] = ga * r; }
                *(u32x4*)rp = pack8(o[0], o[1]); }
        } else if (t == 4) {
#pragma unroll
            EPI_ROWS { bf16_t* rp = CQKV + (size_t)(row0 + ai * HALF + m * 16) * 384 + cl;
#pragma unroll
                for (int bj = 0; bj < 2; ++bj) *(u32x4*)(rp + bj * HALF) = pack8(acc[ai][bj][m][0], acc[ai][bj][m][1]); }
        } else {
#pragma unroll
            EPI_ROWS { const size_t r = (size_t)(row0 + ai * HALF + m * 16);
                *(u32x4*)(CQKV + r * 384 + 256 + cl) = pack8(acc[ai][0][m][0], acc[ai][0][m][1]);
                if (wc == 0) *(u32x4*)(KRR + r * 32 + 8 * fq) = pack8(acc[ai][1][m][0], acc[ai][1][m][1]); }
        }
    }
};
struct EpiO3 {
    static constexpr bool LDS_BIAS = false;
    bf16_t *Q, *KN, *VV; const float* CS;
    __device__ __forceinline__ void operator()(const f32x4 (&acc)[2][2][4][2], const Unit& u, int wr, int wc, int fr, int fq) const {
        const int row0 = u.pm * BM + wr * 64 + fr, cl = wc * 32 + 8 * fq, t = u.pn;
        if (t < 3) {
#pragma unroll
            for (int bj = 0; bj < 2; ++bj) { const int c0 = t * 256 + bj * HALF + cl, h = c0 / 96, d0 = c0 - 96 * h;
                if (d0 < 64) {
#pragma unroll
                    EPI_ROWS *(u32x4*)(Q + (size_t)(row0 + ai * HALF + m * 16) * 768 + c0) = pack8(acc[ai][bj][m][0] * QSCALE, acc[ai][bj][m][1] * QSCALE);
                } else { const int i0 = (d0 - 64) >> 1;
#pragma unroll
                    for (int ai = 0; ai < 2; ++ai) {
                    f32x4 csv[4], snv[4];
#pragma unroll
                    for (int m = 0; m < 4; ++m) { const size_t r = (size_t)(row0 + ai * HALF + m * 16); csv[m] = *(const f32x4*)(CS + r * 32 + i0); snv[m] = *(const f32x4*)(CS + r * 32 + 16 + i0); }
#pragma unroll
                    for (int m = 0; m < 4; ++m) { const size_t r = (size_t)(row0 + ai * HALF + m * 16); const f32x4 cs = csv[m], sn = snv[m];
                        const f32x4 a = acc[ai][bj][m][0], b = acc[ai][bj][m][1]; f32x4 o0, o1;
                        o0[0] = (a[0] * cs[0] - a[1] * sn[0]) * QSCALE; o0[1] = (a[1] * cs[0] + a[0] * sn[0]) * QSCALE; o0[2] = (a[2] * cs[1] - a[3] * sn[1]) * QSCALE; o0[3] = (a[3] * cs[1] + a[2] * sn[1]) * QSCALE;
                        o1[0] = (b[0] * cs[2] - b[1] * sn[2]) * QSCALE; o1[1] = (b[1] * cs[2] + b[0] * sn[2]) * QSCALE; o1[2] = (b[2] * cs[3] - b[3] * sn[3]) * QSCALE; o1[3] = (b[3] * cs[3] + b[2] * sn[3]) * QSCALE;
                        *(u32x4*)(Q + r * 768 + c0) = pack8(o0, o1); } }
                } }
        } else {
            bf16_t* O = t < 5 ? KN : VV; const int tc = ((t - 3) & 1) * 256 + cl;
#pragma unroll
            EPI_ROWS { bf16_t* rp = O + (size_t)(row0 + ai * HALF + m * 16) * 512 + tc;
#pragma unroll
                for (int bj = 0; bj < 2; ++bj) *(u32x4*)(rp + bj * HALF) = pack8(acc[ai][bj][m][0], acc[ai][bj][m][1]); }
        }
    }
};
template <bool XF32> struct EpiOut {
    static constexpr bool LDS_BIAS = false;
    const void* xres; const float* gate; bf16_t* V;
    __device__ __forceinline__ void operator()(const f32x4 (&acc)[2][2][4][2], const Unit& u, int wr, int wc, int fr, int fq) const {
        const int row0 = u.pm * BM + wr * 64 + fr, b = (u.pm * BM) / SEQ;
        f32x4 g[2][2];
#pragma unroll
        for (int bj = 0; bj < 2; ++bj)
#pragma unroll
            for (int n = 0; n < 2; ++n) g[bj][n] = *(const f32x4*)(gate + (size_t)b * 6 * DM + u.pn * BM + bj * HALF + wc * 32 + 8 * fq + 4 * n) + 1.0f;
        const size_t cb = (size_t)u.pn * BM + wc * 32 + 8 * fq;
        if constexpr (!XF32) {
#pragma unroll
            for (int ai = 0; ai < 2; ++ai) {
                u32x4 xb[4][2];
#pragma unroll
                for (int m = 0; m < 4; ++m)
#pragma unroll
                    for (int bj = 0; bj < 2; ++bj) xb[m][bj] = *(const u32x4*)((const bf16_t*)xres + (size_t)(row0 + ai * HALF + m * 16) * DM + cb + bj * HALF);
#pragma unroll
                for (int m = 0; m < 4; ++m)
#pragma unroll
                    for (int bj = 0; bj < 2; ++bj) { const u32x4 t = xb[m][bj];
                        const f32x4 x0 = (f32x4){__uint_as_float(t.x << 16), __uint_as_float(t.x & 0xffff0000u), __uint_as_float(t.y << 16), __uint_as_float(t.y & 0xffff0000u)};
                        const f32x4 x1 = (f32x4){__uint_as_float(t.z << 16), __uint_as_float(t.z & 0xffff0000u), __uint_as_float(t.w << 16), __uint_as_float(t.w & 0xffff0000u)};
                        *(u32x4*)(V + (size_t)(row0 + ai * HALF + m * 16) * DM + cb + bj * HALF) = pack8(x0 * ALPHA + g[bj][0] * acc[ai][bj][m][0], x1 * ALPHA + g[bj][1] * acc[ai][bj][m][1]); }
            }
        } else {
#pragma unroll
            for (int ai = 0; ai < 2; ++ai)
#pragma unroll
                for (int mh = 0; mh < 2; ++mh) {
                    f32x4 xf[2][2][2];
#pragma unroll
                    for (int m2 = 0; m2 < 2; ++m2)
#pragma unroll
                        for (int bj = 0; bj < 2; ++bj) { const float* xp = (const float*)xres + (size_t)(row0 + ai * HALF + (2 * mh + m2) * 16) * DM + cb + bj * HALF; xf[m2][bj][0] = *(const f32x4*)xp; xf[m2][bj][1] = *(const f32x4*)(xp + 4); }
#pragma unroll
                    for (int m2 = 0; m2 < 2; ++m2)
#pragma unroll
                        for (int bj = 0; bj < 2; ++bj) { const int m = 2 * mh + m2;
                            *(u32x4*)(V + (size_t)(row0 + ai * HALF + m * 16) * DM + cb + bj * HALF) = pack8(xf[m2][bj][0] * ALPHA + g[bj][0] * acc[ai][bj][m][0], xf[m2][bj][1] * ALPHA + g[bj][1] * acc[ai][bj][m][1]); }
                }
        }
    }
};
struct EpiM1 {
    const float* bgu; unsigned char* H; LAS unsigned char* lds;
    static constexpr bool LDS_BIAS = true;
    __device__ __forceinline__ const float* bias_src(const Unit& u, int lane) const { return bgu + (size_t)u.e * 2048 + (lane >> 5) * 1024 + u.pn * 128 + (lane & 31) * 4; }
    static __device__ __forceinline__ f32x2 act2(f32x2 g, f32x2 u) {
        f32x2 gg, uu; gg.x = fminf(g.x, 7.0f); gg.y = fminf(g.y, 7.0f); uu.x = __builtin_amdgcn_fmed3f(u.x, -6.0f, 8.0f); uu.y = __builtin_amdgcn_fmed3f(u.y, -6.0f, 8.0f);
        const f32x2 t = gg * (-1.702f * 1.4426950408889634f);
        f32x2 e; e.x = __builtin_amdgcn_exp2f(t.x); e.y = __builtin_amdgcn_exp2f(t.y);
        const f32x2 d = e + 1.0f;
        f32x2 r; r.x = __builtin_amdgcn_rcpf(d.x); r.y = __builtin_amdgcn_rcpf(d.y);
        return (uu * gg) * r;
    }
    __device__ __forceinline__ void operator()(const f32x4 (&acc)[2][2][4][2], const Unit& u, int wr, int wc, int fr, int fq) const {
        const int row0 = u.pm * BM + wr * 64 + fr, col = u.pn * 128 + wc * 32 + 8 * fq;
        const LAS float* bp = (const LAS float*)(lds + BIASSLOT_OFF) + wc * 32 + 8 * fq;
        f32x4 bg[2], bu[2];
#pragma unroll
        for (int n = 0; n < 2; ++n) { bg[n] = *(const LAS f32x4*)(bp + 4 * n); bu[n] = *(const LAS f32x4*)(bp + 128 + 4 * n) + 1.0f; }
#pragma unroll
        EPI_ROWS { f32x2 o[2][2];
#pragma unroll
            for (int n = 0; n < 2; ++n) { const f32x4 gv = acc[ai][0][m][n] + bg[n], uv = acc[ai][1][m][n] + bu[n];
                o[n][0] = act2((f32x2){gv[0], gv[1]}, (f32x2){uv[0], uv[1]}); o[n][1] = act2((f32x2){gv[2], gv[3]}, (f32x2){uv[2], uv[3]}); }
            u32x2 w; w.x = pk4_fp8(o[0][0].x, o[0][0].y, o[0][1].x, o[0][1].y); w.y = pk4_fp8(o[1][0].x, o[1][0].y, o[1][1].x, o[1][1].y);
            *(u32x2*)(H + (size_t)(row0 + ai * HALF + m * 16) * DM + col) = w; }
    }
};
struct EpiM2 {
    const float* bdn; unsigned char* YS; LAS unsigned char* lds;
    static constexpr bool LDS_BIAS = true;
    __device__ __forceinline__ const float* bias_src(const Unit& u, int lane) const { return bdn + (size_t)u.e * DM + u.pn * BM + lane * 4; }
    __device__ __forceinline__ void operator()(const f32x4 (&acc)[2][2][4][2], const Unit& u, int wr, int wc, int fr, int fq) const {
        const int row0 = u.pm * BM + wr * 64 + fr, col = u.pn * BM + wc * 32 + 8 * fq;
        f32x4 bv[2][2];
#pragma unroll
        for (int bj = 0; bj < 2; ++bj)
#pragma unroll
            for (int n = 0; n < 2; ++n) bv[bj][n] = *(const LAS f32x4*)((const LAS float*)(lds + BIASSLOT_OFF) + wc * 32 + 8 * fq + bj * HALF + 4 * n);
#pragma unroll
        EPI_ROWS { unsigned char* rp = YS + (size_t)(row0 + ai * HALF + m * 16) * DM + col;
#pragma unroll
            for (int bj = 0; bj < 2; ++bj) { const f32x4 a = (acc[ai][bj][m][0] + bv[bj][0]) * 16.0f, b = (acc[ai][bj][m][1] + bv[bj][1]) * 16.0f;
                u32x2 w; w.x = pk4_fp8(a[0], a[1], a[2], a[3]); w.y = pk4_fp8(b[0], b[1], b[2], b[3]); *(u32x2*)(rp + bj * HALF) = w; } }
    }
};

template <class Epi, int F8SCALE = -1>
__device__ __forceinline__ void gemm_phase(LAS unsigned char* lds, const int wave_id, const Gemm g, const Sched& S, const Epi& E) {
    const int lane = lane_id_asm();
    const int wid = wave_id, wr = wid >> 2, wc = wid & 3, fr = lane & 15, fq = lane >> 4;
    const int K = g.K, nt = K / BK;
    const int swz = (lane * 16) ^ ((((lane * 16) >> 9) & 1) << 5);
#define PG8_STR(i) ((((wid + 8 * (i)) >> 1) * 16) + (swz >> 6))
#define PG8_STC ((wid & 1) * 32 + ((swz & 63) >> 1))
    unsigned voffB[2];
#pragma unroll
    for (int i = 0; i < 2; ++i) { const int R = PG8_STR(i), Rb = (R & ~31) + perm32(R & 31); voffB[i] = (unsigned)(Rb * g.ldb + PG8_STC) * 2u; }
    const size_t kstep = (size_t)(BK * 2);
    const size_t hstepB = (size_t)HALF * g.ldb * 2;
    const unsigned ldsw = (unsigned)wid * 1024u;
    const int aoff = lds_byte(wr * 64 + fr, fq * 8), boff = lds_byte(wc * 32 + fr, fq * 8);
    const char* const abase = (const char*)g.A;
#define PG8_SA(b, h) (((b) * 2 + (h)) * HTB)
#define PG8_SB(b, h) ((4 + (b) * 2 + (h)) * HTB)
#define PG8_STAGEB(bufoff, gbase) do { _Pragma("unroll") for (int _i = 0; _i < 2; ++_i) \
        __builtin_amdgcn_global_load_lds((const unsigned*)((const char*)(gbase) + voffB[_i]), (LAS unsigned*)(lds + (bufoff) + ldsw + _i * 8192), 16, 0, 0); } while (0)
#define PG8_STAGEA(bufoff, koff, VO, h) do { _Pragma("unroll") for (int _i = 0; _i < 2; ++_i) \
        __builtin_amdgcn_global_load_lds((const unsigned*)(abase + (size_t)(koff) + (VO)[h][_i]), (LAS unsigned*)(lds + (bufoff) + ldsw + _i * 8192), 16, 0, 0); } while (0)
#define PG8_LDA(dst, b, h) do { _Pragma("unroll") for (int m = 0; m < 4; ++m) _Pragma("unroll") for (int k = 0; k < 2; ++k) dst[m][k] = *(const LAS bf16x8*)(lds + PG8_SA(b, h) + aoff + m * 2048 + k * 1024); } while (0)
#define PG8_LDB(dst, b, h) do { _Pragma("unroll") for (int n = 0; n < 2; ++n) _Pragma("unroll") for (int k = 0; k < 2; ++k) dst[n][k] = *(const LAS bf16x8*)(lds + PG8_SB(b, h) + boff + n * 2048 + k * 1024); } while (0)
#define PG8_MMA(ai, bj, At, Bt) do { __builtin_amdgcn_s_setprio(1); \
        if constexpr (F8SCALE < 0) { _Pragma("unroll") for (int m = 0; m < 4; ++m) _Pragma("unroll") for (int n = 0; n < 2; ++n) _Pragma("unroll") for (int k = 0; k < 2; ++k) \
            acc[ai][bj][m][n] = __builtin_amdgcn_mfma_f32_16x16x32_bf16(Bt[n][k], At[m][k], acc[ai][bj][m][n], 0, 0, 0); } \
        else { _Pragma("unroll") for (int m = 0; m < 4; ++m) _Pragma("unroll") for (int n = 0; n < 2; ++n) { \
            const v8i_t _b8 = __builtin_shufflevector(__builtin_bit_cast(u32x4i, Bt[n][0]), __builtin_bit_cast(u32x4i, Bt[n][1]), 0, 1, 2, 3, 4, 5, 6, 7); \
            const v8i_t _a8 = __builtin_shufflevector(__builtin_bit_cast(u32x4i, At[m][0]), __builtin_bit_cast(u32x4i, At[m][1]), 0, 1, 2, 3, 4, 5, 6, 7); \
            acc[ai][bj][m][n] = __builtin_amdgcn_mfma_scale_f32_16x16x128_f8f6f4(_b8, _a8, acc[ai][bj][m][n], 0, 0, 0, f8_sb, 0, f8_sa); } \
            _Pragma("unroll") for (int m = 0; m < 4; ++m) _Pragma("unroll") for (int n = 0; n < 2; ++n) asm volatile("" : "+v"(acc[ai][bj][m][n])); }     \
        __builtin_amdgcn_s_setprio(0); } while (0)
#define PG8_WAIT_V(n) asm volatile("s_waitcnt vmcnt(" #n ")" ::: "memory")
#define PG8_WAIT_L(n) asm volatile("s_waitcnt lgkmcnt(" #n ")" ::: "memory")
#define PG8_BAR __builtin_amdgcn_s_barrier()
#define PG8_SCHED __builtin_amdgcn_sched_barrier(0)
#define PG8_LOADROWS(U, RW) do { _Pragma("unroll") for (int _h = 0; _h < 2; ++_h) _Pragma("unroll") for (int _i = 0; _i < 2; ++_i) { const int _row = (U).pm * BM + _h * HALF + PG8_STR(_i); \
        (RW)[_h][_i] = g.rowmap ? ((const __attribute__((address_space(1))) int*)g.rowmap)[_row] : _row; } } while (0)
#define PG8_ROWS2OFF(U, RW, VO) do { const int _ao = (U).pn >= g.asplit ? g.aoff : 0; _Pragma("unroll") for (int _h = 0; _h < 2; ++_h) _Pragma("unroll") for (int _i = 0; _i < 2; ++_i) (VO)[_h][_i] = (unsigned)((RW)[_h][_i] * g.lda + _ao + PG8_STC) * 2u; } while (0)
#define PG8_CALCA(U, VO) do { int _rw[2][2]; PG8_LOADROWS(U, _rw); PG8_ROWS2OFF(U, _rw, VO); } while (0)
    int f8_sb = (F8SCALE) * 0x01010101, f8_sa = 0x7f7f7f7f; asm volatile("" : "+v"(f8_sb), "+v"(f8_sa));
    Unit cur, nxt; int ui = 0;
    if (!S.next(0, cur)) return;
    f32x4 acc[2][2][4][2];
#pragma unroll
    for (int a = 0; a < 2; ++a)
#pragma unroll
        for (int b = 0; b < 2; ++b)
#pragma unroll
            for (int m = 0; m < 4; ++m)
#pragma unroll
                for (int n = 0; n < 2; ++n) acc[a][b][m][n] = (f32x4){0.f, 0.f, 0.f, 0.f};
    bf16x8 At[4][2], B0[2][2], B1[2][2];
    unsigned voC[2][2];
    PG8_CALCA(cur, voC);
    const char* cB = (const char*)g.Bt + ((size_t)cur.e * g.strideB + (size_t)cur.pn * BM * g.ldb) * 2;
    PG8_STAGEB(PG8_SB(0, 0), cB); PG8_STAGEB(PG8_SB(0, 1), cB + hstepB); PG8_STAGEA(PG8_SA(0, 0), 0, voC, 0); PG8_STAGEA(PG8_SA(0, 1), 0, voC, 1);
    if (wr == 1) PG8_BAR;
    PG8_WAIT_V(2); PG8_BAR;
    PG8_STAGEB(PG8_SB(1, 0), cB + kstep); PG8_STAGEA(PG8_SA(1, 0), kstep, voC, 0); PG8_STAGEB(PG8_SB(1, 1), cB + hstepB + kstep);
    PG8_WAIT_V(6); PG8_BAR;
    for (;;) {
        const bool has_next = S.next(ui + 1, nxt);
        const char* nB = has_next ? (const char*)g.Bt + ((size_t)nxt.e * g.strideB + (size_t)nxt.pn * BM * g.ldb) * 2 : cB;
        int rwN[2][2];
#pragma unroll 1
        for (int t = 0; t < nt; t += 2) {
            const bool last = (t == nt - 2);
            const size_t k1 = (size_t)(t + 1) * kstep;
            const size_t k2 = last ? 0 : (size_t)(t + 2) * kstep, k3 = k2 + kstep;
            const char* b2 = last ? nB : cB + (size_t)(t + 2) * kstep; const char* b3 = b2 + kstep;
            if constexpr (Epi::LDS_BIAS) { if (t == 2 && wid == 0) { const int ln = lane_id_asm(); __builtin_amdgcn_global_load_lds((const unsigned*)E.bias_src(cur, ln), (LAS unsigned*)(lds + BIASSLOT_OFF), 16, 0, 0); } }
            if (t == nt - 4 && has_next) {
                if (g.rowmap) { if (wid == 0) __builtin_amdgcn_global_load_lds((const unsigned*)(g.rowmap + (size_t)nxt.pm * BM + lane * 4), (LAS unsigned*)(lds + ROWSLOT_OFF), 16, 0, 0); }
                else PG8_LOADROWS(nxt, rwN);
            }
            PG8_LDB(B0, 0, 0); PG8_LDB(B1, 0, 1); PG8_SCHED; PG8_LDA(At, 0, 0); PG8_STAGEA(PG8_SA(1, 1), k1, voC, 1);
            PG8_WAIT_V(8); PG8_WAIT_L(0); PG8_BAR; PG8_MMA(0, 0, At, B0); PG8_MMA(0, 1, At, B1); PG8_BAR; PG8_SCHED;
            if (last && has_next) {
                if (g.rowmap) {
#pragma unroll
                    for (int h = 0; h < 2; ++h)
#pragma unroll
                        for (int i = 0; i < 2; ++i) rwN[h][i] = *(const LAS int*)(lds + ROWSLOT_OFF + 4 * (h * HALF + PG8_STR(i)));
                }
                PG8_ROWS2OFF(nxt, rwN, voC);
            }
            PG8_LDA(At, 0, 1); PG8_STAGEB(PG8_SB(0, 0), b2); PG8_STAGEB(PG8_SB(0, 1), b2 + hstepB); PG8_STAGEA(PG8_SA(0, 0), k2, voC, 0);
            PG8_WAIT_V(8); PG8_WAIT_L(0); PG8_BAR; PG8_MMA(1, 0, At, B0); PG8_MMA(1, 1, At, B1); PG8_BAR; PG8_SCHED;
            PG8_LDB(B0, 1, 0); PG8_LDB(B1, 1, 1); PG8_SCHED; PG8_LDA(At, 1, 0); PG8_STAGEA(PG8_SA(0, 1), k2, voC, 1);
            PG8_WAIT_V(8); PG8_WAIT_L(0); PG8_BAR; PG8_MMA(0, 0, At, B0); PG8_MMA(0, 1, At, B1); PG8_BAR; PG8_SCHED;
            PG8_LDA(At, 1, 1); PG8_STAGEB(PG8_SB(1, 0), b3); PG8_STAGEB(PG8_SB(1, 1), b3 + hstepB); PG8_STAGEA(PG8_SA(1, 0), k3, voC, 0);
            PG8_WAIT_V(8); PG8_WAIT_L(0); PG8_BAR; PG8_MMA(1, 0, At, B0); PG8_MMA(1, 1, At, B1); PG8_BAR; PG8_SCHED;
        }
        if (wr == 0) PG8_BAR;
        E(acc, cur, wr, wc, fr, fq);
        if (!has_next) break;
#pragma unroll
        for (int a = 0; a < 2; ++a)
#pragma unroll
            for (int b = 0; b < 2; ++b)
#pragma unroll
                for (int m = 0; m < 4; ++m)
#pragma unroll
                    for (int n = 0; n < 2; ++n) acc[a][b][m][n] = (f32x4){0.f, 0.f, 0.f, 0.f};
        cur = nxt; cB = nB; ++ui;
        if (wr == 1) PG8_BAR;
    }
    PG8_WAIT_V(0);
    PG8_BAR;
#undef PG8_SA
#undef PG8_SB
#undef PG8_STAGEA
#undef PG8_STAGEB
#undef PG8_LDA
#undef PG8_LDB
#undef PG8_MMA
#undef PG8_WAIT_V
#undef PG8_WAIT_L
#undef PG8_BAR
#undef PG8_SCHED
#undef PG8_CALCA
#undef PG8_LOADROWS
#undef PG8_ROWS2OFF
#undef PG8_STR
#undef PG8_STC
}
}


typedef float f32x16 __attribute__((ext_vector_type(16)));
__device__ __forceinline__ float max3f_(float a, float b, float c) { float r; asm("v_max3_f32 %0, %1, %2, %3" : "=v"(r) : "v"(a), "v"(b), "v"(c)); return r; }
__device__ __forceinline__ float max2f_(float a, float b) { float r; asm("v_max_f32_e32 %0, %1, %2" : "=v"(r) : "v"(a), "v"(b)); return r; }
typedef short v4i16_t __attribute__((ext_vector_type(4)));
using pg8::u32x2;
constexpr int AT_KROW = 208, AT_KBYTES = 64 * AT_KROW, AT_VBYTES = 8192, AT_BUF = AT_KBYTES + AT_VBYTES;
__device__ __forceinline__ void attn_phase(LAS unsigned char* lds, const int wave, const int lane, const int bx, const int G,
                                           const bf16_t* __restrict__ Q, const bf16_t* __restrict__ KN, const bf16_t* __restrict__ KR, const bf16_t* __restrict__ VV, bf16_t* __restrict__ Y) {
    const int hi = lane >> 5, r32 = lane & 31, tid = wave * 64 + lane;
    const int g1 = (lane >> 4) & 1, i16 = lane & 15, tq = i16 >> 2, tp = i16 & 3;
    const int vlane_off = (4 * hi + tq) * 64 + (16 * g1 + 4 * tp) * 2;
    const int vbx = (G % 8 == 0) ? (bx % 8) * (G / 8) + bx / 8 : bx;
    for (int pidx = vbx; pidx < 512; pidx += G) {
#pragma unroll 1
        for (int jj = 0; jj < 2; ++jj) {
            const int bh = pidx >> 3, x = pidx & 7, qb = jj ? 15 - x : x, b = bh >> 3, h = bh & 7;
            const size_t tb = (size_t)b * SEQ;
            const int q0 = qb * 256 + wave * 32;
            const bf16_t* kn = KN + tb * 512 + h * 64; const bf16_t* kr = KR + tb * 32; const bf16_t* vv = VV + tb * 512 + h * 64;
            bf16x8 qf[6];
#pragma unroll
            for (int s = 0; s < 6; ++s) qf[s] = *(const bf16x8*)(Q + (tb + q0 + r32) * 768 + h * 96 + 16 * s + 8 * hi);
            f32x16 o0, o1;
#pragma unroll
            for (int r = 0; r < 16; ++r) { o0[r] = 0.f; o1[r] = 0.f; }
            float mrow = 0.f, lsum = 0.f;
            const int nt = 4 * (qb + 1);
            u32x4 pfa[3], pfb[3];
            bf16x8 pb[2][2];
            const unsigned offKV = (unsigned)((tid >> 3) * 512 + (tid & 7) * 8) * 2u, offKR = (unsigned)((tid >> 2) * 32 + (tid & 3) * 8) * 2u;
            const unsigned ldsK = (unsigned)((tid >> 3) * AT_KROW + (tid & 7) * 16), ldsR = (unsigned)((tid >> 2) * AT_KROW + 128 + (tid & 3) * 16), ldsV = (unsigned)(((tid & 7) >> 2) * 4096 + (tid >> 3) * 64 + (tid & 3) * 16);
            typedef const __attribute__((address_space(1))) unsigned char* gcp_t; typedef const __attribute__((address_space(1))) u32x4* gv4_t;
#define AT_LOAD(kt, pf) do { const size_t _k0 = (size_t)(kt) * 64; \
                pf[0] = *(gv4_t)((gcp_t)(kn + _k0 * 512) + offKV); pf[1] = *(gv4_t)((gcp_t)(vv + _k0 * 512) + offKV); \
                if (tid < 256) pf[2] = *(gv4_t)((gcp_t)(kr + _k0 * 32) + offKR); } while (0)
#define AT_STORE(par, pf) do { LAS unsigned char* _kb = lds + (par) * AT_KBYTES; LAS unsigned char* _vb = lds + 2 * AT_KBYTES + (par) * AT_VBYTES; \
                *(LAS u32x4*)(_kb + ldsK) = pf[0]; *(LAS u32x4*)(_vb + ldsV) = pf[1]; if (tid < 256) *(LAS u32x4*)(_kb + ldsR) = pf[2]; } while (0)
#define AT_PV(vbuf) do { LAS unsigned char* vlane = lds + 2 * AT_KBYTES + (vbuf) * AT_VBYTES + vlane_off; \
                bf16x8 vf[2][2][2]; \
                _Pragma("unroll") for (int kb2 = 0; kb2 < 2; ++kb2) _Pragma("unroll") for (int s2 = 0; s2 < 2; ++s2) _Pragma("unroll") for (int db = 0; db < 2; ++db) { \
                    LAS unsigned char* va = vlane + db * 4096 + (32 * kb2 + 16 * s2) * 64; \
                    const v4i16_t lo = __builtin_amdgcn_ds_read_tr16_b64_v4i16((LAS v4i16_t*)va); \
                    const v4i16_t hh = __builtin_amdgcn_ds_read_tr16_b64_v4i16((LAS v4i16_t*)(va + 8 * 64)); \
                    vf[kb2][s2][db] = (bf16x8){lo[0], lo[1], lo[2], lo[3], hh[0], hh[1], hh[2], hh[3]}; } \
                __builtin_amdgcn_sched_barrier(0); \
                _Pragma("unroll") for (int kb2 = 0; kb2 < 2; ++kb2) _Pragma("unroll") for (int s2 = 0; s2 < 2; ++s2) { \
                    o0 = __builtin_amdgcn_mfma_f32_32x32x16_bf16(vf[kb2][s2][0], pb[kb2][s2], o0, 0, 0, 0); \
                    o1 = __builtin_amdgcn_mfma_f32_32x32x16_bf16(vf[kb2][s2][1], pb[kb2][s2], o1, 0, 0, 0); } } while (0)
#define AT_ITER(KT, PAR, PFL, PFS) do { const int kt = (KT); \
                if (kt + 2 < nt) AT_LOAD(kt + 2, PFL); \
                const int kbase = kt * 64; \
                if (kbase <= q0 + 31) { \
                    LAS unsigned char* kb = lds + (PAR) * AT_KBYTES; \
                    f32x16 p0, p1; \
                _Pragma("unroll") \
                    for (int r = 0; r < 16; ++r) { p0[r] = -mrow; p1[r] = -mrow; } \
                _Pragma("unroll") \
                    for (int s = 0; s < 6; ++s) { \
                        const bf16x8 k0 = *(const LAS bf16x8*)(kb + r32 * AT_KROW + (16 * s + 8 * hi) * 2); \
                        const bf16x8 k1 = *(const LAS bf16x8*)(kb + (32 + r32) * AT_KROW + (16 * s + 8 * hi) * 2); \
                        p0 = __builtin_amdgcn_mfma_f32_32x32x16_bf16(k0, qf[s], p0, 0, 0, 0); \
                        p1 = __builtin_amdgcn_mfma_f32_32x32x16_bf16(k1, qf[s], p1, 0, 0, 0); \
                    } \
                    if (kbase + 63 > q0) { \
                        const int qrel = q0 + r32 - kbase - 4 * hi; \
                _Pragma("unroll") \
                        for (int r = 0; r < 16; ++r) { if ((r & 3) + 8 * (r >> 2) > qrel) p0[r] = -INFINITY; if ((r & 3) + 8 * (r >> 2) + 32 > qrel) p1[r] = -INFINITY; } \
                    } \
                    float mxa = max3f_(p0[0], p0[1], p1[0]), mxb = max3f_(p0[2], p0[3], p1[1]); mxa = max3f_(mxa, p1[2], p1[3]); \
                _Pragma("unroll") \
                    for (int r = 4; r < 16; r += 4) { mxa = max3f_(mxa, p0[r], p0[r + 1]); mxb = max3f_(mxb, p0[r + 2], p0[r + 3]); mxa = max3f_(mxa, p1[r], p1[r + 1]); mxb = max3f_(mxb, p1[r + 2], p1[r + 3]); } \
                    float mx = max2f_(mxa, mxb); \
                    mx = max2f_(mx, shfl_xor_l(mx, 32, lane)); \
                    if (__builtin_amdgcn_ballot_w64(mx > 0.f) != 0ull) { \
                        const float d = max2f_(mx, 0.f), sc = __builtin_amdgcn_exp2f(-d); \
                        lsum *= sc; \
                _Pragma("unroll") \
                        for (int r = 0; r < 16; ++r) { o0[r] *= sc; o1[r] *= sc; p0[r] -= d; p1[r] -= d; } \
                        mrow += d; \
                    } \
                    float ps = 0.f; \
                _Pragma("unroll") \
                    for (int r = 0; r < 16; ++r) { p0[r] = __builtin_amdgcn_exp2f(p0[r]); p1[r] = __builtin_amdgcn_exp2f(p1[r]); ps += p0[r] + p1[r]; } \
                    lsum += ps; \
                _Pragma("unroll") \
                    for (int s2 = 0; s2 < 2; ++s2) { \
                        u32x4 w0, w1; \
                        w0.x = pg8::cvt_pk_bf16(p0[8 * s2 + 0], p0[8 * s2 + 1]); w0.y = pg8::cvt_pk_bf16(p0[8 * s2 + 2], p0[8 * s2 + 3]); w0.z = pg8::cvt_pk_bf16(p0[8 * s2 + 4], p0[8 * s2 + 5]); w0.w = pg8::cvt_pk_bf16(p0[8 * s2 + 6], p0[8 * s2 + 7]); \
                        w1.x = pg8::cvt_pk_bf16(p1[8 * s2 + 0], p1[8 * s2 + 1]); w1.y = pg8::cvt_pk_bf16(p1[8 * s2 + 2], p1[8 * s2 + 3]); w1.z = pg8::cvt_pk_bf16(p1[8 * s2 + 4], p1[8 * s2 + 5]); w1.w = pg8::cvt_pk_bf16(p1[8 * s2 + 6], p1[8 * s2 + 7]); \
                        pb[0][s2] = __builtin_bit_cast(bf16x8, w0); pb[1][s2] = __builtin_bit_cast(bf16x8, w1); \
                    } \
                    AT_PV(PAR); \
                } \
                if (kt + 1 < nt) AT_STORE(1 - (PAR), PFS); \
                asm volatile("s_waitcnt lgkmcnt(0)\n\ts_barrier" ::: "memory");     \
            } while (0)
            AT_LOAD(0, pfa);
            AT_STORE(0, pfa);
            AT_LOAD(1, pfb);
            __syncthreads();
            for (int kt2 = 0; kt2 < nt; kt2 += 2) { AT_ITER(kt2, 0, pfa, pfb); AT_ITER(kt2 + 1, 1, pfb, pfa); }
#undef AT_ITER
            __syncthreads();
#undef AT_LOAD
#undef AT_STORE
#undef AT_PV
            const float inv = 1.0f / (lsum + shfl_xor_l(lsum, 32, lane));
            bf16_t* yrow = Y + (tb + q0 + r32) * DM + 512 + h * 64 + 4 * hi;
#pragma unroll
            for (int g4 = 0; g4 < 4; ++g4) {
                u32x2 w; w.x = pg8::cvt_pk_bf16(o0[4 * g4] * inv, o0[4 * g4 + 1] * inv); w.y = pg8::cvt_pk_bf16(o0[4 * g4 + 2] * inv, o0[4 * g4 + 3] * inv);
                *(u32x2*)(yrow + 8 * g4) = w;
                u32x2 w2; w2.x = pg8::cvt_pk_bf16(o1[4 * g4] * inv, o1[4 * g4 + 1] * inv); w2.y = pg8::cvt_pk_bf16(o1[4 * g4 + 2] * inv, o1[4 * g4 + 3] * inv);
                *(u32x2*)(yrow + 32 + 8 * g4) = w2;
            }
        }
    }
}

__device__ __forceinline__ void even_mix_phase(LAS unsigned char* lds, const int wave, const int lane, const int bx, const int G,
                                               const bf16_t* __restrict__ BG, const bf16_t* __restrict__ CX, const bf16_t* __restrict__ GZU, const bf16_t* __restrict__ GZV, const bf16_t* __restrict__ SGW,
                                               const float* __restrict__ conv_w, const float* __restrict__ sg_b, const float* __restrict__ vn_g, const float* __restrict__ vn_b, bf16_t* __restrict__ Y) {
    const int hi = lane >> 5, r32 = lane & 31;
    for (int chunk = bx; chunk < NT / 128; chunk += G) {
        const int tok0 = chunk * 128, t0 = tok0 % SEQ;
        {
            float gch[8], bch[8], w0[8], w1[8], w2[8];
#pragma unroll
            for (int c = 0; c < 8; ++c) { gch[c] = vn_g[lane * 8 + c]; bch[c] = vn_b[lane * 8 + c]; w0[c] = conv_w[lane * 8 + c]; w1[c] = conv_w[512 + lane * 8 + c]; w2[c] = conv_w[1024 + lane * 8 + c]; }
            float p1[8], p2[8];
            { const int j0 = wave * 16; const int tq = t0 + j0;
              const u32x4 a1 = tq >= 1 ? *(const u32x4*)(CX + (size_t)(tok0 + j0 - 1) * 512 + lane * 8) : (u32x4){0u, 0u, 0u, 0u};
              const u32x4 a2 = tq >= 2 ? *(const u32x4*)(CX + (size_t)(tok0 + j0 - 2) * 512 + lane * 8) : (u32x4){0u, 0u, 0u, 0u};
#pragma unroll
              for (int c = 0; c < 8; ++c) { p1[c] = __uint_as_float((c & 1) ? (a1[c >> 1] & 0xffff0000u) : (a1[c >> 1] << 16)); p2[c] = __uint_as_float((c & 1) ? (a2[c >> 1] & 0xffff0000u) : (a2[c >> 1] << 16)); } }
            u32x4 zvn[4], cxn[4], bgn[4];
#pragma unroll
            for (int r4 = 0; r4 < 4; ++r4) { const size_t rowoff = (size_t)(tok0 + wave * 16 + r4) * 512 + lane * 8; zvn[r4] = *(const u32x4*)(GZV + rowoff); cxn[r4] = *(const u32x4*)(CX + rowoff); bgn[r4] = *(const u32x4*)(BG + rowoff); }
#pragma unroll
            for (int jb = 0; jb < 16; jb += 4) {
                u32x4 zv4[4], cx4[4], bg4[4];
#pragma unroll
                for (int r4 = 0; r4 < 4; ++r4) { zv4[r4] = zvn[r4]; cx4[r4] = cxn[r4]; bg4[r4] = bgn[r4]; }
                if (jb + 4 < 16) {
#pragma unroll
                    for (int r4 = 0; r4 < 4; ++r4) { const size_t rowoff = (size_t)(tok0 + wave * 16 + jb + 4 + r4) * 512 + lane * 8; zvn[r4] = *(const u32x4*)(GZV + rowoff); cxn[r4] = *(const u32x4*)(CX + rowoff); bgn[r4] = *(const u32x4*)(BG + rowoff); }
                }
#pragma unroll
                for (int r4 = 0; r4 < 4; ++r4) {
                const int j = wave * 16 + jb + r4;
                const u32x4 zv = zv4[r4], cxv = cx4[r4], bgv = bg4[r4];
                float v[8]; float s = 0.f;
#pragma unroll
                for (int c = 0; c < 8; ++c) { v[c] = __uint_as_float((c & 1) ? (zv[c >> 1] & 0xffff0000u) : (zv[c >> 1] << 16)); s += v[c]; }
                const float mean = wave_sum_l(s, lane) * (1.f / 512.f); float q = 0.f;
#pragma unroll
                for (int c = 0; c < 8; ++c) { v[c] -= mean; q += v[c] * v[c]; }
                const float rstd = rsqrtf(wave_sum_l(q, lane) * (1.f / 512.f) + LN_EPS);
                float z[8];
#pragma unroll
                for (int c = 0; c < 8; ++c) z[c] = v[c] * rstd * gch[c] + bch[c];
                *(LAS u32x4*)(lds + (lane >> 2) * 8192 + j * 64 + (lane & 3) * 16) = pg8::pack8((f32x4){z[0], z[1], z[2], z[3]}, (f32x4){z[4], z[5], z[6], z[7]});
                float ya[8];
#pragma unroll
                for (int c = 0; c < 8; ++c) { const float cxc = __uint_as_float((c & 1) ? (cxv[c >> 1] & 0xffff0000u) : (cxv[c >> 1] << 16)), bgc = __uint_as_float((c & 1) ? (bgv[c >> 1] & 0xffff0000u) : (bgv[c >> 1] << 16));
                    ya[c] = bgc * (w0[c] * p2[c] + w1[c] * p1[c] + w2[c] * cxc); p2[c] = p1[c]; p1[c] = cxc; }
                *(u32x4*)(Y + (size_t)(tok0 + j) * DM + lane * 8) = pg8::pack8((f32x4){ya[0], ya[1], ya[2], ya[3]}, (f32x4){ya[4], ya[5], ya[6], ya[7]});
                }
            }
        }
        __syncthreads();
        {
            const int h = wave;
            const int g1 = (lane >> 4) & 1, i16 = lane & 15, tq = i16 >> 2, tp = i16 & 3;
            LAS unsigned char* zl = lds + (2 * h) * 8192 + (8 * hi + tq) * 64 + (16 * g1 + 4 * tp) * 2;
            const bf16_t* wh = SGW + (size_t)h * 128 * 128;
#pragma unroll 1
            for (int ib = 0; ib < 4; ++ib) {
                f32x16 a0, a1;
#pragma unroll
                for (int r = 0; r < 16; ++r) { a0[r] = 0.f; a1[r] = 0.f; }
                const bf16_t* wrow = wh + (size_t)(32 * ib + r32) * 128 + 8 * hi;
                const int irow = 32 * ib + r32; const float bias = sg_b[h * 128 + irow];
                const size_t trow = (size_t)(tok0 + irow);
                u32x2 zuv[2][4];
#pragma unroll
                for (int cb = 0; cb < 2; ++cb)
#pragma unroll
                    for (int g4 = 0; g4 < 4; ++g4) zuv[cb][g4] = *(const u32x2*)(GZU + trow * 512 + h * 64 + cb * 32 + 8 * g4 + 4 * hi);
                bf16x8 bnx = *(const bf16x8*)wrow;
                for (int ks = 0; ks < 2 * ib + 2; ++ks) {
                    const bf16x8 bfr = bnx;
                    if (ks + 1 < 2 * ib + 2) bnx = *(const bf16x8*)(wrow + 16 * (ks + 1));
                    LAS unsigned char* za = zl + (16 * ks) * 64;
                    const v4i16_t l0 = __builtin_amdgcn_ds_read_tr16_b64_v4i16((LAS v4i16_t*)za), h0 = __builtin_amdgcn_ds_read_tr16_b64_v4i16((LAS v4i16_t*)(za + 4 * 64));
                    const v4i16_t l1 = __builtin_amdgcn_ds_read_tr16_b64_v4i16((LAS v4i16_t*)(za + 8192)), h1 = __builtin_amdgcn_ds_read_tr16_b64_v4i16((LAS v4i16_t*)(za + 8192 + 4 * 64));
                    a0 = __builtin_amdgcn_mfma_f32_32x32x16_bf16((bf16x8){l0[0], l0[1], l0[2], l0[3], h0[0], h0[1], h0[2], h0[3]}, bfr, a0, 0, 0, 0);
                    a1 = __builtin_amdgcn_mfma_f32_32x32x16_bf16((bf16x8){l1[0], l1[1], l1[2], l1[3], h1[0], h1[1], h1[2], h1[3]}, bfr, a1, 0, 0, 0);
                }
#pragma unroll
                for (int cb = 0; cb < 2; ++cb)
#pragma unroll
                    for (int g4 = 0; g4 < 4; ++g4) {
                        const int ch = h * 64 + cb * 32 + 8 * g4 + 4 * hi;
                        const u32x2 zu = zuv[cb][g4];
                        float o[4];
#pragma unroll
                        for (int c = 0; c < 4; ++c) { const float acc = cb ? a1[4 * g4 + c] : a0[4 * g4 + c]; const float zuf = __uint_as_float((c & 1) ? (zu[c >> 1] & 0xffff0000u) : (zu[c >> 1] << 16)); o[c] = zuf * (acc + bias); }
                        u32x2 w; w.x = pg8::cvt_pk_bf16(o[0], o[1]); w.y = pg8::cvt_pk_bf16(o[2], o[3]);
                        *(u32x2*)(Y + trow * DM + 512 + ch) = w;
                    }
            }
        }
        __syncthreads();
    }
}

typedef __bf16 bf16x2_t __attribute__((ext_vector_type(2)));
constexpr int OM_WBYTES = 31 * 512 * 4, OM_TILE = 32, OM_ROWS = OM_TILE + 30;
__device__ __forceinline__ void odd_mix_phase(LAS unsigned char* lds, const int wave, const int lane, const int bx, const int G,
                                              const bf16_t* __restrict__ GLU, const bf16_t* __restrict__ CQKV, const bf16_t* __restrict__ KRR, const float* __restrict__ CS,
                                              const float* __restrict__ dw_w, const float* __restrict__ dw_b, const float* __restrict__ cn_g, const float* __restrict__ cn_b,
                                              const float* __restrict__ qn_g, const float* __restrict__ kvn_g, bf16_t* __restrict__ Y, bf16_t* __restrict__ CQKVN, bf16_t* __restrict__ KR) {
    const int tid = wave * 64 + lane;
    LAS unsigned char* gl = lds + OM_WBYTES;
    LAS unsigned* wpl = (LAS unsigned*)lds;
    for (int i = tid; i < 16 * 512 / 4; i += NTHR) { const int k2 = i >> 7, c4 = (i & 127) * 4; const f32x4 w0 = *(const f32x4*)(dw_w + (size_t)(2 * k2) * 512 + c4);
        const f32x4 w1 = (2 * k2 + 1 < 31) ? *(const f32x4*)(dw_w + (size_t)(2 * k2 + 1) * 512 + c4) : (f32x4){0.f, 0.f, 0.f, 0.f};
        *(LAS u32x4*)(wpl + 4 * i) = (u32x4){pg8::cvt_pk_bf16(w0[0], w1[0]), pg8::cvt_pk_bf16(w0[1], w1[1]), pg8::cvt_pk_bf16(w0[2], w1[2]), pg8::cvt_pk_bf16(w0[3], w1[3])}; }
    if (tid < 64) { unsigned z = 0u; asm volatile("" : "+v"(z)); *(LAS u32x4*)(gl + OM_ROWS * 1024 + tid * 16) = (u32x4){z, z, z, z}; }
    float bch[8], gch[8], cch[8];
#pragma unroll
    for (int c = 0; c < 8; ++c) { bch[c] = dw_b[lane * 8 + c]; gch[c] = cn_g[lane * 8 + c]; cch[c] = cn_b[lane * 8 + c]; }
    const f32x4 qg = *(const f32x4*)(qn_g + lane * 4); const float kg0 = kvn_g[lane * 2], kg1 = kvn_g[lane * 2 + 1];
    u32x4 pf[8];
#define OM_LOAD(tile_) do { const int _tok0 = (tile_) * OM_TILE, _t0 = _tok0 % SEQ; _Pragma("unroll") for (int i = 0; i < 8; ++i) { const int c = tid + NTHR * i, rr = c >> 6, cc = c & 63; \
        pf[i] = (c < OM_ROWS * 64 && _t0 - 30 + rr >= 0) ? *(const u32x4*)(GLU + (size_t)(_tok0 - 30 + rr) * 512 + cc * 8) : (u32x4){0u, 0u, 0u, 0u}; } } while (0)
    int tile = bx;
    if (tile < NT / OM_TILE) OM_LOAD(tile);
    for (; tile < NT / OM_TILE; tile += G) {
        const int tok0 = tile * OM_TILE;
        __syncthreads();
#pragma unroll
        for (int i = 0; i < 8; ++i) { const int c = tid + NTHR * i, rr = c >> 6, cc = c & 63; if (c < OM_ROWS * 64) *(LAS u32x4*)(gl + rr * 1024 + cc * 16) = pf[i]; }
        __syncthreads();
        if (tile + G < NT / OM_TILE) OM_LOAD(tile + G);
        u32x2 cqv[4]; unsigned ckv[4]; float kx1[4], kx2[4], kcs[4], ksn[4];
#pragma unroll
        for (int tt = 0; tt < 4; ++tt) { const size_t row = (size_t)(tok0 + wave * 4 + tt);
            cqv[tt] = *(const u32x2*)(CQKV + row * 384 + lane * 4); ckv[tt] = *(const unsigned*)(CQKV + row * 384 + 256 + lane * 2);
            kx1[tt] = bf2f(KRR[row * 32 + (lane & 15)]); kx2[tt] = bf2f(KRR[row * 32 + 16 + (lane & 15)]); kcs[tt] = CS[row * 32 + (lane & 15)]; ksn[tt] = CS[row * 32 + 16 + (lane & 15)]; }
        float acc[4][8];
#pragma unroll
        for (int tt = 0; tt < 4; ++tt)
#pragma unroll
            for (int c = 0; c < 8; ++c) acc[tt][c] = bch[c];
#pragma unroll 1
        for (int k2 = 0; k2 < 16; ++k2) {
            const u32x4 wa = *(const LAS u32x4*)(wpl + k2 * 512 + lane * 8), wb = *(const LAS u32x4*)(wpl + k2 * 512 + lane * 8 + 4);
            u32x4 gr[5];
#pragma unroll
            for (int j = 0; j < 5; ++j) gr[j] = *(const LAS u32x4*)(gl + (wave * 4 + 2 * k2 + j) * 1024 + lane * 16);
#pragma unroll
            for (int tt = 0; tt < 4; ++tt)
#pragma unroll
                for (int i = 0; i < 4; ++i) {
                    const unsigned p0 = __builtin_amdgcn_perm(gr[tt + 1][i], gr[tt][i], 0x05040100u), p1 = __builtin_amdgcn_perm(gr[tt + 1][i], gr[tt][i], 0x07060302u);
                    const unsigned wq0 = i < 2 ? wa[2 * i] : wb[2 * i - 4], wq1 = i < 2 ? wa[2 * i + 1] : wb[2 * i - 3];
                    acc[tt][2 * i] = __builtin_amdgcn_fdot2_f32_bf16(__builtin_bit_cast(bf16x2_t, p0), __builtin_bit_cast(bf16x2_t, wq0), acc[tt][2 * i], false);
                    acc[tt][2 * i + 1] = __builtin_amdgcn_fdot2_f32_bf16(__builtin_bit_cast(bf16x2_t, p1), __builtin_bit_cast(bf16x2_t, wq1), acc[tt][2 * i + 1], false);
                }
        }
#pragma unroll
        for (int tt = 0; tt < 4; ++tt) {
            const int row = tok0 + wave * 4 + tt;
            float s = 0.f;
#pragma unroll
            for (int c = 0; c < 8; ++c) s += acc[tt][c];
            const float mean = wave_sum_l(s, lane) * (1.f / 512.f); float q = 0.f;
#pragma unroll
            for (int c = 0; c < 8; ++c) { acc[tt][c] -= mean; q += acc[tt][c] * acc[tt][c]; }
            const float rstd = rsqrtf(wave_sum_l(q, lane) * (1.f / 512.f) + LN_EPS);
            float o8[8];
#pragma unroll
            for (int c = 0; c < 8; ++c) { const float z = acc[tt][c] * rstd * gch[c] + cch[c]; o8[c] = z * pg8::fsig(z); }
            *(u32x4*)(Y + (size_t)row * DM + lane * 8) = pg8::pack8((f32x4){o8[0], o8[1], o8[2], o8[3]}, (f32x4){o8[4], o8[5], o8[6], o8[7]});
            float cq[4], ck[2]; float sq = 0.f, sk = 0.f;
#pragma unroll
            for (int c = 0; c < 4; ++c) { cq[c] = __uint_as_float((c & 1) ? (cqv[tt][c >> 1] & 0xffff0000u) : (cqv[tt][c >> 1] << 16)); sq += cq[c] * cq[c]; }
            ck[0] = __uint_as_float(ckv[tt] << 16); ck[1] = __uint_as_float(ckv[tt] & 0xffff0000u); sk = ck[0] * ck[0] + ck[1] * ck[1];
            const float rq = rsqrtf(wave_sum_l(sq, lane) * (1.f / 256.f) + RMS_EPS), rk = rsqrtf(wave_sum_l(sk, lane) * (1.f / 128.f) + RMS_EPS);
            u32x2 wq; wq.x = pg8::cvt_pk_bf16(cq[0] * rq * qg[0], cq[1] * rq * qg[1]); wq.y = pg8::cvt_pk_bf16(cq[2] * rq * qg[2], cq[3] * rq * qg[3]);
            *(u32x2*)(CQKVN + (size_t)row * 384 + lane * 4) = wq;
            *(unsigned*)(CQKVN + (size_t)row * 384 + 256 + lane * 2) = pg8::cvt_pk_bf16(ck[0] * rk * kg0, ck[1] * rk * kg1);
            if (lane < 16) *(unsigned*)(KR + (size_t)row * 32 + 2 * lane) = pg8::cvt_pk_bf16(kx1[tt] * kcs[tt] - kx2[tt] * ksn[tt], kx2[tt] * kcs[tt] + kx1[tt] * ksn[tt]);
        }
    }
#undef OM_LOAD
    __syncthreads();
}

constexpr int LR_USTRIDE = 2048 + 32;
constexpr int LR_UH = 0, LR_UL = 16 * LR_USTRIDE, LR_PART = 2 * 16 * LR_USTRIDE, LR_LOG = LR_PART + 8 * 16 * 32 * 4, LR_CNT = LR_LOG + 16 * 32 * 4 + 16 * 4 * 4, LR_REC = LR_CNT + 256, LR_PAR = LR_REC + 4096, LR_END = LR_PAR + 4 * DM * 4;
static_assert(LR_END <= MISC_OFF, "lnr LDS map");
__device__ __forceinline__ void lnr_phase(LAS unsigned char* lds, const int wave, const int lane, const int bx, const int G,
                                          const bf16_t* __restrict__ V, const float* __restrict__ lng, const float* __restrict__ lnb, const float* __restrict__ mod_l, float* __restrict__ STAT, unsigned char* __restrict__ U8,
                                          const float* __restrict__ rw, const float* __restrict__ rb, int* __restrict__ TOPE, float* __restrict__ TOPG, int* __restrict__ POS, unsigned* CNT) {
    const int tid = wave * 64 + lane, fr = lane & 15, fq = lane >> 4;
    LAS unsigned* lcnt = (LAS unsigned*)(lds + LR_CNT);
    LAS unsigned* lrec = (LAS unsigned*)(lds + LR_REC);
    LAS float* part = (LAS float*)(lds + LR_PART); LAS float* logit = (LAS float*)(lds + LR_LOG);
    bf16x8 wh[4][2], wl[4][2];
#pragma unroll
    for (int s4 = 0; s4 < 4; ++s4)
#pragma unroll
        for (int nt = 0; nt < 2; ++nt) {
            float wv[8], wr[8];
#pragma unroll
            for (int j = 0; j < 8; ++j) { wv[j] = rw[(size_t)(128 * wave + 32 * s4 + 8 * fq + j) * NEXP + 16 * nt + fr]; wr[j] = wv[j] - bf2f(f2bf(wv[j])); }
            wh[s4][nt] = __builtin_bit_cast(bf16x8, pg8::pack8((f32x4){wv[0], wv[1], wv[2], wv[3]}, (f32x4){wv[4], wv[5], wv[6], wv[7]}));
            wl[s4][nt] = __builtin_bit_cast(bf16x8, pg8::pack8((f32x4){wr[0], wr[1], wr[2], wr[3]}, (f32x4){wr[4], wr[5], wr[6], wr[7]}));
        }
    const int Gb = G / NB, bb = bx / Gb, kb = bx - bb * Gb;
    const bool act = bb < NB;
    LAS float* par = (LAS float*)(lds + LR_PAR);
    if (act) { const float* m = mod_l + (size_t)bb * 6 * DM;
        for (int i = tid; i < DM / 4; i += NTHR) { *(LAS f32x4*)(par + 4 * i) = *(const f32x4*)(lng + 4 * i); *(LAS f32x4*)(par + DM + 4 * i) = *(const f32x4*)(lnb + 4 * i);
            *(LAS f32x4*)(par + 2 * DM + 4 * i) = *(const f32x4*)(m + 4 * DM + 4 * i) + 1.0f; *(LAS f32x4*)(par + 3 * DM + 4 * i) = *(const f32x4*)(m + 3 * DM + 4 * i); } }
    if (tid < 64) lcnt[tid] = 0u;
    __syncthreads();
    u32x2 vpre[2][4];
    const int sb0 = bb * (SEQ / 16) + kb;
    if (act && kb < SEQ / 16) {
#pragma unroll
        for (int rr = 0; rr < 2; ++rr)
#pragma unroll
            for (int j = 0; j < 4; ++j) vpre[rr][j] = *(const u32x2*)(V + (size_t)(sb0 * 16 + 2 * wave + rr) * DM + j * 256 + lane * 4);
    }
    int li = 0;
    for (int sq = act ? kb : SEQ / 16; sq < SEQ / 16; sq += Gb, ++li) {
        const int sb = bb * (SEQ / 16) + sq, rbase = sb * 16;
        int l4 = lane * 4; asm volatile("" : "+v"(l4));
#pragma unroll
        for (int rr = 0; rr < 2; ++rr) {
            const int r16 = 2 * wave + rr; const size_t row = (size_t)(rbase + r16);
            float v[16]; float s = 0.f;
#pragma unroll
            for (int j = 0; j < 4; ++j) { const u32x2 tb = vpre[rr][j]; const f32x4 t4 = (f32x4){__uint_as_float(tb.x << 16), __uint_as_float(tb.x & 0xffff0000u), __uint_as_float(tb.y << 16), __uint_as_float(tb.y & 0xffff0000u)};
                v[4 * j] = t4[0]; v[4 * j + 1] = t4[1]; v[4 * j + 2] = t4[2]; v[4 * j + 3] = t4[3]; s += (t4[0] + t4[1]) + (t4[2] + t4[3]); }
            const float mean = wave_sum_l(s, lane) * (1.f / DM); float q = 0.f;
#pragma unroll
            for (int i = 0; i < 16; ++i) { v[i] -= mean; q += v[i] * v[i]; }
            const float rstd = rsqrtf(wave_sum_l(q, lane) * (1.f / DM) + LN_EPS);
            if (lane == 0) *(pg8::f32x2*)(STAT + row * 2) = (pg8::f32x2){mean, rstd};
#pragma unroll
            for (int j = 0; j < 4; ++j) {
                const f32x4 g4 = *(const LAS f32x4*)(par + j * 256 + l4), b4 = *(const LAS f32x4*)(par + DM + j * 256 + l4), sc4 = *(const LAS f32x4*)(par + 2 * DM + j * 256 + l4), sh4 = *(const LAS f32x4*)(par + 3 * DM + j * 256 + l4);
                f32x4 xn, uu, ur;
#pragma unroll
                for (int c = 0; c < 4; ++c) { xn[c] = v[4 * j + c] * rstd * g4[c] + b4[c]; uu[c] = xn[c] * sc4[c] + sh4[c]; }
                u32x2 ub; ub.x = pg8::cvt_pk_bf16(uu[0], uu[1]); ub.y = pg8::cvt_pk_bf16(uu[2], uu[3]);
                *(unsigned*)(U8 + row * DM + j * 256 + l4) = pk4_fp8(uu[0], uu[1], uu[2], uu[3]);
                ur[0] = uu[0] - __uint_as_float(ub.x << 16); ur[1] = uu[1] - __uint_as_float(ub.x & 0xffff0000u); ur[2] = uu[2] - __uint_as_float(ub.y << 16); ur[3] = uu[3] - __uint_as_float(ub.y & 0xffff0000u);
                u32x2 ul; ul.x = pg8::cvt_pk_bf16(ur[0], ur[1]); ul.y = pg8::cvt_pk_bf16(ur[2], ur[3]);
                *(LAS u32x2*)(lds + LR_UH + r16 * LR_USTRIDE + (j * 256 + l4) * 2) = ub;
                *(LAS u32x2*)(lds + LR_UL + r16 * LR_USTRIDE + (j * 256 + l4) * 2) = ul;
            }
        }
        if (sq + Gb < SEQ / 16) {
#pragma unroll
            for (int rr = 0; rr < 2; ++rr)
#pragma unroll
                for (int j = 0; j < 4; ++j) vpre[rr][j] = *(const u32x2*)(V + (size_t)((sb + Gb) * 16 + 2 * wave + rr) * DM + j * 256 + l4);
        }
        __syncthreads();
        f32x4 acc0 = (f32x4){0.f, 0.f, 0.f, 0.f}, acc1 = (f32x4){0.f, 0.f, 0.f, 0.f};
#pragma unroll
        for (int s4 = 0; s4 < 4; ++s4) {
            const bf16x8 uh = *(const LAS bf16x8*)(lds + LR_UH + fr * LR_USTRIDE + (128 * wave + 32 * s4 + 8 * fq) * 2);
            const bf16x8 ul = *(const LAS bf16x8*)(lds + LR_UL + fr * LR_USTRIDE + (128 * wave + 32 * s4 + 8 * fq) * 2);
            acc0 = __builtin_amdgcn_mfma_f32_16x16x32_bf16(uh, wh[s4][0], acc0, 0, 0, 0); acc1 = __builtin_amdgcn_mfma_f32_16x16x32_bf16(uh, wh[s4][1], acc1, 0, 0, 0);
            acc0 = __builtin_amdgcn_mfma_f32_16x16x32_bf16(ul, wh[s4][0], acc0, 0, 0, 0); acc1 = __builtin_amdgcn_mfma_f32_16x16x32_bf16(ul, wh[s4][1], acc1, 0, 0, 0);
            acc0 = __builtin_amdgcn_mfma_f32_16x16x32_bf16(uh, wl[s4][0], acc0, 0, 0, 0); acc1 = __builtin_amdgcn_mfma_f32_16x16x32_bf16(uh, wl[s4][1], acc1, 0, 0, 0);
        }
#pragma unroll
        for (int r = 0; r < 4; ++r) { part[(wave * 16 + 4 * fq + r) * 32 + fr] = acc0[r]; part[(wave * 16 + 4 * fq + r) * 32 + 16 + fr] = acc1[r]; }
        __syncthreads();
        { const int rr = lane >> 5, e = lane & 31, r16 = 2 * wave + rr; const size_t row = (size_t)(rbase + r16);
            float sv = rb[e];
#pragma unroll
            for (int w8 = 0; w8 < 8; ++w8) sv += part[(w8 * 16 + r16) * 32 + e];
            logit[r16 * 32 + e] = sv;
            asm volatile("s_waitcnt lgkmcnt(0)" ::: "memory");
            int rank = 0;
#pragma unroll
            for (int e4 = 0; e4 < 8; ++e4) { const f32x4 t4 = *(const LAS f32x4*)(logit + r16 * 32 + 4 * e4);
#pragma unroll
                for (int c = 0; c < 4; ++c) { const int j = 4 * e4 + c; rank += (t4[c] > sv || (t4[c] == sv && j < e)) ? 1 : 0; } }
            LAS float* sel = logit + 512 + r16 * 4;
            if (rank < 4) sel[rank] = sv;
            asm volatile("s_waitcnt lgkmcnt(0)" ::: "memory");
            if (rank < 4) {
                const f32x4 t4 = *(const LAS f32x4*)sel;
                const float ex1 = __expf(t4[1] - t4[0]), ex2 = __expf(t4[2] - t4[0]), ex3 = __expf(t4[3] - t4[0]), inv = 1.0f / ((1.0f + ex1) + (ex2 + ex3));
                const unsigned k = __hip_atomic_fetch_add(lcnt + e, 1u, __ATOMIC_RELAXED, __HIP_MEMORY_SCOPE_WORKGROUP);
                lrec[(li * 16 + r16) * 4 + rank] = ((unsigned)e << 16) | k;
                TOPE[row * 4 + rank] = e; TOPG[row * 4 + rank] = __expf(sv - t4[0]) * inv;
            }
        }
        __syncthreads();
    }
    if (tid < NEXP) lcnt[32 + tid] = atomicAdd(&CNT[tid], lcnt[tid]);
    __syncthreads();
    for (int i = tid; i < li * 64; i += NTHR) { const unsigned rec = lrec[i]; const int sb = sb0 + (i >> 6) * Gb; POS[(size_t)sb * 64 + (i & 63)] = (int)(lcnt[32 + (rec >> 16)] + (rec & 0xffffu)); }
    __syncthreads();
}

__device__ __forceinline__ void unpack8(const u32x4 w, float (&f)[8]) {
#pragma unroll
    for (int c = 0; c < 4; ++c) { f[2 * c] = __uint_as_float(w[c] << 16); f[2 * c + 1] = __uint_as_float(w[c] & 0xffff0000u); }
}
__device__ __forceinline__ void unpack8_fp8(const u32x2 w, float (&f)[8]) {
#pragma unroll
    for (int c = 0; c < 2; ++c) { const auto lo = __builtin_amdgcn_cvt_pk_f32_fp8((int)w[c], false), hi = __builtin_amdgcn_cvt_pk_f32_fp8((int)w[c], true);
        f[4 * c] = lo[0]; f[4 * c + 1] = lo[1]; f[4 * c + 2] = hi[0]; f[4 * c + 3] = hi[1]; }
}
__device__ __forceinline__ void lnf_phase(LAS unsigned char* lds, const int wave, const int lane, const int bx, const int G, const unsigned char* __restrict__ YS, const int* __restrict__ SLOT, const float* __restrict__ TOPG,
                                          const float* __restrict__ lng, const float* __restrict__ lnb, const float* __restrict__ mod_l, const float* __restrict__ mod_n,
                                          const bf16_t* __restrict__ V, const float* __restrict__ STAT, const float* __restrict__ lmg, const float* __restrict__ lmb,
                                          bf16_t* __restrict__ X, bf16_t* __restrict__ U, float* __restrict__ out_final) {
    const int Gb = G / NB, bb = bx / Gb, kb = bx - bb * Gb, tid = wave * 64 + lane;
    if (bb >= NB) return;
    LAS float* par = (LAS float*)lds;
    { const float* m = mod_l + (size_t)bb * 6 * DM; const float* mn = mod_n + (size_t)bb * 6 * DM;
        for (int i = tid; i < DM / 4; i += NTHR) { *(LAS f32x4*)(par + 4 * i) = *(const f32x4*)(m + 5 * DM + 4 * i) + 1.0f; *(LAS f32x4*)(par + DM + 4 * i) = *(const f32x4*)(lng + 4 * i); *(LAS f32x4*)(par + 2 * DM + 4 * i) = *(const f32x4*)(lnb + 4 * i);
            *(LAS f32x4*)(par + 3 * DM + 4 * i) = *(const f32x4*)(lmg + 4 * i); *(LAS f32x4*)(par + 4 * DM + 4 * i) = *(const f32x4*)(lmb + 4 * i);
            if (!out_final) { *(LAS f32x4*)(par + 5 * DM + 4 * i) = *(const f32x4*)(mn + DM + 4 * i) + 1.0f; *(LAS f32x4*)(par + 6 * DM + 4 * i) = *(const f32x4*)(mn + 4 * i); } } }
    __syncthreads();
    for (int p = kb * NWAVES + wave; p < SEQ / 2; p += Gb * NWAVES) {
        const int row0 = bb * SEQ + 2 * p;
        int l8 = lane * 8; asm volatile("" : "+v"(l8));
        u32x4 sl[2]; f32x4 gk[2]; pg8::f32x2 st[2];
#pragma unroll
        for (int rr = 0; rr < 2; ++rr) { sl[rr] = *(const u32x4*)(SLOT + (size_t)(row0 + rr) * 4); gk[rr] = *(const f32x4*)(TOPG + (size_t)(row0 + rr) * 4) * 0.0625f; st[rr] = *(const pg8::f32x2*)(STAT + (size_t)(row0 + rr) * 2); }
        u32x2 yv[2][4][2]; u32x4 xv[2][2];
#pragma unroll
        for (int rr = 0; rr < 2; ++rr) {
#pragma unroll
            for (int k = 0; k < 4; ++k)
#pragma unroll
                for (int j = 0; j < 2; ++j) yv[rr][k][j] = *(const u32x2*)(YS + (size_t)sl[rr][k] * DM + j * 512 + l8);
#pragma unroll
            for (int j = 0; j < 2; ++j) xv[rr][j] = *(const u32x4*)(V + (size_t)(row0 + rr) * DM + j * 512 + l8);
        }
#pragma unroll
        for (int rr = 0; rr < 2; ++rr) {
            const size_t row = (size_t)(row0 + rr);
            float v[16]; float s = 0.f;
#pragma unroll
            for (int j = 0; j < 2; ++j) {
                float y[8], t[8], xs[8];
#pragma unroll
                for (int c = 0; c < 8; ++c) y[c] = 0.f;
#pragma unroll
                for (int k = 0; k < 4; ++k) { unpack8_fp8(yv[rr][k][j], t);
#pragma unroll
                    for (int c = 0; c < 8; ++c) y[c] += gk[rr][k] * t[c]; }
                unpack8(xv[rr][j], xs);
                { const f32x4 a0 = *(const LAS f32x4*)(par + 3 * DM + j * 512 + l8), a1 = *(const LAS f32x4*)(par + 3 * DM + j * 512 + l8 + 4), b0 = *(const LAS f32x4*)(par + 4 * DM + j * 512 + l8), b1 = *(const LAS f32x4*)(par + 4 * DM + j * 512 + l8 + 4);
#pragma unroll
                  for (int c = 0; c < 8; ++c) xs[c] = (xs[c] - st[rr].x) * st[rr].y * (c < 4 ? a0[c & 3] : a1[c & 3]) + (c < 4 ? b0[c & 3] : b1[c & 3]); }
                const f32x4 g0 = *(const LAS f32x4*)(par + j * 512 + l8), g1 = *(const LAS f32x4*)(par + j * 512 + l8 + 4);
#pragma unroll
                for (int c = 0; c < 8; ++c) { v[8 * j + c] = ALPHA * xs[c] + (c < 4 ? g0[c & 3] : g1[c & 3]) * y[c]; s += v[8 * j + c]; }
            }
            const float mean = wave_sum_l(s, lane) * (1.f / DM); float q = 0.f;
#pragma unroll
            for (int i = 0; i < 16; ++i) { v[i] -= mean; q += v[i] * v[i]; }
            const float rstd = rsqrtf(wave_sum_l(q, lane) * (1.f / DM) + LN_EPS);
#pragma unroll
            for (int j = 0; j < 2; ++j) {
                const f32x4 a0 = *(const LAS f32x4*)(par + DM + j * 512 + l8), a1 = *(const LAS f32x4*)(par + DM + j * 512 + l8 + 4), b0 = *(const LAS f32x4*)(par + 2 * DM + j * 512 + l8), b1 = *(const LAS f32x4*)(par + 2 * DM + j * 512 + l8 + 4);
                f32x4 x0, x1;
#pragma unroll
                for (int c = 0; c < 4; ++c) { x0[c] = v[8 * j + c] * rstd * a0[c] + b0[c]; x1[c] = v[8 * j + 4 + c] * rstd * a1[c] + b1[c]; }
                if (out_final) { *(f32x4*)(out_final + row * DM + j * 512 + l8) = x0; *(f32x4*)(out_final + row * DM + j * 512 + l8 + 4) = x1; }
                else {
                    *(u32x4*)(X + row * DM + j * 512 + l8) = pg8::pack8(x0, x1);
                    const f32x4 sc0 = *(const LAS f32x4*)(par + 5 * DM + j * 512 + l8), sc1 = *(const LAS f32x4*)(par + 5 * DM + j * 512 + l8 + 4), sh0 = *(const LAS f32x4*)(par + 6 * DM + j * 512 + l8), sh1 = *(const LAS f32x4*)(par + 6 * DM + j * 512 + l8 + 4);
                    *(u32x4*)(U + row * DM + j * 512 + l8) = pg8::pack8(x0 * sc0 + sh0, x1 * sc1 + sh1);
                }
            }
        }
    }
}

struct Params {
    const float *x_in, *c_in; const int* pos_in;
    const float *ada_w, *ada_b, *ln_mix_g, *ln_mix_b, *ln_ffn_g, *ln_ffn_b;
    const float *ev_w_in, *ev_conv_w, *ev_sg_w, *ev_sg_b, *ev_vn_g, *ev_vn_b, *ev_w_out;
    const float *od_w_in, *od_dw_w, *od_dw_b, *od_cn_g, *od_cn_b, *od_qn_g, *od_w_uq, *od_kvn_g, *od_w_ukv, *od_w_out;
    const float *r_w, *r_b, *w_gu, *b_gu, *w_dn, *b_dn;
    float* out; unsigned char* ws;
    int ph_lo, ph_hi;
};
constexpr int PH_PREP = 0, PH_MOD0 = 1, PH_LAYER0 = 2, PH_STRIDE = 16, PH_END = PH_LAYER0 + PH_STRIDE * (DEPTH - 1) + 10;
constexpr int LP_IN = 0, LP_MIX = 1, LP_UP = 2, LP_ATT = 3, LP_OUT = 4, LP_LNR = 5, LP_SCAT = 6, LP_M1 = 7, LP_M2 = 8, LP_LNF = 9;

enum { WM_ID = 0, WM_GU = 1, WM_EIN = 2, WM_OIN = 3, WM_UQ = 4, WM_UKV = 5 };
__device__ __forceinline__ int srccol(int mode, int pr) {
    const int tile = pr >> 8, r = pr & 255;
    switch (mode) {
        case WM_GU: return (r < 128 ? 0 : 1024) + tile * 128 + (r & 127);
        case WM_EIN: return (tile < 2 || tile >= 6) ? pr : ((r < 128 ? 512 : 1024) + (tile - 2) * 128 + (r & 127));
        case WM_OIN: if (tile < 4) return (r < 128 ? 0 : 512) + tile * 128 + (r & 127); if (tile == 4) return 1024 + r; return r < 128 ? 1280 + r : (r < 160 ? 1408 + (r - 128) : -1);
        case WM_UQ: { const int h = pr / 96, d = pr - 96 * h; return d < 64 ? pr : h * 96 + 64 + 16 * ((d - 64) & 1) + ((d - 64) >> 1); }
        case WM_UKV: { const int j = pr & 511, h = j >> 6, d = j & 63; return h * 128 + (pr < 512 ? 0 : 64) + d; }
        default: return pr;
    }
}
__device__ __forceinline__ void transpose_item(const float* W, int ldw, bf16_t* WT, int ldk, int k0, int n0, int mode, LAS float* scr, int lane) {
    if (mode == WM_UQ) {
        const int sc = srccol(mode, n0 + (lane & 31));
#pragma unroll 8
        for (int i = 0; i < 32; ++i) { const int kk = 2 * i + (lane >> 5); scr[kk * 33 + (lane & 31)] = W[(size_t)(k0 + kk) * ldw + sc]; }
    } else {
        const int c4 = (lane & 7) * 4, sc = srccol(mode, n0 + c4);
        f32x4 t[8];
#pragma unroll
        for (int i = 0; i < 8; ++i) { const int kk = 8 * i + (lane >> 3); t[i] = sc >= 0 ? __builtin_nontemporal_load((const f32x4*)(W + (size_t)(k0 + kk) * ldw + sc)) : (f32x4){0.f, 0.f, 0.f, 0.f}; }
#pragma unroll
        for (int i = 0; i < 8; ++i) { const int kk = 8 * i + (lane >> 3); LAS float* d = scr + kk * 33 + c4; d[0] = t[i][0]; d[1] = t[i][1]; d[2] = t[i][2]; d[3] = t[i][3]; }
    }
    asm volatile("s_waitcnt lgkmcnt(0)" ::: "memory");
    const int c = lane & 7;
#pragma unroll
    for (int j = 0; j < 4; ++j) { const int n = (lane >> 3) + 8 * j; const LAS float* s = scr + (8 * c) * 33 + n;
        u32x4 o; o.x = pg8::cvt_pk_bf16(s[0 * 33], s[1 * 33]); o.y = pg8::cvt_pk_bf16(s[2 * 33], s[3 * 33]); o.z = pg8::cvt_pk_bf16(s[4 * 33], s[5 * 33]); o.w = pg8::cvt_pk_bf16(s[6 * 33], s[7 * 33]);
        *(u32x4*)(WT + (size_t)(n0 + n) * ldk + k0 + 8 * c) = o; }
    asm volatile("s_waitcnt lgkmcnt(0)" ::: "memory");
}
__device__ __forceinline__ void transpose_item_f8(const float* W, int ldw, unsigned char* WT, int ldk, int k0, int n0, int mode, float mul, LAS float* scr, int lane) {
    const int c4 = (lane & 7) * 4, sc = srccol(mode, n0 + c4);
    f32x4 t[8];
#pragma unroll
    for (int i = 0; i < 8; ++i) { const int kk = 8 * i + (lane >> 3); t[i] = __builtin_nontemporal_load((const f32x4*)(W + (size_t)(k0 + kk) * ldw + sc)); }
#pragma unroll
    for (int i = 0; i < 8; ++i) { const int kk = 8 * i + (lane >> 3); LAS float* d = scr + kk * 33 + c4; d[0] = t[i][0] * mul; d[1] = t[i][1] * mul; d[2] = t[i][2] * mul; d[3] = t[i][3] * mul; }
    asm volatile("s_waitcnt lgkmcnt(0)" ::: "memory");
    const int c = lane & 3;
#pragma unroll
    for (int j = 0; j < 2; ++j) { const int n = (lane >> 2) + 16 * j; const LAS float* s = scr + (16 * c) * 33 + n;
        u32x4 o; o.x = pk4_fp8(s[0 * 33], s[1 * 33], s[2 * 33], s[3 * 33]); o.y = pk4_fp8(s[4 * 33], s[5 * 33], s[6 * 33], s[7 * 33]);
        o.z = pk4_fp8(s[8 * 33], s[9 * 33], s[10 * 33], s[11 * 33]); o.w = pk4_fp8(s[12 * 33], s[13 * 33], s[14 * 33], s[15 * 33]);
        *(u32x4*)(WT + (size_t)(n0 + n) * ldk + k0 + 16 * c) = o; }
    asm volatile("s_waitcnt lgkmcnt(0)" ::: "memory");
}
__device__ __forceinline__ bool prep_family_f8(int& it, const float* W, size_t wstride, int ldw, int K, int nphys, unsigned char* WT, size_t tstride, int ldk, int nmat, int mode, float mul, LAS float* scr, int lane) {
    const int nblk = nphys / 32, per = (K / 64) * nblk, tot = per * nmat;
    if (it >= tot) { it -= tot; return false; }
    const int mi = it / per, r = it % per, kb = r / nblk, nb = r % nblk;
    transpose_item_f8(W + (size_t)mi * wstride, ldw, WT + (size_t)mi * tstride, ldk, kb * 64, nb * 32, mode, mul, scr, lane);
    return true;
}
__device__ __forceinline__ bool prep_family(int& it, const float* W, size_t wstride, int ldw, int K, int nphys, bf16_t* WT, size_t tstride, int ldk, int koff, int nmat, int mode, LAS float* scr, int lane) {
    const int nblk = nphys / 32, per = (K / 64) * nblk, tot = per * nmat;
    if (it >= tot) { it -= tot; return false; }
    const int mi = it / per, r = it % per, kb = r / nblk, nb = r % nblk;
    transpose_item(W + (size_t)mi * wstride, ldw, WT + (size_t)mi * tstride + koff, ldk, kb * 64, nb * 32, mode, scr, lane);
    return true;
}


struct F8Item { const float* src; unsigned char* dst; float mul; };
constexpr int F8_SCR = 128 * 33 * 4;
__device__ __forceinline__ F8Item f8_item(const Params& P, unsigned char* ws, int it, int lane) {
    F8Item r; const int c4 = (lane & 7) * 4;
    if (it < 128 * 512) { const int mi = it >> 9, q = it & 511, k0 = (q >> 6) * 128, n0 = (q & 63) * 32;
        r.src = P.w_gu + (size_t)mi * DM * 2048 + (size_t)(k0 + (lane >> 3)) * 2048 + srccol(WM_GU, n0 + c4);
        r.dst = ws + WT_GU + (size_t)mi * 2048 * DM + (size_t)(n0 + (lane >> 3)) * DM + k0 + 16 * (lane & 7); r.mul = (float)(1 << W8_GU_SH); }
    else { const int i2 = it - 128 * 512, mi = i2 >> 8, q = i2 & 255, k0 = (q >> 5) * 128, n0 = (q & 31) * 32;
        r.src = P.w_dn + (size_t)mi * DM * DM + (size_t)(k0 + (lane >> 3)) * DM + n0 + c4;
        r.dst = ws + WT_DN + (size_t)mi * DM * DM + (size_t)(n0 + (lane >> 3)) * DM + k0 + 16 * (lane & 7); r.mul = (float)(1 << W8_DN_SH); }
    return r;
}
constexpr int F8_ITEMS_GU = 32 * 512, F8_ITEMS_DN = 32 * 256, F8_ITEMS_LAYER = F8_ITEMS_GU + F8_ITEMS_DN;
__device__ __forceinline__ int f8_item_id(int layer, int j) { return j < F8_ITEMS_GU ? layer * F8_ITEMS_GU + j : DEPTH * F8_ITEMS_GU + layer * F8_ITEMS_DN + (j - F8_ITEMS_GU); }
__device__ __forceinline__ void f8_convert(const Params& P, unsigned char* ws, LAS float* scr, int lane, int it) {
    const F8Item cur = f8_item(P, ws, it, lane);
    const int ldw = it < 128 * 512 ? 2048 : DM;
    f32x4 t[16];
#pragma unroll
    for (int i = 0; i < 16; ++i) t[i] = __builtin_nontemporal_load((const f32x4*)(cur.src + (size_t)(8 * i) * ldw));
    const int c4 = (lane & 7) * 4;
#pragma unroll
    for (int i = 0; i < 16; ++i) { const int kk = 8 * i + (lane >> 3); LAS float* d = scr + kk * 33 + c4; d[0] = t[i][0] * cur.mul; d[1] = t[i][1] * cur.mul; d[2] = t[i][2] * cur.mul; d[3] = t[i][3] * cur.mul; }
    asm volatile("s_waitcnt lgkmcnt(0)" ::: "memory");
#pragma unroll
    for (int j = 0; j < 4; ++j) { const LAS float* sp = scr + (16 * (lane & 7)) * 33 + (lane >> 3) + 8 * j;
        u32x4 o; o.x = pk4_fp8(sp[0 * 33], sp[1 * 33], sp[2 * 33], sp[3 * 33]); o.y = pk4_fp8(sp[4 * 33], sp[5 * 33], sp[6 * 33], sp[7 * 33]);
        o.z = pk4_fp8(sp[8 * 33], sp[9 * 33], sp[10 * 33], sp[11 * 33]); o.w = pk4_fp8(sp[12 * 33], sp[13 * 33], sp[14 * 33], sp[15 * 33]);
        *(u32x4*)(cur.dst + (size_t)(8 * j) * DM) = o; }
    asm volatile("s_waitcnt lgkmcnt(0)" ::: "memory");
}
struct SparePlan { int g1, q1, g2, q2, done; };
__device__ __forceinline__ SparePlan spare_plan(int nM, int G) {
    SparePlan p; const int n1 = nM * 8, r1 = (n1 + G - 1) / G, n2 = nM * 4, r2 = (n2 + G - 1) / G;
    p.g1 = (n1 + r1 - 1) / r1; p.q1 = 32 * r1; p.g2 = (n2 + r2 - 1) / r2; p.q2 = 40 * r2;
    const int d = (G - p.g1) * p.q1 + (G - p.g2) * p.q2; p.done = d < F8_ITEMS_LAYER ? d : F8_ITEMS_LAYER; return p;
}
__device__ __forceinline__ void f8_convert_range(const Params& P, unsigned char* ws, LAS float* scr, int lane, int wave, int layer, int j0, int j1) {
    if (j1 > F8_ITEMS_LAYER) j1 = F8_ITEMS_LAYER;
    for (int j = j0 + wave; j < j1; j += NWAVES) f8_convert(P, ws, scr, lane, f8_item_id(layer, j));
}
#define PH_LOCALS \
    __attribute__((address_space(1))) unsigned char* wsg = (__attribute__((address_space(1))) unsigned char*)P.ws; asm volatile("" : "+s"(wsg)); unsigned char* ws = (unsigned char*)wsg;     \
    const int lane = lane_id_asm(); \
    int wave = wave0; asm volatile("" : "+s"(wave)); const int tid = wave * 64 + lane; \
    int bx = blockIdx.x, G = gridDim.x; asm volatile("" : "+s"(bx), "+s"(G)); \
    const int gw = bx * NWAVES + wave, NW = G * NWAVES; \
    const size_t gtid = (size_t)bx * NTHR + tid, GT = (size_t)G * NTHR; \
    unsigned* ctl = (unsigned*)(ws + WS_CTL); \
    float* MOD = (float*)(ws + WS_MOD); float* CS = (float*)(ws + WS_CS); float* X = (float*)(ws + WS_X); float* V = (float*)(ws + WS_V); \
    bf16_t* U = (bf16_t*)(ws + WS_U); bf16_t* Y = (bf16_t*)(ws + WS_Y); bf16_t* BG = (bf16_t*)(ws + WS_BG); bf16_t* CX = (bf16_t*)(ws + WS_CX); bf16_t* GZU = (bf16_t*)(ws + WS_GZU); bf16_t* GZV = (bf16_t*)(ws + WS_GZV); \
    bf16_t* GLU = (bf16_t*)(ws + WS_GLU); bf16_t* CQKV = (bf16_t*)(ws + WS_CQKV); bf16_t* CQKVN = (bf16_t*)(ws + WS_CQKVN); bf16_t* KRR = (bf16_t*)(ws + WS_KRR); bf16_t* KR = (bf16_t*)(ws + WS_KR); \
    bf16_t* Q = (bf16_t*)(ws + WS_Q); bf16_t* KN = (bf16_t*)(ws + WS_KN); bf16_t* VV = (bf16_t*)(ws + WS_VV); \
    int* TOPE = (int*)(ws + WS_TOPE); float* TOPG = (float*)(ws + WS_TOPG); int* POS = (int*)(ws + WS_POS); int* SLOT = (int*)(ws + WS_SLOT); int* ROWTOK = (int*)(ws + WS_ROWTOK); \
    bf16_t* H = (bf16_t*)(ws + WS_H); unsigned char* YS = (unsigned char*)(ws + WS_YS); \
    (void)lane; (void)wave; (void)gw; (void)NW; (void)gtid; (void)GT; (void)ctl; (void)MOD; (void)CS; (void)X; (void)V; (void)U; (void)Y; (void)BG; (void)CX; (void)GZU; (void)GZV; (void)GLU; (void)CQKV; (void)CQKVN; \
    (void)KRR; (void)KR; (void)Q; (void)KN; (void)VV; (void)TOPE; (void)TOPG; (void)POS; (void)SLOT; (void)ROWTOK; (void)H; (void)YS
#define LY_LOCALS \
    int ly = layer; asm volatile("" : "+s"(ly)); const int li = ly >> 1; \
    const float* mod_l = MOD + (size_t)ly * NB * 6 * DM; const float* mod_n = MOD + (size_t)(ly + 1) * NB * 6 * DM; \
    const float* xres = ly == 0 ? P.x_in : X; \
    unsigned* CNT = ctl + CW_CNT + ly * 32; unsigned* OFFS = ctl + CW_OFFS + ly * 64; \
    (void)li; (void)mod_l; (void)mod_n; (void)xres; (void)CNT; (void)OFFS

__global__ void __launch_bounds__(NTHR, 2) mega(Params P) {
    extern __shared__ __attribute__((aligned(16))) unsigned char lds_raw[];
    LAS unsigned char* lds = (LAS unsigned char*)lds_raw;
    volatile LAS unsigned* MISC = (volatile LAS unsigned*)(lds + MISC_OFF);
    for (int u = threadIdx.x; u < (LDS_BYTES - MISC_OFF) / 4; u += NTHR) ((LAS unsigned*)(lds + MISC_OFF))[u] = 0u;
    __syncthreads();
    const int wave0 = __builtin_amdgcn_readfirstlane((int)(threadIdx.x >> 6));
    XcdBarrier bar = xcd_barrier_post((unsigned*)(P.ws + WS_CTL) + CW_BAR, MISC + 8, wave0);
    const int lo = P.ph_lo, hi = P.ph_hi;
#define IN(k) (lo <= (k) && (k) < hi)
#define SEAM(k) do { if ((k) + 1 < hi) xcd_barrier(bar); } while (0)

    if (IN(PH_PREP)) {
        PH_LOCALS;
        LAS float* scr = (LAS float*)(lds + wave * F8_SCR);
        for (int j = gw; j < F8_ITEMS_LAYER; j += NW) f8_convert(P, ws, scr, lane, f8_item_id(0, j));
        constexpr int NITEMS = 2 * 1280 + 2 * 512 + 2 * 768 + 2 * 96 + 2 * 64 + 2 * 512;
        for (int it0 = gw; it0 < NITEMS; it0 += NW) {
            int it = it0;
            if (prep_family(it, P.ev_w_in, (size_t)DM * 2560, 2560, DM, 2560, (bf16_t*)(ws + WT_EIN), (size_t)2560 * DM, DM, 0, 2, WM_EIN, scr, lane)) continue;
            if (prep_family(it, P.ev_w_out, (size_t)DM * DM, DM, DM, DM, (bf16_t*)(ws + WT_EOUT), (size_t)DM * DM, DM, 0, 2, WM_ID, scr, lane)) continue;
            if (prep_family(it, P.od_w_in, (size_t)DM * 1440, 1440, DM, 1536, (bf16_t*)(ws + WT_OIN), (size_t)1536 * DM, DM, 0, 2, WM_OIN, scr, lane)) continue;
            if (prep_family(it, P.od_w_uq, (size_t)256 * 768, 768, 256, 768, (bf16_t*)(ws + WT_OUP), (size_t)1792 * 256, 256, 0, 2, WM_UQ, scr, lane)) continue;
            if (prep_family(it, P.od_w_ukv, (size_t)128 * 1024, 1024, 128, 1024, (bf16_t*)(ws + WT_OUP) + (size_t)768 * 256, (size_t)1792 * 256, 256, 128, 2, WM_UKV, scr, lane)) continue;
            prep_family(it, P.od_w_out, (size_t)DM * DM, DM, DM, DM, (bf16_t*)(ws + WT_OOUT), (size_t)DM * DM, DM, 0, 2, WM_ID, scr, lane);
        }
        for (size_t i = gtid; i < (size_t)2 * 1792 * 256; i += GT) { const int col = (int)(i & 255), row = (int)((i >> 8) % 1792); if (row >= 768 && col < 128) ((bf16_t*)(ws + WT_OUP))[i] = 0; }
        for (size_t i = gtid; i < (size_t)2 * 8 * 128 * 128; i += GT) { const int jj = (int)(i & 127), ii = (int)((i >> 7) & 127); ((bf16_t*)(ws + WT_SGW))[i] = jj <= ii ? f2bf(P.ev_sg_w[i]) : (bf16_t)0; }
        for (size_t i = gtid; i < (size_t)NT * 16; i += GT) { const int tok = (int)(i >> 4), f = (int)(i & 15); float c, s; sincos_d((double)P.pos_in[tok] * INVF[f], c, s); CS[(size_t)tok * 32 + f] = c; CS[(size_t)tok * 32 + 16 + f] = s; }
        __syncthreads();
        {
            LAS float* sc = (LAS float*)lds;
            LAS float* red = (LAS float*)(lds + 32768);
            for (int i = tid; i < NB * DM; i += NTHR) { const float v = P.c_in[i]; sc[i] = v * sigmoidf_(v); }
            __syncthreads();
            for (int item = bx; item < DEPTH * 6 * DM / 64; item += G) {
                const int col = item * 64 + (tid & 63), l = col / (6 * DM), n = col % (6 * DM), kg = tid >> 6;
                float a[NB];
#pragma unroll
                for (int b = 0; b < NB; ++b) a[b] = 0.f;
                const float* w = P.ada_w + (size_t)l * DM * 6 * DM + (size_t)(kg * 128) * 6 * DM + n;
                for (int k = 0; k < 128; ++k) { const float wv = w[(size_t)k * 6 * DM];
#pragma unroll
                    for (int b = 0; b < NB; ++b) a[b] += sc[b * DM + kg * 128 + k] * wv; }
#pragma unroll
                for (int b = 0; b < NB; ++b) red[(kg * NB + b) * 64 + (tid & 63)] = a[b];
                __syncthreads();
                { const int b = tid >> 6, cc = tid & 63; float s = 0.f;
#pragma unroll
                    for (int k8 = 0; k8 < 8; ++k8) s += red[(k8 * NB + b) * 64 + cc];
                    const int col2 = item * 64 + cc, l2 = col2 / (6 * DM), n2 = col2 % (6 * DM);
                    MOD[((size_t)l2 * NB + b) * 6 * DM + n2] = s + P.ada_b[(size_t)l2 * 6 * DM + n2]; }
                __syncthreads();
            }
        }
        SEAM(PH_PREP);
    }
    if (IN(PH_MOD0)) {
        PH_LOCALS;
        for (size_t i = gtid * 4; i < (size_t)NT * DM; i += GT * 4) { const int tok = (int)(i / DM), col = (int)(i % DM), b = tok / SEQ; const float* m = MOD + (size_t)b * 6 * DM;
            const float4 xv = *(const float4*)(P.x_in + i), sc = *(const float4*)(m + DM + col), sh = *(const float4*)(m + col);
            ushort4 o; o.x = f2bf(xv.x * (1.f + sc.x) + sh.x); o.y = f2bf(xv.y * (1.f + sc.y) + sh.y); o.z = f2bf(xv.z * (1.f + sc.z) + sh.z); o.w = f2bf(xv.w * (1.f + sc.w) + sh.w);
            *(ushort4*)(U + i) = o; }
        SEAM(PH_MOD0);
    }

    for (int layer = 0; layer < DEPTH; ++layer) {
        const int pb = PH_LAYER0 + PH_STRIDE * layer;
        if ((layer & 1) == 0) {
            if (IN(pb + LP_IN)) {
                PH_LOCALS; LY_LOCALS;
                pg8::Gemm g{U, DM, nullptr, (const bf16_t*)(ws + WT_EIN) + (size_t)li * 2560 * DM, DM, 0, DM};
                pg8::Sched S; S.init(NT / 256, 10, G, bx, nullptr);
                pg8::EpiE1 E{BG, CX, GZU, GZV};
                pg8::gemm_phase(lds, wave, g, S, E);
                SEAM(pb + LP_IN);
            }
            if (IN(pb + LP_MIX)) {
                PH_LOCALS; LY_LOCALS;
                even_mix_phase(lds, wave, lane, bx, G, BG, CX, GZU, GZV, (const bf16_t*)(ws + WT_SGW) + (size_t)li * 8 * 128 * 128, P.ev_conv_w + (size_t)li * 3 * 512, P.ev_sg_b + (size_t)li * 8 * 128,
                               P.ev_vn_g + (size_t)li * 512, P.ev_vn_b + (size_t)li * 512, Y);
                SEAM(pb + LP_MIX);
            }
        } else {
            if (IN(pb + LP_IN)) {
                PH_LOCALS; LY_LOCALS;
                pg8::Gemm g{U, DM, nullptr, (const bf16_t*)(ws + WT_OIN) + (size_t)li * 1536 * DM, DM, 0, DM};
                pg8::Sched S; S.init(NT / 256, 6, G, bx, nullptr);
                pg8::EpiO1 E{GLU, CQKV, KRR};
                pg8::gemm_phase(lds, wave, g, S, E);
                SEAM(pb + LP_IN);
            }
            if (IN(pb + LP_MIX)) {
                PH_LOCALS; LY_LOCALS;
                odd_mix_phase(lds, wave, lane, bx, G, GLU, CQKV, KRR, CS, P.od_dw_w + (size_t)li * 31 * 512, P.od_dw_b + (size_t)li * 512, P.od_cn_g + (size_t)li * 512, P.od_cn_b + (size_t)li * 512,
                              P.od_qn_g + (size_t)li * 256, P.od_kvn_g + (size_t)li * 128, Y, CQKVN, KR);
                SEAM(pb + LP_MIX);
            }
            if (IN(pb + LP_UP)) {
                PH_LOCALS; LY_LOCALS;
                pg8::Gemm g{CQKVN, 384, nullptr, (const bf16_t*)(ws + WT_OUP) + (size_t)li * 1792 * 256, 256, 0, 256, 3, 128};
                pg8::Sched S; S.init(NT / 256, 7, G, bx, nullptr);
                pg8::EpiO3 E{Q, KN, VV, CS};
                pg8::gemm_phase(lds, wave, g, S, E);
                SEAM(pb + LP_UP);
            }
            if (IN(pb + LP_ATT)) {
                PH_LOCALS; LY_LOCALS;
                attn_phase(lds, wave, lane, bx, G, Q, KN, KR, VV, Y);
                SEAM(pb + LP_ATT);
            }
        }
        if (IN(pb + LP_OUT)) {
                PH_LOCALS; LY_LOCALS;
            pg8::Gemm g{Y, DM, nullptr, (const bf16_t*)(ws + ((ly & 1) ? WT_OOUT : WT_EOUT)) + (size_t)li * DM * DM, DM, 0, DM};
            pg8::Sched S; S.init(NT / 256, 4, G, bx, nullptr);
            if (ly == 0) { pg8::EpiOut<true> E{P.x_in, mod_l + 2 * DM, (bf16_t*)V}; pg8::gemm_phase(lds, wave, g, S, E); }
            else { pg8::EpiOut<false> E{X, mod_l + 2 * DM, (bf16_t*)V}; pg8::gemm_phase(lds, wave, g, S, E); }
            SEAM(pb + LP_OUT);
        }
        if (IN(pb + LP_LNR)) {
                PH_LOCALS; LY_LOCALS;
            lnr_phase(lds, wave, lane, bx, G, (const bf16_t*)V, P.ln_mix_g + (size_t)ly * DM, P.ln_mix_b + (size_t)ly * DM, mod_l, (float*)(ws + WS_STAT), ws + WS_U8, P.r_w + (size_t)ly * DM * NEXP, P.r_b + (size_t)ly * NEXP, TOPE, TOPG, POS, CNT);
            SEAM(pb + LP_LNR);
        }
        if (IN(pb + LP_SCAT)) {
                PH_LOCALS; LY_LOCALS;
            LAS unsigned char* l2 = lds; asm volatile("" : "+v"(l2));
            volatile LAS unsigned* offs = (volatile LAS unsigned*)(l2 + MISC_OFF) + 64;
            if (tid == 0) { unsigned o = 0; for (int e = 0; e < NEXP; ++e) { const unsigned c = CNT[e]; offs[48 + e] = c; offs[e] = o; o += (c + 255u) & ~255u; } offs[NEXP] = o; }
            __syncthreads();
            if (bx == 0 && tid <= NEXP) OFFS[tid] = offs[tid];
            for (size_t a = gtid; a < (size_t)NASSIGN; a += GT) { const int e = TOPE[a]; const int slot = (int)offs[e] + POS[a]; SLOT[a] = slot; ROWTOK[slot] = (int)(a >> 2); }
            for (int e = 0; e < NEXP; ++e) for (size_t s = offs[e] + offs[48 + e] + gtid; s < offs[e + 1]; s += GT) ROWTOK[s] = 0;
            __syncthreads();
            if (ly > 0) {
                const int nMp = __builtin_amdgcn_readfirstlane((int)(ctl[CW_OFFS + (ly - 1) * 64 + NEXP] >> 8));
                const SparePlan sp = spare_plan(nMp, G);
                LAS float* scr = (LAS float*)(lds + wave * F8_SCR);
                for (int j = sp.done + gw; j < F8_ITEMS_LAYER; j += NW) f8_convert(P, ws, scr, lane, f8_item_id(ly, j));
                __syncthreads();
            }
            SEAM(pb + LP_SCAT);
        }
        if (IN(pb + LP_M1)) {
                PH_LOCALS; LY_LOCALS;
            const int nM = __builtin_amdgcn_readfirstlane((int)(OFFS[NEXP] >> 8));
            LAS int* tile_e = (LAS int*)(lds + MISC_OFF + 1024);
            for (int pm = tid; pm < nM; pm += NTHR) { const unsigned rowb = (unsigned)pm * 256u; int e = 0;
                for (int j = 1; j < NEXP; ++j) e += (rowb >= OFFS[j]) ? 1 : 0;
                tile_e[pm] = e; }
            __syncthreads();
            pg8::Gemm g{(const bf16_t*)(ws + WS_U8), DM / 2, ROWTOK, (const bf16_t*)(ws + WT_GU) + (size_t)ly * NEXP * 2048 * (DM / 2), DM / 2, (size_t)2048 * (DM / 2), DM / 2};
            const SparePlan sp = spare_plan(nM, G);
            if (bx < sp.g1) {
                pg8::Sched S; S.init(nM, 8, sp.g1, bx, tile_e);
                pg8::EpiM1 E{P.b_gu + (size_t)ly * NEXP * 2048, (unsigned char*)H, lds};
                pg8::gemm_phase<pg8::EpiM1, 127 - W8_GU_SH>(lds, wave, g, S, E);
            } else if (ly + 1 < DEPTH) { const int k = bx - sp.g1; f8_convert_range(P, ws, (LAS float*)(lds + wave * F8_SCR), lane, wave, ly + 1, k * sp.q1, (k + 1) * sp.q1); }
            SEAM(pb + LP_M1);
        }
        if (IN(pb + LP_M2)) {
                PH_LOCALS; LY_LOCALS;
            const int nM = __builtin_amdgcn_readfirstlane((int)(OFFS[NEXP] >> 8));
            LAS int* tile_e = (LAS int*)(lds + MISC_OFF + 1024);
            for (int pm = tid; pm < nM; pm += NTHR) { const unsigned rowb = (unsigned)pm * 256u; int e = 0;
                for (int j = 1; j < NEXP; ++j) e += (rowb >= OFFS[j]) ? 1 : 0;
                tile_e[pm] = e; }
            __syncthreads();
            pg8::Gemm g{H, DM / 2, nullptr, (const bf16_t*)(ws + WT_DN) + (size_t)ly * NEXP * DM * (DM / 2), DM / 2, (size_t)DM * (DM / 2), DM / 2};
            const SparePlan sp = spare_plan(nM, G);
            if (bx < sp.g2) {
                pg8::Sched S; S.init(nM, 4, sp.g2, bx, tile_e);
                pg8::EpiM2 E{P.b_dn + (size_t)ly * NEXP * DM, YS, lds};
                pg8::gemm_phase<pg8::EpiM2, 127 - W8_DN_SH>(lds, wave, g, S, E);
            } else if (ly + 1 < DEPTH) { const int k = bx - sp.g2, first = (G - sp.g1) * sp.q1; f8_convert_range(P, ws, (LAS float*)(lds + wave * F8_SCR), lane, wave, ly + 1, first + k * sp.q2, first + (k + 1) * sp.q2); }
            SEAM(pb + LP_M2);
        }
        if (IN(pb + LP_LNF)) {
                PH_LOCALS; LY_LOCALS;
            const float* lng = P.ln_ffn_g + (size_t)ly * DM; const float* lnb = P.ln_ffn_b + (size_t)ly * DM;
            float* out_final = ly == DEPTH - 1 ? P.out : nullptr;
            lnf_phase(lds, wave, lane, bx, G, YS, SLOT, TOPG, lng, lnb, mod_l, mod_n, (const bf16_t*)V, (const float*)(ws + WS_STAT), P.ln_mix_g + (size_t)ly * DM, P.ln_mix_b + (size_t)ly * DM, (bf16_t*)X, U, out_final);
            SEAM(pb + LP_LNF);
        }
    }
#undef IN
#undef SEAM
}

extern "C" void kernel_launch(void* const* d_in, const int* in_sizes, int n_in, void* d_out, int out_size, void* d_ws, size_t ws_size, hipStream_t stream) {
    if (n_in != 32 || in_sizes[0] != NT * DM || out_size != NT * DM || ws_size < WS_END) { fprintf(stderr, "kernel_launch: built for 32 inputs, x / out of %d floats and >= %zu bytes of workspace; got n_in %d, out %d, ws %zu; nothing launched\n", NT * DM, (size_t)WS_END, n_in, out_size, ws_size); return; }
    static int grid = 0;
    if (grid == 0) {
        int dev = 0, cus = 0;
        if (hipGetDevice(&dev) != hipSuccess || hipDeviceGetAttribute(&cus, hipDeviceAttributeMultiprocessorCount, dev) != hipSuccess) { fprintf(stderr, "kernel_launch: device query failed; nothing launched\n"); grid = -1; return; }
        if (hipFuncSetAttribute((const void*)mega, hipFuncAttributeMaxDynamicSharedMemorySize, LDS_BYTES) != hipSuccess) { fprintf(stderr, "kernel_launch: hipFuncSetAttribute(%d B of dynamic LDS) failed; nothing launched\n", LDS_BYTES); grid = -1; return; }
        int per_cu = 0;
        if (hipOccupancyMaxActiveBlocksPerMultiprocessor(&per_cu, (const void*)mega, NTHR, LDS_BYTES) != hipSuccess || per_cu < 1) { fprintf(stderr, "kernel_launch: the occupancy query reports %d workgroups per CU; nothing launched\n", per_cu); (void)hipGetLastError(); grid = -1; return; }
        (void)hipGetLastError();
        grid = cus;
    }
    if (grid < 0) return;
    (void)hipMemsetAsync((unsigned char*)d_ws + WS_CTL, 0, 1 * MiB, stream);
    Params P{};
    P.x_in = (const float*)d_in[0]; P.c_in = (const float*)d_in[1]; P.pos_in = (const int*)d_in[2]; P.ada_w = (const float*)d_in[3]; P.ada_b = (const float*)d_in[4];
    P.ln_mix_g = (const float*)d_in[5]; P.ln_mix_b = (const float*)d_in[6]; P.ln_ffn_g = (const float*)d_in[7]; P.ln_ffn_b = (const float*)d_in[8];
    P.ev_w_in = (const float*)d_in[9]; P.ev_conv_w = (const float*)d_in[10]; P.ev_sg_w = (const float*)d_in[11]; P.ev_sg_b = (const float*)d_in[12]; P.ev_vn_g = (const float*)d_in[13]; P.ev_vn_b = (const float*)d_in[14]; P.ev_w_out = (const float*)d_in[15];
    P.od_w_in = (const float*)d_in[16]; P.od_dw_w = (const float*)d_in[17]; P.od_dw_b = (const float*)d_in[18]; P.od_cn_g = (const float*)d_in[19]; P.od_cn_b = (const float*)d_in[20]; P.od_qn_g = (const float*)d_in[21];
    P.od_w_uq = (const float*)d_in[22]; P.od_kvn_g = (const float*)d_in[23]; P.od_w_ukv = (const float*)d_in[24]; P.od_w_out = (const float*)d_in[25];
    P.r_w = (const float*)d_in[26]; P.r_b = (const float*)d_in[27]; P.w_gu = (const float*)d_in[28]; P.b_gu = (const float*)d_in[29]; P.w_dn = (const float*)d_in[30]; P.b_dn = (const float*)d_in[31];
    P.out = (float*)d_out; P.ws = (unsigned char*)d_ws; P.ph_lo = 0; P.ph_hi = PH_END;
    hipLaunchKernelGGL(mega, dim3(grid), dim3(NTHR), LDS_BYTES, stream, P);
}
```

```cpp
#include <hip/hip_runtime.h>
#include <cstdio>
#include <cstdint>

constexpr int NB = 8, SEQ = 4096, DM = 1024, NT = NB * SEQ, DEPTH = 4;
constexpr int NEXP = 32, TOPK = 4, NASSIGN = NT * TOPK;
constexpr int NSLOT = NASSIGN + NEXP * 256;
constexpr float ALPHA = 1.681792830507429f;
constexpr float LN_EPS = 1e-5f, RMS_EPS = 1e-6f;
constexpr float QSCALE = 0.1472444460259031f;

typedef unsigned short bf16_t;
__device__ __forceinline__ float bf2f(bf16_t v) { return __uint_as_float(((unsigned)v) << 16); }
__device__ __forceinline__ bf16_t f2bf(float f) { unsigned u = __float_as_uint(f); u += 0x7fffu + ((u >> 16) & 1u); return (bf16_t)(u >> 16); }
__device__ __forceinline__ float wave_sum(float v) {
#pragma unroll
    for (int o = 1; o < 64; o <<= 1) v += __shfl_xor(v, o);
    return v;
}
__device__ __forceinline__ float gelu_erf(float x) { return 0.5f * x * (1.0f + erff(x * 0.70710678118654752f)); }
__device__ __forceinline__ float sigmoidf_(float x) { return 1.0f / (1.0f + __expf(-x)); }

constexpr size_t MiB = 1ull << 20;
constexpr size_t WS_CTL = 0;
constexpr size_t WS_MOD = 1 * MiB;
constexpr size_t WS_CS = 2 * MiB;
constexpr size_t WS_X = 8 * MiB;
constexpr size_t WS_V = 136 * MiB;
constexpr size_t WS_U = 264 * MiB;
constexpr size_t WS_Y = 328 * MiB;
constexpr size_t WS_BG = 392 * MiB;
constexpr size_t WS_CX = 424 * MiB;
constexpr size_t WS_GZU = 456 * MiB;
constexpr size_t WS_GZV = 488 * MiB;
constexpr size_t WS_GLU = 520 * MiB;
constexpr size_t WS_CQKV = 552 * MiB;
constexpr size_t WS_CQKVN = 584 * MiB;
constexpr size_t WS_KRR = 616 * MiB;
constexpr size_t WS_KR = 620 * MiB;
constexpr size_t WS_Q = 624 * MiB;
constexpr size_t WS_KN = 672 * MiB;
constexpr size_t WS_VV = 704 * MiB;
constexpr size_t WS_TOPE = 736 * MiB;
constexpr size_t WS_TOPG = 737 * MiB;
constexpr size_t WS_POS = 738 * MiB;
constexpr size_t WS_SLOT = 739 * MiB;
constexpr size_t WS_ROWTOK = 740 * MiB;
constexpr size_t WS_STAT = 741 * MiB;
constexpr size_t WS_H = 744 * MiB;
constexpr size_t WS_YS = 1016 * MiB;
constexpr size_t WS_WT = 1288 * MiB;
constexpr size_t WS_U8 = 3176 * MiB;
constexpr size_t WS_END = 3208 * MiB;
constexpr int CW_CNT = 1024;
constexpr int CW_OFFS = 2048;

__device__ __constant__ double INVF[16] = {1.0, 0.5623413251903491, 0.31622776601683794, 0.1778279410038923, 0.1, 0.05623413251903491, 0.03162277660168379, 0.01778279410038923,
                                            0.01, 0.005623413251903491, 0.0031622776601683794, 0.0017782794100389228, 0.001, 0.0005623413251903491, 0.00031622776601683794, 0.00017782794100389227};

__device__ __forceinline__ void sincos_d(double a, float& c, float& s) {
    const double TWO_PI = 6.283185307179586476925286766559;
    double r = a - rint(a / TWO_PI) * TWO_PI;
    r *= 0.25;
    const double r2 = r * r;
    double sn = r * (1.0 + r2 * (-1.0 / 6 + r2 * (1.0 / 120 + r2 * (-1.0 / 5040 + r2 * (1.0 / 362880 + r2 * (-1.0 / 39916800 + r2 * (1.0 / 6227020800.0 + r2 * (-1.0 / 1307674368000.0))))))));
    double cs = 1.0 + r2 * (-0.5 + r2 * (1.0 / 24 + r2 * (-1.0 / 720 + r2 * (1.0 / 40320 + r2 * (-1.0 / 3628800 + r2 * (1.0 / 479001600.0 + r2 * (-1.0 / 87178291200.0 + r2 * (1.0 / 20922789888000.0))))))));
#pragma unroll
    for (int i = 0; i < 2; ++i) { const double s2 = 2.0 * sn * cs, c2 = 1.0 - 2.0 * sn * sn; sn = s2; cs = c2; }
    c = (float)cs; s = (float)sn;
}
#define LAS __attribute__((address_space(3)))
typedef short bf16x8 __attribute__((ext_vector_type(8)));
typedef float f32x4 __attribute__((ext_vector_type(4)));
typedef unsigned u32x4 __attribute__((ext_vector_type(4)));
constexpr int NWAVES = 8, NTHR = 512;
constexpr int RING_BYTES = 131072;
constexpr int MISC_OFF = 139264;
constexpr int MISC_OFF_OLD_UNUSED = RING_BYTES;
constexpr int LDS_BYTES = 147456;
constexpr size_t WT_GU = WS_WT, WT_DN = WS_WT + 512 * MiB, WT_EIN = WS_WT + 768 * MiB, WT_EOUT = WS_WT + 778 * MiB, WT_OIN = WS_WT + 782 * MiB, WT_OUP = WS_WT + 788 * MiB, WT_OOUT = WS_WT + 791 * MiB, WT_SGW = WS_WT + 795 * MiB;
constexpr int BIASSLOT_OFF = MISC_OFF + 5120;
constexpr int ROWSLOT_OFF = MISC_OFF + 4096;
constexpr int CW_BAR = 4096;

__device__ __forceinline__ int lane_id_asm() { int l; asm volatile("v_mbcnt_lo_u32_b32 %0, -1, 0\n\tv_mbcnt_hi_u32_b32 %0, -1, %0" : "=v"(l)); return l; }
__device__ __forceinline__ float shfl_xor_l(float v, int o, int lane) { return __int_as_float(__builtin_amdgcn_ds_bpermute((lane ^ o) << 2, __float_as_int(v))); }
__device__ __forceinline__ float wave_sum_l(float v, int lane) {
#pragma unroll
    for (int o = 1; o < 64; o <<= 1) v += shfl_xor_l(v, o, lane);
    return v;
}
#define XB_TMO      128
#define XB_XCNT(j)  (256  + 64 * (j))
#define XB_XSUB(j)  (1280 + 64 * (j))
#define XB_XGEN(j)  (2304 + 64 * (j))
#define XB_TOP      3328
#define XB_TOPGEN   3392
#define XCD_BAR_WORDS 3456
#define XB_SPIN_CAP (1u << 18)
__device__ __forceinline__ unsigned xb_ld(unsigned* p)              { return __hip_atomic_load(p, __ATOMIC_RELAXED, __HIP_MEMORY_SCOPE_AGENT); }
__device__ __forceinline__ unsigned xb_add(unsigned* p, unsigned v) { return __hip_atomic_fetch_add(p, v, __ATOMIC_RELAXED, __HIP_MEMORY_SCOPE_AGENT); }
__device__ __forceinline__ unsigned xb_xcc_id() { return (unsigned)__builtin_amdgcn_s_getreg((3 << 11) | 20) & 0xFu; }
#define XB_SPIN(cond, bar) do { unsigned _sp = 0; while (cond) { __builtin_amdgcn_s_sleep(1); \
    if ((++_sp & 255u) == 0u) { if (xb_ld(&(bar)[XB_TMO])) break; if (_sp > XB_SPIN_CAP) { atomicAdd(&(bar)[XB_TMO], 1u); break; } } } } while (0)
struct XcdBarrier { unsigned* bar; unsigned x; volatile LAS unsigned* st; int wave; };
__device__ __forceinline__ XcdBarrier xcd_barrier_post(unsigned* bar, volatile LAS unsigned* st, int wave) {
    XcdBarrier b; b.bar = bar; b.x = xb_xcc_id(); b.st = st; b.wave = wave;
    if (threadIdx.x == 0) (void)xb_add(&bar[XB_XCNT(b.x)], 1u);
    return b;
}
__device__ __forceinline__ void xcd_barrier_complete(unsigned* bar, unsigned x, unsigned& nloc, unsigned& nx) {
    const unsigned G = gridDim.x * gridDim.y * gridDim.z;
    unsigned sum, cnt, mine, sp = 0u;
    for (;;) {
        sum = 0u; cnt = 0u; mine = 0u;
#pragma unroll
        for (unsigned j = 0; j < 16; ++j) { const unsigned c = xb_ld(&bar[XB_XCNT(j)]); sum += c; cnt += (c > 0u) ? 1u : 0u; mine = (j == x) ? c : mine; }
        if (sum == G) break;
        __builtin_amdgcn_s_sleep(1);
        if ((++sp & 255u) == 0u) { if (xb_ld(&bar[XB_TMO])) break; if (sp > XB_SPIN_CAP) { atomicAdd(&bar[XB_TMO], 1u); break; } }
    }
    nloc = mine > 0u ? mine : 1u; nx = cnt > 0u ? cnt : 1u;
}
__device__ __forceinline__ void xcd_barrier(const XcdBarrier& b) {
    asm volatile("s_waitcnt vmcnt(0)" ::: "memory");
    __syncthreads();
    if (b.wave == 0 && lane_id_asm() == 0) {
        unsigned* bar = b.bar; asm volatile("" : "+s"(bar));
        __builtin_amdgcn_s_waitcnt(0);
        unsigned nloc = b.st[0], nx = b.st[1];
        if (nloc == 0u) { xcd_barrier_complete(bar, b.x, nloc, nx); b.st[0] = nloc; b.st[1] = nx; }
        const unsigned old = xb_add(&bar[XB_XSUB(b.x)], 1u);
        const unsigned gen = old / nloc;
        if (old + 1u == (gen + 1u) * nloc) {
            __builtin_amdgcn_fence(__ATOMIC_RELEASE, "agent");
            asm volatile("s_waitcnt vmcnt(0)" ::: "memory");
            const unsigned og = xb_add(&bar[XB_TOP], 1u);
            const unsigned tg = og / nx;
            if (og + 1u == (tg + 1u) * nx) xb_add(&bar[XB_TOPGEN], 1u);
            else XB_SPIN(xb_ld(&bar[XB_TOPGEN]) == tg, bar);
            __builtin_amdgcn_fence(__ATOMIC_ACQUIRE, "agent");
            xb_add(&bar[XB_XGEN(b.x)], 1u);
            asm volatile("s_waitcnt vmcnt(0)" ::: "memory");
        } else {
            XB_SPIN(xb_ld(&bar[XB_XGEN(b.x)]) == gen, bar);
            __builtin_amdgcn_fence(__ATOMIC_ACQUIRE, "agent");
            asm volatile("s_waitcnt vmcnt(0)" ::: "memory");
        }
    }
    __syncthreads();
}

constexpr int W8_GU_SH = 4, W8_DN_SH = 5;
typedef int v8i_t __attribute__((ext_vector_type(8)));
typedef int u32x4i __attribute__((ext_vector_type(4)));
__device__ __forceinline__ unsigned pk4_fp8(float a, float b, float c, float d) { int w = __builtin_amdgcn_cvt_pk_fp8_f32(a, b, 0, false); w = __builtin_amdgcn_cvt_pk_fp8_f32(c, d, w, true); return (unsigned)w; }
namespace pg8 {
constexpr int BM = 256, BK = 64, HALF = 128, HTB = HALF * BK * 2, STAGE_BYTES = 8 * HTB, NXCD = 8, WGM = 8;
__device__ __forceinline__ int lds_byte(int r, int c) { const int st = (r >> 4) * 2 + (c >> 5), rr = r & 15, cc = c & 31, ob = rr * 64 + cc * 2; return st * 1024 + (ob ^ (((ob >> 9) & 1) << 5)); }
__device__ __forceinline__ void stage_rc(int b, int& R, int& C) { const int st = b / 1024, sb = b % 1024, swz = sb ^ (((sb >> 9) & 1) << 5); R = (st >> 1) * 16 + swz / 64; C = (st & 1) * 32 + (swz % 64) / 2; }
__device__ __forceinline__ int perm32(int rho) { const int n = rho >> 4, i = rho & 15; return 8 * (i >> 2) + 4 * n + (i & 3); }
struct Unit { int pm, pn, e; };
struct Gemm { const bf16_t* A; int lda; const int* rowmap; const bf16_t* Bt; int ldb; size_t strideB; int K; int asplit = 1 << 30, aoff = 0; };
struct Sched {
    int nM, nN, nwg, G, c; const LAS int* tile_e;
    __device__ __forceinline__ void init(int nM_, int nN_, int G_, int c_, const LAS int* tile_e_) { nM = nM_; nN = nN_; nwg = nM * nN; G = G_; c = c_; tile_e = tile_e_; }
    __device__ __forceinline__ bool next(int i, Unit& u) const {
        const int L = i * G + c; if (L >= nwg) return false;
        int wgid = L; { const int q = nwg / NXCD, r = nwg % NXCD, xcd = wgid % NXCD, off = wgid / NXCD; wgid = (xcd < r ? xcd * (q + 1) : r * (q + 1) + (xcd - r) * q) + off; }
        const int nig = WGM * nN, gid = wgid / nig, fm = gid * WGM, gsz = (nM - fm) < WGM ? (nM - fm) : WGM;
        u.pm = fm + ((wgid % nig) % gsz); u.pn = (wgid % nig) / gsz; u.e = 0;
        if (tile_e) u.e = __builtin_amdgcn_readfirstlane(tile_e[u.pm]);
        return true;
    }
};
__device__ __forceinline__ unsigned cvt_pk_bf16(float lo, float hi) { unsigned r; asm volatile("v_cvt_pk_bf16_f32 %0, %1, %2" : "=v"(r) : "v"(lo), "v"(hi)); return r; }
__device__ __forceinline__ u32x4 pack8(const f32x4 a, const f32x4 b) { u32x4 w; w.x = cvt_pk_bf16(a[0], a[1]); w.y = cvt_pk_bf16(a[2], a[3]); w.z = cvt_pk_bf16(b[0], b[1]); w.w = cvt_pk_bf16(b[2], b[3]); return w; }
typedef float f32x2 __attribute__((ext_vector_type(2)));
typedef unsigned u32x2 __attribute__((ext_vector_type(2)));
__device__ __forceinline__ f32x2 gelu_pk(f32x2 v) {
    const f32x2 av = __builtin_elementwise_abs(v), d = av * 0.2316418882f + 1.0f;
    f32x2 t; t.x = __builtin_amdgcn_rcpf(d.x); t.y = __builtin_amdgcn_rcpf(d.y);
    f32x2 q = t * 0.5307027145f + (-0.7265760135f); q = q * t + 0.7107068705f; q = q * t + (-0.142248368f); q = q * t + 0.127414796f; q = q * t;
    const f32x2 s = (v * v) * (-0.72134752044f);
    f32x2 e; e.x = __builtin_amdgcn_exp2f(s.x); e.y = __builtin_amdgcn_exp2f(s.y);
    const f32x2 m = v * (q * e), r = v - m;
    f32x2 o; o.x = v.x < 0.f ? m.x : r.x; o.y = v.y < 0.f ? m.y : r.y; return o;
}
__device__ __forceinline__ f32x4 gelu4(const f32x4 v) { const f32x2 a = gelu_pk((f32x2){v[0], v[1]}), b = gelu_pk((f32x2){v[2], v[3]}); return (f32x4){a.x, a.y, b.x, b.y}; }
__device__ __forceinline__ float fsig(float x) { return __builtin_amdgcn_rcpf(1.0f + __builtin_amdgcn_exp2f(-1.4426950408889634f * x)); }

#define EPI_ROWS for (int ai = 0; ai < 2; ++ai) _Pragma("unroll") for (int m = 0; m < 4; ++m)

struct EpiE1 {
    static constexpr bool LDS_BIAS = false;
    bf16_t *BG, *CX, *GZU, *GZV;
    __device__ __forceinline__ void operator()(const f32x4 (&acc)[2][2][4][2], const Unit& u, int wr, int wc, int fr, int fq) const {
        const int row0 = u.pm * BM + wr * 64 + fr, cl = wc * 32 + 8 * fq, t = u.pn;
        if (t < 2) {
#pragma unroll
            EPI_ROWS { bf16_t* rp = BG + (size_t)(row0 + ai * HALF + m * 16) * 512 + t * 256 + cl;
#pragma unroll
                for (int bj = 0; bj < 2; ++bj) *(u32x4*)(rp + bj * HALF) = pack8(acc[ai][bj][m][0], acc[ai][bj][m][1]); }
        } else if (t < 6) {
#pragma unroll
            EPI_ROWS { bf16_t* rp = CX + (size_t)(row0 + ai * HALF + m * 16) * 512 + (t - 2) * 128 + cl;
                *(u32x4*)rp = pack8(acc[ai][0][m][0] * acc[ai][1][m][0], acc[ai][0][m][1] * acc[ai][1][m][1]); }
        } else {
            bf16_t* O = t < 8 ? GZU : GZV; const int tc = (t & 1) * 256 + cl;
#pragma unroll
            EPI_ROWS { bf16_t* rp = O + (size_t)(row0 + ai * HALF + m * 16) * 512 + tc;
#pragma unroll
                for (int bj = 0; bj < 2; ++bj) *(u32x4*)(rp + bj * HALF) = pack8(gelu4(acc[ai][bj][m][0]), gelu4(acc[ai][bj][m][1])); }
        }
    }
};
struct EpiO1 {
    static constexpr bool LDS_BIAS = false;
    bf16_t *GLU, *CQKV, *KRR;
    __device__ __forceinline__ void operator()(const f32x4 (&acc)[2][2][4][2], const Unit& u, int wr, int wc, int fr, int fq) const {
        const int row0 = u.pm * BM + wr * 64 + fr, cl = wc * 32 + 8 * fq, t = u.pn;
        if (t < 4) {
#pragma unroll
            EPI_ROWS { bf16_t* rp = GLU + (size_t)(row0 + ai * HALF + m * 16) * 512 + t * 128 + cl; f32x4 o[2];
#pragma unroll
                for (int n = 0; n < 2; ++n) {
                    const f32x4 ga = acc[ai][0][m][n], tb = acc[ai][1][m][n] * (-1.4426950408889634f);
                    f32x4 e; e[0] = __builtin_amdgcn_exp2f(tb[0]); e[1] = __builtin_amdgcn_exp2f(tb[1]); e[2] = __builtin_amdgcn_exp2f(tb[2]); e[3] = __builtin_amdgcn_exp2f(tb[3]);
                    const f32x4 d = e + 1.0f;
                    f32x4 r; r[0] = __builtin_amdgcn_rcpf(d[0]); r[1] = __builtin_amdgcn_rcpf(d[1]); r[2] = __builtin_amdgcn_rcpf(d[2]); r[3] = __builtin_amdgcn_rcpf(d[3]);
                    o[n] = ga * r; }
                *(u32x4*)rp = pack8(o[0], o[1]); }
        } else if (t == 4) {
#pragma unroll
            EPI_ROWS { bf16_t* rp = CQKV + (size_t)(row0 + ai * HALF + m * 16) * 384 + cl;
#pragma unroll
                for (int bj = 0; bj < 2; ++bj) *(u32x4*)(rp + bj * HALF) = pack8(acc[ai][bj][m][0], acc[ai][bj][m][1]); }
        } else {
#pragma unroll
            EPI_ROWS { const size_t r = (size_t)(row0 + ai * HALF + m * 16);
                *(u32x4*)(CQKV + r * 384 + 256 + cl) = pack8(acc[ai][0][m][0], acc[ai][0][m][1]);
                if (wc == 0) *(u32x4*)(KRR + r * 32 + 8 * fq) = pack8(acc[ai][1][m][0], acc[ai][1][m][1]); }
        }
    }
};
struct EpiO3 {
    static constexpr bool LDS_BIAS = false;
    bf16_t *Q, *KN, *VV; const float* CS;
    __device__ __forceinline__ void operator()(const f32x4 (&acc)[2][2][4][2], const Unit& u, int wr, int wc, int fr, int fq) const {
        const int row0 = u.pm * BM + wr * 64 + fr, cl = wc * 32 + 8 * fq, t = u.pn;
        if (t < 3) {
#pragma unroll
            for (int bj = 0; bj < 2; ++bj) { const int c0 = t * 256 + bj * HALF + cl, h = c0 / 96, d0 = c0 - 96 * h;
                if (d0 < 64) {
#pragma unroll
                    EPI_ROWS *(u32x4*)(Q + (size_t)(row0 + ai * HALF + m * 16) * 768 + c0) = pack8(acc[ai][bj][m][0] * QSCALE, acc[ai][bj][m][1] * QSCALE);
                } else { const int i0 = (d0 - 64) >> 1;
#pragma unroll
                    for (int ai = 0; ai < 2; ++ai) {
                    f32x4 csv[4], snv[4];
#pragma unroll
                    for (int m = 0; m < 4; ++m) { const size_t r = (size_t)(row0 + ai * HALF + m * 16); csv[m] = *(const f32x4*)(CS + r * 32 + i0); snv[m] = *(const f32x4*)(CS + r * 32 + 16 + i0); }
#pragma unroll
                    for (int m = 0; m < 4; ++m) { const size_t r = (size_t)(row0 + ai * HALF + m * 16); const f32x4 cs = csv[m], sn = snv[m];
                        const f32x4 a = acc[ai][bj][m][0], b = acc[ai][bj][m][1]; f32x4 o0, o1;
                        o0[0] = (a[0] * cs[0] - a[1] * sn[0]) * QSCALE; o0[1] = (a[1] * cs[0] + a[0] * sn[0]) * QSCALE; o0[2] = (a[2] * cs[1] - a[3] * sn[1]) * QSCALE; o0[3] = (a[3] * cs[1] + a[2] * sn[1]) * QSCALE;
                        o1[0] = (b[0] * cs[2] - b[1] * sn[2]) * QSCALE; o1[1] = (b[1] * cs[2] + b[0] * sn[2]) * QSCALE; o1[2] = (b[2] * cs[3] - b[3] * sn[3]) * QSCALE; o1[3] = (b[3] * cs[3] + b[2] * sn[3]) * QSCALE;
                        *(u32x4*)(Q + r * 768 + c0) = pack8(o0, o1); } }
                } }
        } else {
            bf16_t* O = t < 5 ? KN : VV; const int tc = ((t - 3) & 1) * 256 + cl;
#pragma unroll
            EPI_ROWS { bf16_t* rp = O + (size_t)(row0 + ai * HALF + m * 16) * 512 + tc;
#pragma unroll
                for (int bj = 0; bj < 2; ++bj) *(u32x4*)(rp + bj * HALF) = pack8(acc[ai][bj][m][0], acc[ai][bj][m][1]); }
        }
    }
};
template <bool XF32> struct EpiOut {
    static constexpr bool LDS_BIAS = true;
    const void* xres; const float* gate; bf16_t* V; LAS unsigned char* lds;
    __device__ __forceinline__ const float* bias_src(const Unit& u, int lane) const { return gate + (size_t)((u.pm * BM) / SEQ) * 6 * DM + u.pn * BM + lane * 4; }
    __device__ __forceinline__ void operator()(const f32x4 (&acc)[2][2][4][2], const Unit& u, int wr, int wc, int fr, int fq) const {
        const int row0 = u.pm * BM + wr * 64 + fr, b = (u.pm * BM) / SEQ;
        f32x4 g[2][2];
#pragma unroll
        for (int bj = 0; bj < 2; ++bj)
#pragma unroll
            for (int n = 0; n < 2; ++n) g[bj][n] = *(const LAS f32x4*)((const LAS float*)(lds + BIASSLOT_OFF) + bj * HALF + wc * 32 + 8 * fq + 4 * n) + 1.0f;
        const size_t cb = (size_t)u.pn * BM + wc * 32 + 8 * fq;
        if constexpr (!XF32) {
#pragma unroll
            for (int ai = 0; ai < 2; ++ai) {
                u32x4 xb[4][2];
#pragma unroll
                for (int m = 0; m < 4; ++m)
#pragma unroll
                    for (int bj = 0; bj < 2; ++bj) xb[m][bj] = *(const u32x4*)((const bf16_t*)xres + (size_t)(row0 + ai * HALF + m * 16) * DM + cb + bj * HALF);
#pragma unroll
                for (int m = 0; m < 4; ++m)
#pragma unroll
                    for (int bj = 0; bj < 2; ++bj) { const u32x4 t = xb[m][bj];
                        const f32x4 x0 = (f32x4){__uint_as_float(t.x << 16), __uint_as_float(t.x & 0xffff0000u), __uint_as_float(t.y << 16), __uint_as_float(t.y & 0xffff0000u)};
                        const f32x4 x1 = (f32x4){__uint_as_float(t.z << 16), __uint_as_float(t.z & 0xffff0000u), __uint_as_float(t.w << 16), __uint_as_float(t.w & 0xffff0000u)};
                        *(u32x4*)(V + (size_t)(row0 + ai * HALF + m * 16) * DM + cb + bj * HALF) = pack8(x0 * ALPHA + g[bj][0] * acc[ai][bj][m][0], x1 * ALPHA + g[bj][1] * acc[ai][bj][m][1]); }
            }
        } else {
#pragma unroll
            for (int ai = 0; ai < 2; ++ai)
#pragma unroll
                for (int mh = 0; mh < 2; ++mh) {
                    f32x4 xf[2][2][2];
#pragma unroll
                    for (int m2 = 0; m2 < 2; ++m2)
#pragma unroll
                        for (int bj = 0; bj < 2; ++bj) { const float* xp = (const float*)xres + (size_t)(row0 + ai * HALF + (2 * mh + m2) * 16) * DM + cb + bj * HALF; xf[m2][bj][0] = *(const f32x4*)xp; xf[m2][bj][1] = *(const f32x4*)(xp + 4); }
#pragma unroll
                    for (int m2 = 0; m2 < 2; ++m2)
#pragma unroll
                        for (int bj = 0; bj < 2; ++bj) { const int m = 2 * mh + m2;
                            *(u32x4*)(V + (size_t)(row0 + ai * HALF + m * 16) * DM + cb + bj * HALF) = pack8(xf[m2][bj][0] * ALPHA + g[bj][0] * acc[ai][bj][m][0], xf[m2][bj][1] * ALPHA + g[bj][1] * acc[ai][bj][m][1]); }
                }
        }
    }
};
struct EpiM1 {
    const float* bgu; unsigned char* H; LAS unsigned char* lds;
    static constexpr bool LDS_BIAS = true;
    __device__ __forceinline__ const float* bias_src(const Unit& u, int lane) const { return bgu + (size_t)u.e * 2048 + (lane >> 5) * 1024 + u.pn * 128 + (lane & 31) * 4; }
    static __device__ __forceinline__ f32x2 act2(f32x2 g, f32x2 u) {
        f32x2 gg, uu; gg.x = fminf(g.x, 7.0f); gg.y = fminf(g.y, 7.0f); uu.x = __builtin_amdgcn_fmed3f(u.x, -6.0f, 8.0f); uu.y = __builtin_amdgcn_fmed3f(u.y, -6.0f, 8.0f);
        const f32x2 t = gg * (-1.702f * 1.4426950408889634f);
        f32x2 e; e.x = __builtin_amdgcn_exp2f(t.x); e.y = __builtin_amdgcn_exp2f(t.y);
        const f32x2 d = e + 1.0f;
        f32x2 r; r.x = __builtin_amdgcn_rcpf(d.x); r.y = __builtin_amdgcn_rcpf(d.y);
        return (uu * gg) * r;
    }
    __device__ __forceinline__ void operator()(const f32x4 (&acc)[2][2][4][2], const Unit& u, int wr, int wc, int fr, int fq) const {
        const int row0 = u.pm * BM + wr * 64 + fr, col = u.pn * 128 + wc * 32 + 8 * fq;
        const LAS float* bp = (const LAS float*)(lds + BIASSLOT_OFF) + wc * 32 + 8 * fq;
        f32x4 bg[2], bu[2];
#pragma unroll
        for (int n = 0; n < 2; ++n) { bg[n] = *(const LAS f32x4*)(bp + 4 * n); bu[n] = *(const LAS f32x4*)(bp + 128 + 4 * n) + 1.0f; }
#pragma unroll
        EPI_ROWS { f32x2 o[2][2];
#pragma unroll
            for (int n = 0; n < 2; ++n) { const f32x4 gv = acc[ai][0][m][n] + bg[n], uv = acc[ai][1][m][n] + bu[n];
                o[n][0] = act2((f32x2){gv[0], gv[1]}, (f32x2){uv[0], uv[1]}); o[n][1] = act2((f32x2){gv[2], gv[3]}, (f32x2){uv[2], uv[3]}); }
            u32x2 w; w.x = pk4_fp8(o[0][0].x, o[0][0].y, o[0][1].x, o[0][1].y); w.y = pk4_fp8(o[1][0].x, o[1][0].y, o[1][1].x, o[1][1].y);
            *(u32x2*)(H + (size_t)(row0 + ai * HALF + m * 16) * DM + col) = w; }
    }
};
struct EpiM2 {
    const float* bdn; unsigned char* YS; LAS unsigned char* lds;
    static constexpr bool LDS_BIAS = true;
    __device__ __forceinline__ const float* bias_src(const Unit& u, int lane) const { return bdn + (size_t)u.e * DM + u.pn * BM + lane * 4; }
    __device__ __forceinline__ void operator()(const f32x4 (&acc)[2][2][4][2], const Unit& u, int wr, int wc, int fr, int fq) const {
        const int row0 = u.pm * BM + wr * 64 + fr, col = u.pn * BM + wc * 32 + 8 * fq;
        f32x4 bv[2][2];
#pragma unroll
        for (int bj = 0; bj < 2; ++bj)
#pragma unroll
            for (int n = 0; n < 2; ++n) bv[bj][n] = *(const LAS f32x4*)((const LAS float*)(lds + BIASSLOT_OFF) + wc * 32 + 8 * fq + bj * HALF + 4 * n);
#pragma unroll
        EPI_ROWS { unsigned char* rp = YS + (size_t)(row0 + ai * HALF + m * 16) * DM + col;
#pragma unroll
            for (int bj = 0; bj < 2; ++bj) { const f32x4 a = (acc[ai][bj][m][0] + bv[bj][0]) * 16.0f, b = (acc[ai][bj][m][1] + bv[bj][1]) * 16.0f;
                u32x2 w; w.x = pk4_fp8(a[0], a[1], a[2], a[3]); w.y = pk4_fp8(b[0], b[1], b[2], b[3]); *(u32x2*)(rp + bj * HALF) = w; } }
    }
};

template <class Epi, int F8SCALE = -1>
__device__ __forceinline__ void gemm_phase(LAS unsigned char* lds, const int wave_id, const Gemm g, const Sched& S, const Epi& E) {
    const int lane = lane_id_asm();
    const int wid = wave_id, wr = wid >> 2, wc = wid & 3, fr = lane & 15, fq = lane >> 4;
    const int K = g.K, nt = K / BK;
    const int swz = (lane * 16) ^ ((((lane * 16) >> 9) & 1) << 5);
#define PG8_STR(i) ((((wid + 8 * (i)) >> 1) * 16) + (swz >> 6))
#define PG8_STC ((wid & 1) * 32 + ((swz & 63) >> 1))
    unsigned voffB[2];
#pragma unroll
    for (int i = 0; i < 2; ++i) { const int R = PG8_STR(i), Rb = (R & ~31) + perm32(R & 31); voffB[i] = (unsigned)(Rb * g.ldb + PG8_STC) * 2u; }
    const size_t kstep = (size_t)(BK * 2);
    const size_t hstepB = (size_t)HALF * g.ldb * 2;
    const unsigned ldsw = (unsigned)wid * 1024u;
    const int aoff = lds_byte(wr * 64 + fr, fq * 8), boff = lds_byte(wc * 32 + fr, fq * 8);
    const char* const abase = (const char*)g.A;
#define PG8_SA(b, h) (((b) * 2 + (h)) * HTB)
#define PG8_SB(b, h) ((4 + (b) * 2 + (h)) * HTB)
#define PG8_STAGEB(bufoff, gbase) do { _Pragma("unroll") for (int _i = 0; _i < 2; ++_i) \
        __builtin_amdgcn_global_load_lds((const unsigned*)((const char*)(gbase) + voffB[_i]), (LAS unsigned*)(lds + (bufoff) + ldsw + _i * 8192), 16, 0, 0); } while (0)
#define PG8_STAGEA(bufoff, koff, VO, h) do { _Pragma("unroll") for (int _i = 0; _i < 2; ++_i) \
        __builtin_amdgcn_global_load_lds((const unsigned*)(abase + (size_t)(koff) + (VO)[h][_i]), (LAS unsigned*)(lds + (bufoff) + ldsw + _i * 8192), 16, 0, 0); } while (0)
#define PG8_LDA(dst, b, h) do { _Pragma("unroll") for (int m = 0; m < 4; ++m) _Pragma("unroll") for (int k = 0; k < 2; ++k) dst[m][k] = *(const LAS bf16x8*)(lds + PG8_SA(b, h) + aoff + m * 2048 + k * 1024); } while (0)
#define PG8_LDB(dst, b, h) do { _Pragma("unroll") for (int n = 0; n < 2; ++n) _Pragma("unroll") for (int k = 0; k < 2; ++k) dst[n][k] = *(const LAS bf16x8*)(lds + PG8_SB(b, h) + boff + n * 2048 + k * 1024); } while (0)
#define PG8_MMA(ai, bj, At, Bt) do { __builtin_amdgcn_s_setprio(1); \
        if constexpr (F8SCALE < 0) { _Pragma("unroll") for (int m = 0; m < 4; ++m) _Pragma("unroll") for (int n = 0; n < 2; ++n) _Pragma("unroll") for (int k = 0; k < 2; ++k) \
            acc[ai][bj][m][n] = __builtin_amdgcn_mfma_f32_16x16x32_bf16(Bt[n][k], At[m][k], acc[ai][bj][m][n], 0, 0, 0); } \
        else { _Pragma("unroll") for (int m = 0; m < 4; ++m) _Pragma("unroll") for (int n = 0; n < 2; ++n) { \
            const v8i_t _b8 = __builtin_shufflevector(__builtin_bit_cast(u32x4i, Bt[n][0]), __builtin_bit_cast(u32x4i, Bt[n][1]), 0, 1, 2, 3, 4, 5, 6, 7); \
            const v8i_t _a8 = __builtin_shufflevector(__builtin_bit_cast(u32x4i, At[m][0]), __builtin_bit_cast(u32x4i, At[m][1]), 0, 1, 2, 3, 4, 5, 6, 7); \
            acc[ai][bj][m][n] = __builtin_amdgcn_mfma_scale_f32_16x16x128_f8f6f4(_b8, _a8, acc[ai][bj][m][n], 0, 0, 0, f8_sb, 0, f8_sa); } \
            _Pragma("unroll") for (int m = 0; m < 4; ++m) _Pragma("unroll") for (int n = 0; n < 2; ++n) asm volatile("" : "+v"(acc[ai][bj][m][n])); }     \
        __builtin_amdgcn_s_setprio(0); } while (0)
#define PG8_WAIT_V(n) asm volatile("s_waitcnt vmcnt(" #n ")" ::: "memory")
#define PG8_WAIT_L(n) asm volatile("s_waitcnt lgkmcnt(" #n ")" ::: "memory")
#define PG8_BAR __builtin_amdgcn_s_barrier()
#define PG8_SCHED __builtin_amdgcn_sched_barrier(0)
#define PG8_LOADROWS(U, RW) do { _Pragma("unroll") for (int _h = 0; _h < 2; ++_h) _Pragma("unroll") for (int _i = 0; _i < 2; ++_i) { const int _row = (U).pm * BM + _h * HALF + PG8_STR(_i); \
        (RW)[_h][_i] = g.rowmap ? ((const __attribute__((address_space(1))) int*)g.rowmap)[_row] : _row; } } while (0)
#define PG8_ROWS2OFF(U, RW, VO) do { const int _ao = (U).pn >= g.asplit ? g.aoff : 0; _Pragma("unroll") for (int _h = 0; _h < 2; ++_h) _Pragma("unroll") for (int _i = 0; _i < 2; ++_i) (VO)[_h][_i] = (unsigned)((RW)[_h][_i] * g.lda + _ao + PG8_STC) * 2u; } while (0)
#define PG8_CALCA(U, VO) do { int _rw[2][2]; PG8_LOADROWS(U, _rw); PG8_ROWS2OFF(U, _rw, VO); } while (0)
    int f8_sb = (F8SCALE) * 0x01010101, f8_sa = 0x7f7f7f7f; asm volatile("" : "+v"(f8_sb), "+v"(f8_sa));
    Unit cur, nxt; int ui = 0;
    if (!S.next(0, cur)) return;
    f32x4 acc[2][2][4][2];
#pragma unroll
    for (int a = 0; a < 2; ++a)
#pragma unroll
        for (int b = 0; b < 2; ++b)
#pragma unroll
            for (int m = 0; m < 4; ++m)
#pragma unroll
                for (int n = 0; n < 2; ++n) acc[a][b][m][n] = (f32x4){0.f, 0.f, 0.f, 0.f};
    bf16x8 At[4][2], B0[2][2], B1[2][2];
    unsigned voC[2][2];
    PG8_CALCA(cur, voC);
    const char* cB = (const char*)g.Bt + ((size_t)cur.e * g.strideB + (size_t)cur.pn * BM * g.ldb) * 2;
    PG8_STAGEB(PG8_SB(0, 0), cB); PG8_STAGEB(PG8_SB(0, 1), cB + hstepB); PG8_STAGEA(PG8_SA(0, 0), 0, voC, 0); PG8_STAGEA(PG8_SA(0, 1), 0, voC, 1);
    if (wr == 1) PG8_BAR;
    PG8_WAIT_V(2); PG8_BAR;
    PG8_STAGEB(PG8_SB(1, 0), cB + kstep); PG8_STAGEA(PG8_SA(1, 0), kstep, voC, 0); PG8_STAGEB(PG8_SB(1, 1), cB + hstepB + kstep);
    PG8_WAIT_V(6); PG8_BAR;
    for (;;) {
        const bool has_next = S.next(ui + 1, nxt);
        const char* nB = has_next ? (const char*)g.Bt + ((size_t)nxt.e * g.strideB + (size_t)nxt.pn * BM * g.ldb) * 2 : cB;
        int rwN[2][2];
#pragma unroll 1
        for (int t = 0; t < nt; t += 2) {
            const bool last = (t == nt - 2);
            const size_t k1 = (size_t)(t + 1) * kstep;
            const size_t k2 = last ? 0 : (size_t)(t + 2) * kstep, k3 = k2 + kstep;
            const char* b2 = last ? nB : cB + (size_t)(t + 2) * kstep; const char* b3 = b2 + kstep;
            if constexpr (Epi::LDS_BIAS) { if (t == 2 && wid == 0) { const int ln = lane_id_asm(); __builtin_amdgcn_global_load_lds((const unsigned*)E.bias_src(cur, ln), (LAS unsigned*)(lds + BIASSLOT_OFF), 16, 0, 0); } }
            if (t == nt - 4 && has_next) {
                if (g.rowmap) { if (wid == 0) __builtin_amdgcn_global_load_lds((const unsigned*)(g.rowmap + (size_t)nxt.pm * BM + lane * 4), (LAS unsigned*)(lds + ROWSLOT_OFF), 16, 0, 0); }
                else PG8_LOADROWS(nxt, rwN);
            }
            PG8_LDB(B0, 0, 0); PG8_LDB(B1, 0, 1); PG8_SCHED; PG8_LDA(At, 0, 0); PG8_STAGEA(PG8_SA(1, 1), k1, voC, 1);
            PG8_WAIT_V(8); PG8_WAIT_L(0); PG8_BAR; PG8_MMA(0, 0, At, B0); PG8_MMA(0, 1, At, B1); PG8_BAR; PG8_SCHED;
            if (last && has_next) {
                if (g.rowmap) {
#pragma unroll
                    for (int h = 0; h < 2; ++h)
#pragma unroll
                        for (int i = 0; i < 2; ++i) rwN[h][i] = *(const LAS int*)(lds + ROWSLOT_OFF + 4 * (h * HALF + PG8_STR(i)));
                }
                PG8_ROWS2OFF(nxt, rwN, voC);
            }
            PG8_LDA(At, 0, 1); PG8_STAGEB(PG8_SB(0, 0), b2); PG8_STAGEB(PG8_SB(0, 1), b2 + hstepB); PG8_STAGEA(PG8_SA(0, 0), k2, voC, 0);
            PG8_WAIT_V(8); PG8_WAIT_L(0); PG8_BAR; PG8_MMA(1, 0, At, B0); PG8_MMA(1, 1, At, B1); PG8_BAR; PG8_SCHED;
            PG8_LDB(B0, 1, 0); PG8_LDB(B1, 1, 1); PG8_SCHED; PG8_LDA(At, 1, 0); PG8_STAGEA(PG8_SA(0, 1), k2, voC, 1);
            PG8_WAIT_V(8); PG8_WAIT_L(0); PG8_BAR; PG8_MMA(0, 0, At, B0); PG8_MMA(0, 1, At, B1); PG8_BAR; PG8_SCHED;
            PG8_LDA(At, 1, 1); PG8_STAGEB(PG8_SB(1, 0), b3); PG8_STAGEB(PG8_SB(1, 1), b3 + hstepB); PG8_STAGEA(PG8_SA(1, 0), k3, voC, 0);
            PG8_WAIT_V(8); PG8_WAIT_L(0); PG8_BAR; PG8_MMA(1, 0, At, B0); PG8_MMA(1, 1, At, B1); PG8_BAR; PG8_SCHED;
        }
        if (wr == 0) PG8_BAR;
        E(acc, cur, wr, wc, fr, fq);
        if (!has_next) break;
#pragma unroll
        for (int a = 0; a < 2; ++a)
#pragma unroll
            for (int b = 0; b < 2; ++b)
#pragma unroll
                for (int m = 0; m < 4; ++m)
#pragma unroll
                    for (int n = 0; n < 2; ++n) acc[a][b][m][n] = (f32x4){0.f, 0.f, 0.f, 0.f};
        cur = nxt; cB = nB; ++ui;
        if (wr == 1) PG8_BAR;
    }
    PG8_WAIT_V(0);
    PG8_BAR;
#undef PG8_SA
#undef PG8_SB
#undef PG8_STAGEA
#undef PG8_STAGEB
#undef PG8_LDA
#undef PG8_LDB
#undef PG8_MMA
#undef PG8_WAIT_V
#undef PG8_WAIT_L
#undef PG8_BAR
#undef PG8_SCHED
#undef PG8_CALCA
#undef PG8_LOADROWS
#undef PG8_ROWS2OFF
#undef PG8_STR
#undef PG8_STC
}
}


typedef float f32x16 __attribute__((ext_vector_type(16)));
__device__ __forceinline__ float max3f_(float a, float b, float c) { float r; asm("v_max3_f32 %0, %1, %2, %3" : "=v"(r) : "v"(a), "v"(b), "v"(c)); return r; }
__device__ __forceinline__ float max2f_(float a, float b) { float r; asm("v_max_f32_e32 %0, %1, %2" : "=v"(r) : "v"(a), "v"(b)); return r; }
typedef short v4i16_t __attribute__((ext_vector_type(4)));
using pg8::u32x2;
constexpr int AT_KROW = 208, AT_KBYTES = 64 * AT_KROW, AT_VBYTES = 8192, AT_BUF = AT_KBYTES + AT_VBYTES;
__device__ __forceinline__ void attn_phase(LAS unsigned char* lds, const int wave, const int lane, const int bx, const int G,
                                           const bf16_t* __restrict__ Q, const bf16_t* __restrict__ KN, const bf16_t* __restrict__ KR, const bf16_t* __restrict__ VV, bf16_t* __restrict__ Y) {
    const int hi = lane >> 5, r32 = lane & 31, tid = wave * 64 + lane;
    const int g1 = (lane >> 4) & 1, i16 = lane & 15, tq = i16 >> 2, tp = i16 & 3;
    const int vlane_off = (4 * hi + tq) * 64 + (16 * g1 + 4 * tp) * 2;
    const int vbx = (G % 8 == 0) ? (bx % 8) * (G / 8) + bx / 8 : bx;
    for (int pidx = vbx; pidx < 512; pidx += G) {
#pragma unroll 1
        for (int jj = 0; jj < 2; ++jj) {
            const int bh = pidx >> 3, x = pidx & 7, qb = jj ? 15 - x : x, b = bh >> 3, h = bh & 7;
            const size_t tb = (size_t)b * SEQ;
            const int q0 = qb * 256 + wave * 32;
            const bf16_t* kn = KN + tb * 512 + h * 64; const bf16_t* kr = KR + tb * 32; const bf16_t* vv = VV + tb * 512 + h * 64;
            bf16x8 qf[6];
#pragma unroll
            for (int s = 0; s < 6; ++s) qf[s] = *(const bf16x8*)(Q + (tb + q0 + r32) * 768 + h * 96 + 16 * s + 8 * hi);
            f32x16 o0, o1;
#pragma unroll
            for (int r = 0; r < 16; ++r) { o0[r] = 0.f; o1[r] = 0.f; }
            float mrow = 0.f, lsum = 0.f;
            const int nt = 4 * (qb + 1);
            u32x4 pfa[3], pfb[3];
            bf16x8 pb[2][2];
            const unsigned offKV = (unsigned)((tid >> 3) * 512 + (tid & 7) * 8) * 2u, offKR = (unsigned)((tid >> 2) * 32 + (tid & 3) * 8) * 2u;
            const unsigned ldsK = (unsigned)((tid >> 3) * AT_KROW + (tid & 7) * 16), ldsR = (unsigned)((tid >> 2) * AT_KROW + 128 + (tid & 3) * 16), ldsV = (unsigned)(((tid & 7) >> 2) * 4096 + (tid >> 3) * 64 + (tid & 3) * 16);
            typedef const __attribute__((address_space(1))) unsigned char* gcp_t; typedef const __attribute__((address_space(1))) u32x4* gv4_t;
#define AT_LOAD(kt, pf) do { const size_t _k0 = (size_t)(kt) * 64; \
                pf[0] = *(gv4_t)((gcp_t)(kn + _k0 * 512) + offKV); pf[1] = *(gv4_t)((gcp_t)(vv + _k0 * 512) + offKV); \
                if (tid < 256) pf[2] = *(gv4_t)((gcp_t)(kr + _k0 * 32) + offKR); } while (0)
#define AT_STORE(par, pf) do { LAS unsigned char* _kb = lds + (par) * AT_KBYTES; LAS unsigned char* _vb = lds + 2 * AT_KBYTES + (par) * AT_VBYTES; \
                *(LAS u32x4*)(_kb + ldsK) = pf[0]; *(LAS u32x4*)(_vb + ldsV) = pf[1]; if (tid < 256) *(LAS u32x4*)(_kb + ldsR) = pf[2]; } while (0)
#define AT_PV(vbuf) do { LAS unsigned char* vlane = lds + 2 * AT_KBYTES + (vbuf) * AT_VBYTES + vlane_off; \
                bf16x8 vf[2][2][2]; \
                _Pragma("unroll") for (int kb2 = 0; kb2 < 2; ++kb2) _Pragma("unroll") for (int s2 = 0; s2 < 2; ++s2) _Pragma("unroll") for (int db = 0; db < 2; ++db) { \
                    LAS unsigned char* va = vlane + db * 4096 + (32 * kb2 + 16 * s2) * 64; \
                    const v4i16_t lo = __builtin_amdgcn_ds_read_tr16_b64_v4i16((LAS v4i16_t*)va); \
                    const v4i16_t hh = __builtin_amdgcn_ds_read_tr16_b64_v4i16((LAS v4i16_t*)(va + 8 * 64)); \
                    vf[kb2][s2][db] = (bf16x8){lo[0], lo[1], lo[2], lo[3], hh[0], hh[1], hh[2], hh[3]}; } \
                __builtin_amdgcn_sched_barrier(0); \
                _Pragma("unroll") for (int kb2 = 0; kb2 < 2; ++kb2) _Pragma("unroll") for (int s2 = 0; s2 < 2; ++s2) { \
                    o0 = __builtin_amdgcn_mfma_f32_32x32x16_bf16(vf[kb2][s2][0], pb[kb2][s2], o0, 0, 0, 0); \
                    o1 = __builtin_amdgcn_mfma_f32_32x32x16_bf16(vf[kb2][s2][1], pb[kb2][s2], o1, 0, 0, 0); } } while (0)
#define AT_ITER(KT, PAR, PFL, PFS) do { const int kt = (KT); \
                if (kt + 2 < nt) AT_LOAD(kt + 2, PFL); \
                const int kbase = kt * 64; \
                if (kbase <= q0 + 31) { \
                    LAS unsigned char* kb = lds + (PAR) * AT_KBYTES; \
                    f32x16 p0, p1; \
                _Pragma("unroll") \
                    for (int r = 0; r < 16; ++r) { p0[r] = -mrow; p1[r] = -mrow; } \
                _Pragma("unroll") \
                    for (int s = 0; s < 6; ++s) { \
                        const bf16x8 k0 = *(const LAS bf16x8*)(kb + r32 * AT_KROW + (16 * s + 8 * hi) * 2); \
                        const bf16x8 k1 = *(const LAS bf16x8*)(kb + (32 + r32) * AT_KROW + (16 * s + 8 * hi) * 2); \
                        p0 = __builtin_amdgcn_mfma_f32_32x32x16_bf16(k0, qf[s], p0, 0, 0, 0); \
                        p1 = __builtin_amdgcn_mfma_f32_32x32x16_bf16(k1, qf[s], p1, 0, 0, 0); \
                    } \
                    if (kbase + 63 > q0) { \
                        const int qrel = q0 + r32 - kbase - 4 * hi; \
                _Pragma("unroll") \
                        for (int r = 0; r < 16; ++r) { if ((r & 3) + 8 * (r >> 2) > qrel) p0[r] = -INFINITY; if ((r & 3) + 8 * (r >> 2) + 32 > qrel) p1[r] = -INFINITY; } \
                    } \
                    float mxa = max3f_(p0[0], p0[1], p1[0]), mxb = max3f_(p0[2], p0[3], p1[1]); mxa = max3f_(mxa, p1[2], p1[3]); \
                _Pragma("unroll") \
                    for (int r = 4; r < 16; r += 4) { mxa = max3f_(mxa, p0[r], p0[r + 1]); mxb = max3f_(mxb, p0[r + 2], p0[r + 3]); mxa = max3f_(mxa, p1[r], p1[r + 1]); mxb = max3f_(mxb, p1[r + 2], p1[r + 3]); } \
                    float mx = max2f_(mxa, mxb); \
                    mx = max2f_(mx, shfl_xor_l(mx, 32, lane)); \
                    if (__builtin_amdgcn_ballot_w64(mx > 0.f) != 0ull) { \
                        const float d = max2f_(mx, 0.f), sc = __builtin_amdgcn_exp2f(-d); \
                        lsum *= sc; \
                _Pragma("unroll") \
                        for (int r = 0; r < 16; ++r) { o0[r] *= sc; o1[r] *= sc; p0[r] -= d; p1[r] -= d; } \
                        mrow += d; \
                    } \
                    float ps = 0.f; \
                _Pragma("unroll") \
                    for (int r = 0; r < 16; ++r) { p0[r] = __builtin_amdgcn_exp2f(p0[r]); p1[r] = __builtin_amdgcn_exp2f(p1[r]); ps += p0[r] + p1[r]; } \
                    lsum += ps; \
                _Pragma("unroll") \
                    for (int s2 = 0; s2 < 2; ++s2) { \
                        u32x4 w0, w1; \
                        w0.x = pg8::cvt_pk_bf16(p0[8 * s2 + 0], p0[8 * s2 + 1]); w0.y = pg8::cvt_pk_bf16(p0[8 * s2 + 2], p0[8 * s2 + 3]); w0.z = pg8::cvt_pk_bf16(p0[8 * s2 + 4], p0[8 * s2 + 5]); w0.w = pg8::cvt_pk_bf16(p0[8 * s2 + 6], p0[8 * s2 + 7]); \
                        w1.x = pg8::cvt_pk_bf16(p1[8 * s2 + 0], p1[8 * s2 + 1]); w1.y = pg8::cvt_pk_bf16(p1[8 * s2 + 2], p1[8 * s2 + 3]); w1.z = pg8::cvt_pk_bf16(p1[8 * s2 + 4], p1[8 * s2 + 5]); w1.w = pg8::cvt_pk_bf16(p1[8 * s2 + 6], p1[8 * s2 + 7]); \
                        pb[0][s2] = __builtin_bit_cast(bf16x8, w0); pb[1][s2] = __builtin_bit_cast(bf16x8, w1); \
                    } \
                    AT_PV(PAR); \
                } \
                if (kt + 1 < nt) AT_STORE(1 - (PAR), PFS); \
                asm volatile("s_waitcnt lgkmcnt(0)\n\ts_barrier" ::: "memory");     \
            } while (0)
            AT_LOAD(0, pfa);
            AT_STORE(0, pfa);
            AT_LOAD(1, pfb);
            __syncthreads();
            for (int kt2 = 0; kt2 < nt; kt2 += 2) { AT_ITER(kt2, 0, pfa, pfb); AT_ITER(kt2 + 1, 1, pfb, pfa); }
#undef AT_ITER
            __syncthreads();
#undef AT_LOAD
#undef AT_STORE
#undef AT_PV
            const float inv = 1.0f / (lsum + shfl_xor_l(lsum, 32, lane));
            bf16_t* yrow = Y + (tb + q0 + r32) * DM + 512 + h * 64 + 4 * hi;
#pragma unroll
            for (int g4 = 0; g4 < 4; ++g4) {
                u32x2 w; w.x = pg8::cvt_pk_bf16(o0[4 * g4] * inv, o0[4 * g4 + 1] * inv); w.y = pg8::cvt_pk_bf16(o0[4 * g4 + 2] * inv, o0[4 * g4 + 3] * inv);
                *(u32x2*)(yrow + 8 * g4) = w;
                u32x2 w2; w2.x = pg8::cvt_pk_bf16(o1[4 * g4] * inv, o1[4 * g4 + 1] * inv); w2.y = pg8::cvt_pk_bf16(o1[4 * g4 + 2] * inv, o1[4 * g4 + 3] * inv);
                *(u32x2*)(yrow + 32 + 8 * g4) = w2;
            }
        }
    }
}

__device__ __forceinline__ void even_mix_phase(LAS unsigned char* lds, const int wave, const int lane, const int bx, const int G,
                                               const bf16_t* __restrict__ BG, const bf16_t* __restrict__ CX, const bf16_t* __restrict__ GZU, const bf16_t* __restrict__ GZV, const bf16_t* __restrict__ SGW,
                                               const float* __restrict__ conv_w, const float* __restrict__ sg_b, const float* __restrict__ vn_g, const float* __restrict__ vn_b, bf16_t* __restrict__ Y) {
    const int hi = lane >> 5, r32 = lane & 31;
    for (int chunk = bx; chunk < NT / 128; chunk += G) {
        const int tok0 = chunk * 128, t0 = tok0 % SEQ;
        {
            float gch[8], bch[8], w0[8], w1[8], w2[8];
#pragma unroll
            for (int c = 0; c < 8; ++c) { gch[c] = vn_g[lane * 8 + c]; bch[c] = vn_b[lane * 8 + c]; w0[c] = conv_w[lane * 8 + c]; w1[c] = conv_w[512 + lane * 8 + c]; w2[c] = conv_w[1024 + lane * 8 + c]; }
            float p1[8], p2[8];
            { const int j0 = wave * 16; const int tq = t0 + j0;
              const u32x4 a1 = tq >= 1 ? *(const u32x4*)(CX + (size_t)(tok0 + j0 - 1) * 512 + lane * 8) : (u32x4){0u, 0u, 0u, 0u};
              const u32x4 a2 = tq >= 2 ? *(const u32x4*)(CX + (size_t)(tok0 + j0 - 2) * 512 + lane * 8) : (u32x4){0u, 0u, 0u, 0u};
#pragma unroll
              for (int c = 0; c < 8; ++c) { p1[c] = __uint_as_float((c & 1) ? (a1[c >> 1] & 0xffff0000u) : (a1[c >> 1] << 16)); p2[c] = __uint_as_float((c & 1) ? (a2[c >> 1] & 0xffff0000u) : (a2[c >> 1] << 16)); } }
            u32x4 zvn[4], cxn[4], bgn[4];
#pragma unroll
            for (int r4 = 0; r4 < 4; ++r4) { const size_t rowoff = (size_t)(tok0 + wave * 16 + r4) * 512 + lane * 8; zvn[r4] = *(const u32x4*)(GZV + rowoff); cxn[r4] = *(const u32x4*)(CX + rowoff); bgn[r4] = *(const u32x4*)(BG + rowoff); }
#pragma unroll
            for (int jb = 0; jb < 16; jb += 4) {
                u32x4 zv4[4], cx4[4], bg4[4];
#pragma unroll
                for (int r4 = 0; r4 < 4; ++r4) { zv4[r4] = zvn[r4]; cx4[r4] = cxn[r4]; bg4[r4] = bgn[r4]; }
                if (jb + 4 < 16) {
#pragma unroll
                    for (int r4 = 0; r4 < 4; ++r4) { const size_t rowoff = (size_t)(tok0 + wave * 16 + jb + 4 + r4) * 512 + lane * 8; zvn[r4] = *(const u32x4*)(GZV + rowoff); cxn[r4] = *(const u32x4*)(CX + rowoff); bgn[r4] = *(const u32x4*)(BG + rowoff); }
                }
#pragma unroll
                for (int r4 = 0; r4 < 4; ++r4) {
                const int j = wave * 16 + jb + r4;
                const u32x4 zv = zv4[r4], cxv = cx4[r4], bgv = bg4[r4];
                float v[8]; float s = 0.f;
#pragma unroll
                for (int c = 0; c < 8; ++c) { v[c] = __uint_as_float((c & 1) ? (zv[c >> 1] & 0xffff0000u) : (zv[c >> 1] << 16)); s += v[c]; }
                const float mean = wave_sum_l(s, lane) * (1.f / 512.f); float q = 0.f;
#pragma unroll
                for (int c = 0; c < 8; ++c) { v[c] -= mean; q += v[c] * v[c]; }
                const float rstd = rsqrtf(wave_sum_l(q, lane) * (1.f / 512.f) + LN_EPS);
                float z[8];
#pragma unroll
                for (int c = 0; c < 8; ++c) z[c] = v[c] * rstd * gch[c] + bch[c];
                *(LAS u32x4*)(lds + (lane >> 2) * 8192 + j * 64 + (lane & 3) * 16) = pg8::pack8((f32x4){z[0], z[1], z[2], z[3]}, (f32x4){z[4], z[5], z[6], z[7]});
                float ya[8];
#pragma unroll
                for (int c = 0; c < 8; ++c) { const float cxc = __uint_as_float((c & 1) ? (cxv[c >> 1] & 0xffff0000u) : (cxv[c >> 1] << 16)), bgc = __uint_as_float((c & 1) ? (bgv[c >> 1] & 0xffff0000u) : (bgv[c >> 1] << 16));
                    ya[c] = bgc * (w0[c] * p2[c] + w1[c] * p1[c] + w2[c] * cxc); p2[c] = p1[c]; p1[c] = cxc; }
                *(u32x4*)(Y + (size_t)(tok0 + j) * DM + lane * 8) = pg8::pack8((f32x4){ya[0], ya[1], ya[2], ya[3]}, (f32x4){ya[4], ya[5], ya[6], ya[7]});
                }
            }
        }
        __syncthreads();
        {
            const int h = wave;
            const int g1 = (lane >> 4) & 1, i16 = lane & 15, tq = i16 >> 2, tp = i16 & 3;
            LAS unsigned char* zl = lds + (2 * h) * 8192 + (8 * hi + tq) * 64 + (16 * g1 + 4 * tp) * 2;
            const bf16_t* wh = SGW + (size_t)h * 128 * 128;
#pragma unroll 1
            for (int ib = 0; ib < 4; ++ib) {
                f32x16 a0, a1;
#pragma unroll
                for (int r = 0; r < 16; ++r) { a0[r] = 0.f; a1[r] = 0.f; }
                const bf16_t* wrow = wh + (size_t)(32 * ib + r32) * 128 + 8 * hi;
                const int irow = 32 * ib + r32; const float bias = sg_b[h * 128 + irow];
                const size_t trow = (size_t)(tok0 + irow);
                u32x2 zuv[2][4];
#pragma unroll
                for (int cb = 0; cb < 2; ++cb)
#pragma unroll
                    for (int g4 = 0; g4 < 4; ++g4) zuv[cb][g4] = *(const u32x2*)(GZU + trow * 512 + h * 64 + cb * 32 + 8 * g4 + 4 * hi);
                bf16x8 bnx = *(const bf16x8*)wrow;
                for (int ks = 0; ks < 2 * ib + 2; ++ks) {
                    const bf16x8 bfr = bnx;
                    if (ks + 1 < 2 * ib + 2) bnx = *(const bf16x8*)(wrow + 16 * (ks + 1));
                    LAS unsigned char* za = zl + (16 * ks) * 64;
                    const v4i16_t l0 = __builtin_amdgcn_ds_read_tr16_b64_v4i16((LAS v4i16_t*)za), h0 = __builtin_amdgcn_ds_read_tr16_b64_v4i16((LAS v4i16_t*)(za + 4 * 64));
                    const v4i16_t l1 = __builtin_amdgcn_ds_read_tr16_b64_v4i16((LAS v4i16_t*)(za + 8192)), h1 = __builtin_amdgcn_ds_read_tr16_b64_v4i16((LAS v4i16_t*)(za + 8192 + 4 * 64));
                    a0 = __builtin_amdgcn_mfma_f32_32x32x16_bf16((bf16x8){l0[0], l0[1], l0[2], l0[3], h0[0], h0[1], h0[2], h0[3]}, bfr, a0, 0, 0, 0);
                    a1 = __builtin_amdgcn_mfma_f32_32x32x16_bf16((bf16x8){l1[0], l1[1], l1[2], l1[3], h1[0], h1[1], h1[2], h1[3]}, bfr, a1, 0, 0, 0);
                }
#pragma unroll
                for (int cb = 0; cb < 2; ++cb)
#pragma unroll
                    for (int g4 = 0; g4 < 4; ++g4) {
                        const int ch = h * 64 + cb * 32 + 8 * g4 + 4 * hi;
                        const u32x2 zu = zuv[cb][g4];
                        float o[4];
#pragma unroll
                        for (int c = 0; c < 4; ++c) { const float acc = cb ? a1[4 * g4 + c] : a0[4 * g4 + c]; const float zuf = __uint_as_float((c & 1) ? (zu[c >> 1] & 0xffff0000u) : (zu[c >> 1] << 16)); o[c] = zuf * (acc + bias); }
                        u32x2 w; w.x = pg8::cvt_pk_bf16(o[0], o[1]); w.y = pg8::cvt_pk_bf16(o[2], o[3]);
                        *(u32x2*)(Y + trow * DM + 512 + ch) = w;
                    }
            }
        }
        __syncthreads();
    }
}

typedef __bf16 bf16x2_t __attribute__((ext_vector_type(2)));
constexpr int OM_WBYTES = 31 * 512 * 4, OM_TILE = 32, OM_ROWS = OM_TILE + 30;
__device__ __forceinline__ void odd_mix_phase(LAS unsigned char* lds, const int wave, const int lane, const int bx, const int G,
                                              const bf16_t* __restrict__ GLU, const bf16_t* __restrict__ CQKV, const bf16_t* __restrict__ KRR, const float* __restrict__ CS,
                                              const float* __restrict__ dw_w, const float* __restrict__ dw_b, const float* __restrict__ cn_g, const float* __restrict__ cn_b,
                                              const float* __restrict__ qn_g, const float* __restrict__ kvn_g, bf16_t* __restrict__ Y, bf16_t* __restrict__ CQKVN, bf16_t* __restrict__ KR) {
    const int tid = wave * 64 + lane;
    LAS unsigned char* gl = lds + OM_WBYTES;
    LAS unsigned* wpl = (LAS unsigned*)lds;
    for (int i = tid; i < 16 * 512 / 4; i += NTHR) { const int k2 = i >> 7, c4 = (i & 127) * 4; const f32x4 w0 = *(const f32x4*)(dw_w + (size_t)(2 * k2) * 512 + c4);
        const f32x4 w1 = (2 * k2 + 1 < 31) ? *(const f32x4*)(dw_w + (size_t)(2 * k2 + 1) * 512 + c4) : (f32x4){0.f, 0.f, 0.f, 0.f};
        *(LAS u32x4*)(wpl + 4 * i) = (u32x4){pg8::cvt_pk_bf16(w0[0], w1[0]), pg8::cvt_pk_bf16(w0[1], w1[1]), pg8::cvt_pk_bf16(w0[2], w1[2]), pg8::cvt_pk_bf16(w0[3], w1[3])}; }
    if (tid < 64) { unsigned z = 0u; asm volatile("" : "+v"(z)); *(LAS u32x4*)(gl + OM_ROWS * 1024 + tid * 16) = (u32x4){z, z, z, z}; }
    float bch[8], gch[8], cch[8];
#pragma unroll
    for (int c = 0; c < 8; ++c) { bch[c] = dw_b[lane * 8 + c]; gch[c] = cn_g[lane * 8 + c]; cch[c] = cn_b[lane * 8 + c]; }
    const f32x4 qg = *(const f32x4*)(qn_g + lane * 4); const float kg0 = kvn_g[lane * 2], kg1 = kvn_g[lane * 2 + 1];
    u32x4 pf[8];
#define OM_LOAD(tile_) do { const int _tok0 = (tile_) * OM_TILE, _t0 = _tok0 % SEQ; _Pragma("unroll") for (int i = 0; i < 8; ++i) { const int c = tid + NTHR * i, rr = c >> 6, cc = c & 63; \
        pf[i] = (c < OM_ROWS * 64 && _t0 - 30 + rr >= 0) ? *(const u32x4*)(GLU + (size_t)(_tok0 - 30 + rr) * 512 + cc * 8) : (u32x4){0u, 0u, 0u, 0u}; } } while (0)
    int tile = bx;
    if (tile < NT / OM_TILE) OM_LOAD(tile);
    for (; tile < NT / OM_TILE; tile += G) {
        const int tok0 = tile * OM_TILE;
        __syncthreads();
#pragma unroll
        for (int i = 0; i < 8; ++i) { const int c = tid + NTHR * i, rr = c >> 6, cc = c & 63; if (c < OM_ROWS * 64) *(LAS u32x4*)(gl + rr * 1024 + cc * 16) = pf[i]; }
        __syncthreads();
        if (tile + G < NT / OM_TILE) OM_LOAD(tile + G);
        u32x2 cqv[4]; unsigned ckv[4]; float kx1[4], kx2[4], kcs[4], ksn[4];
#pragma unroll
        for (int tt = 0; tt < 4; ++tt) { const size_t row = (size_t)(tok0 + wave * 4 + tt);
            cqv[tt] = *(const u32x2*)(CQKV + row * 384 + lane * 4); ckv[tt] = *(const unsigned*)(CQKV + row * 384 + 256 + lane * 2);
            kx1[tt] = bf2f(KRR[row * 32 + (lane & 15)]); kx2[tt] = bf2f(KRR[row * 32 + 16 + (lane & 15)]); kcs[tt] = CS[row * 32 + (lane & 15)]; ksn[tt] = CS[row * 32 + 16 + (lane & 15)]; }
        float acc[4][8];
#pragma unroll
        for (int tt = 0; tt < 4; ++tt)
#pragma unroll
            for (int c = 0; c < 8; ++c) acc[tt][c] = bch[c];
#pragma unroll 1
        for (int k2 = 0; k2 < 16; ++k2) {
            const u32x4 wa = *(const LAS u32x4*)(wpl + k2 * 512 + lane * 8), wb = *(const LAS u32x4*)(wpl + k2 * 512 + lane * 8 + 4);
            u32x4 gr[5];
#pragma unroll
            for (int j = 0; j < 5; ++j) gr[j] = *(const LAS u32x4*)(gl + (wave * 4 + 2 * k2 + j) * 1024 + lane * 16);
#pragma unroll
            for (int tt = 0; tt < 4; ++tt)
#pragma unroll
                for (int i = 0; i < 4; ++i) {
                    const unsigned p0 = __builtin_amdgcn_perm(gr[tt + 1][i], gr[tt][i], 0x05040100u), p1 = __builtin_amdgcn_perm(gr[tt + 1][i], gr[tt][i], 0x07060302u);
                    const unsigned wq0 = i < 2 ? wa[2 * i] : wb[2 * i - 4], wq1 = i < 2 ? wa[2 * i + 1] : wb[2 * i - 3];
                    acc[tt][2 * i] = __builtin_amdgcn_fdot2_f32_bf16(__builtin_bit_cast(bf16x2_t, p0), __builtin_bit_cast(bf16x2_t, wq0), acc[tt][2 * i], false);
                    acc[tt][2 * i + 1] = __builtin_amdgcn_fdot2_f32_bf16(__builtin_bit_cast(bf16x2_t, p1), __builtin_bit_cast(bf16x2_t, wq1), acc[tt][2 * i + 1], false);
                }
        }
#pragma unroll
        for (int tt = 0; tt < 4; ++tt) {
            const int row = tok0 + wave * 4 + tt;
            float s = 0.f;
#pragma unroll
            for (int c = 0; c < 8; ++c) s += acc[tt][c];
            const float mean = wave_sum_l(s, lane) * (1.f / 512.f); float q = 0.f;
#pragma unroll
            for (int c = 0; c < 8; ++c) { acc[tt][c] -= mean; q += acc[tt][c] * acc[tt][c]; }
            const float rstd = rsqrtf(wave_sum_l(q, lane) * (1.f / 512.f) + LN_EPS);
            float o8[8];
#pragma unroll
            for (int c = 0; c < 8; ++c) { const float z = acc[tt][c] * rstd * gch[c] + cch[c]; o8[c] = z * pg8::fsig(z); }
            *(u32x4*)(Y + (size_t)row * DM + lane * 8) = pg8::pack8((f32x4){o8[0], o8[1], o8[2], o8[3]}, (f32x4){o8[4], o8[5], o8[6], o8[7]});
            float cq[4], ck[2]; float sq = 0.f, sk = 0.f;
#pragma unroll
            for (int c = 0; c < 4; ++c) { cq[c] = __uint_as_float((c & 1) ? (cqv[tt][c >> 1] & 0xffff0000u) : (cqv[tt][c >> 1] << 16)); sq += cq[c] * cq[c]; }
            ck[0] = __uint_as_float(ckv[tt] << 16); ck[1] = __uint_as_float(ckv[tt] & 0xffff0000u); sk = ck[0] * ck[0] + ck[1] * ck[1];
            const float rq = rsqrtf(wave_sum_l(sq, lane) * (1.f / 256.f) + RMS_EPS), rk = rsqrtf(wave_sum_l(sk, lane) * (1.f / 128.f) + RMS_EPS);
            u32x2 wq; wq.x = pg8::cvt_pk_bf16(cq[0] * rq * qg[0], cq[1] * rq * qg[1]); wq.y = pg8::cvt_pk_bf16(cq[2] * rq * qg[2], cq[3] * rq * qg[3]);
            *(u32x2*)(CQKVN + (size_t)row * 384 + lane * 4) = wq;
            *(unsigned*)(CQKVN + (size_t)row * 384 + 256 + lane * 2) = pg8::cvt_pk_bf16(ck[0] * rk * kg0, ck[1] * rk * kg1);
            if (lane < 16) *(unsigned*)(KR + (size_t)row * 32 + 2 * lane) = pg8::cvt_pk_bf16(kx1[tt] * kcs[tt] - kx2[tt] * ksn[tt], kx2[tt] * kcs[tt] + kx1[tt] * ksn[tt]);
        }
    }
#undef OM_LOAD
    __syncthreads();
}

constexpr int LR_USTRIDE = 2048 + 32;
constexpr int LR_UH = 0, LR_UL = 16 * LR_USTRIDE, LR_PART = 2 * 16 * LR_USTRIDE, LR_LOG = LR_PART + 8 * 16 * 32 * 4, LR_CNT = LR_LOG + 16 * 32 * 4 + 16 * 4 * 4, LR_REC = LR_CNT + 256, LR_PAR = LR_REC + 4096, LR_END = LR_PAR + 4 * DM * 4;
static_assert(LR_END <= MISC_OFF, "lnr LDS map");
__device__ __forceinline__ void lnr_phase(LAS unsigned char* lds, const int wave, const int lane, const int bx, const int G,
                                          const bf16_t* __restrict__ V, const float* __restrict__ lng, const float* __restrict__ lnb, const float* __restrict__ mod_l, float* __restrict__ STAT, unsigned char* __restrict__ U8,
                                          const float* __restrict__ rw, const float* __restrict__ rb, int* __restrict__ TOPE, float* __restrict__ TOPG, int* __restrict__ POS, unsigned* CNT) {
    const int tid = wave * 64 + lane, fr = lane & 15, fq = lane >> 4;
    LAS unsigned* lcnt = (LAS unsigned*)(lds + LR_CNT);
    LAS unsigned* lrec = (LAS unsigned*)(lds + LR_REC);
    LAS float* part = (LAS float*)(lds + LR_PART); LAS float* logit = (LAS float*)(lds + LR_LOG);
    bf16x8 wh[4][2], wl[4][2];
#pragma unroll
    for (int s4 = 0; s4 < 4; ++s4)
#pragma unroll
        for (int nt = 0; nt < 2; ++nt) {
            float wv[8], wr[8];
#pragma unroll
            for (int j = 0; j < 8; ++j) { wv[j] = rw[(size_t)(128 * wave + 32 * s4 + 8 * fq + j) * NEXP + 16 * nt + fr]; wr[j] = wv[j] - bf2f(f2bf(wv[j])); }
            wh[s4][nt] = __builtin_bit_cast(bf16x8, pg8::pack8((f32x4){wv[0], wv[1], wv[2], wv[3]}, (f32x4){wv[4], wv[5], wv[6], wv[7]}));
            wl[s4][nt] = __builtin_bit_cast(bf16x8, pg8::pack8((f32x4){wr[0], wr[1], wr[2], wr[3]}, (f32x4){wr[4], wr[5], wr[6], wr[7]}));
        }
    const int Gb = G / NB, bb = bx / Gb, kb = bx - bb * Gb;
    const bool act = bb < NB;
    LAS float* par = (LAS float*)(lds + LR_PAR);
    if (act) { const float* m = mod_l + (size_t)bb * 6 * DM;
        for (int i = tid; i < DM / 4; i += NTHR) { *(LAS f32x4*)(par + 4 * i) = *(const f32x4*)(lng + 4 * i); *(LAS f32x4*)(par + DM + 4 * i) = *(const f32x4*)(lnb + 4 * i);
            *(LAS f32x4*)(par + 2 * DM + 4 * i) = *(const f32x4*)(m + 4 * DM + 4 * i) + 1.0f; *(LAS f32x4*)(par + 3 * DM + 4 * i) = *(const f32x4*)(m + 3 * DM + 4 * i); } }
    if (tid < 64) lcnt[tid] = 0u;
    const float rbias = rb[lane & 31];
    __syncthreads();
    u32x2 vpre[2][4];
    const int sb0 = bb * (SEQ / 16) + kb;
    if (act && kb < SEQ / 16) {
#pragma unroll
        for (int rr = 0; rr < 2; ++rr)
#pragma unroll
            for (int j = 0; j < 4; ++j) vpre[rr][j] = *(const u32x2*)(V + (size_t)(sb0 * 16 + 2 * wave + rr) * DM + j * 256 + lane * 4);
    }
    int li = 0;
    for (int sq = act ? kb : SEQ / 16; sq < SEQ / 16; sq += Gb, ++li) {
        const int sb = bb * (SEQ / 16) + sq, rbase = sb * 16;
        int l4 = lane * 4; asm volatile("" : "+v"(l4));
#pragma unroll
        for (int rr = 0; rr < 2; ++rr) {
            const int r16 = 2 * wave + rr; const size_t row = (size_t)(rbase + r16);
            float v[16]; float s = 0.f;
#pragma unroll
            for (int j = 0; j < 4; ++j) { const u32x2 tb = vpre[rr][j]; const f32x4 t4 = (f32x4){__uint_as_float(tb.x << 16), __uint_as_float(tb.x & 0xffff0000u), __uint_as_float(tb.y << 16), __uint_as_float(tb.y & 0xffff0000u)};
                v[4 * j] = t4[0]; v[4 * j + 1] = t4[1]; v[4 * j + 2] = t4[2]; v[4 * j + 3] = t4[3]; s += (t4[0] + t4[1]) + (t4[2] + t4[3]); }
            const float mean = wave_sum_l(s, lane) * (1.f / DM); float q = 0.f;
#pragma unroll
            for (int i = 0; i < 16; ++i) { v[i] -= mean; q += v[i] * v[i]; }
            const float rstd = rsqrtf(wave_sum_l(q, lane) * (1.f / DM) + LN_EPS);
            if (lane == 0) *(pg8::f32x2*)(STAT + row * 2) = (pg8::f32x2){mean, rstd};
#pragma unroll
            for (int j = 0; j < 4; ++j) {
                const f32x4 g4 = *(const LAS f32x4*)(par + j * 256 + l4), b4 = *(const LAS f32x4*)(par + DM + j * 256 + l4), sc4 = *(const LAS f32x4*)(par + 2 * DM + j * 256 + l4), sh4 = *(const LAS f32x4*)(par + 3 * DM + j * 256 + l4);
                f32x4 xn, uu, ur;
#pragma unroll
                for (int c = 0; c < 4; ++c) { xn[c] = v[4 * j + c] * rstd * g4[c] + b4[c]; uu[c] = xn[c] * sc4[c] + sh4[c]; }
                u32x2 ub; ub.x = pg8::cvt_pk_bf16(uu[0], uu[1]); ub.y = pg8::cvt_pk_bf16(uu[2], uu[3]);
                *(unsigned*)(U8 + row * DM + j * 256 + l4) = pk4_fp8(uu[0], uu[1], uu[2], uu[3]);
                ur[0] = uu[0] - __uint_as_float(ub.x << 16); ur[1] = uu[1] - __uint_as_float(ub.x & 0xffff0000u); ur[2] = uu[2] - __uint_as_float(ub.y << 16); ur[3] = uu[3] - __uint_as_float(ub.y & 0xffff0000u);
                u32x2 ul; ul.x = pg8::cvt_pk_bf16(ur[0], ur[1]); ul.y = pg8::cvt_pk_bf16(ur[2], ur[3]);
                *(LAS u32x2*)(lds + LR_UH + r16 * LR_USTRIDE + (j * 256 + l4) * 2) = ub;
                *(LAS u32x2*)(lds + LR_UL + r16 * LR_USTRIDE + (j * 256 + l4) * 2) = ul;
            }
        }
        if (sq + Gb < SEQ / 16) {
#pragma unroll
            for (int rr = 0; rr < 2; ++rr)
#pragma unroll
                for (int j = 0; j < 4; ++j) vpre[rr][j] = *(const u32x2*)(V + (size_t)((sb + Gb) * 16 + 2 * wave + rr) * DM + j * 256 + l4);
        }
        __syncthreads();
        f32x4 acc0 = (f32x4){0.f, 0.f, 0.f, 0.f}, acc1 = (f32x4){0.f, 0.f, 0.f, 0.f};
#pragma unroll
        for (int s4 = 0; s4 < 4; ++s4) {
            const bf16x8 uh = *(const LAS bf16x8*)(lds + LR_UH + fr * LR_USTRIDE + (128 * wave + 32 * s4 + 8 * fq) * 2);
            const bf16x8 ul = *(const LAS bf16x8*)(lds + LR_UL + fr * LR_USTRIDE + (128 * wave + 32 * s4 + 8 * fq) * 2);
            acc0 = __builtin_amdgcn_mfma_f32_16x16x32_bf16(uh, wh[s4][0], acc0, 0, 0, 0); acc1 = __builtin_amdgcn_mfma_f32_16x16x32_bf16(uh, wh[s4][1], acc1, 0, 0, 0);
            acc0 = __builtin_amdgcn_mfma_f32_16x16x32_bf16(ul, wh[s4][0], acc0, 0, 0, 0); acc1 = __builtin_amdgcn_mfma_f32_16x16x32_bf16(ul, wh[s4][1], acc1, 0, 0, 0);
            acc0 = __builtin_amdgcn_mfma_f32_16x16x32_bf16(uh, wl[s4][0], acc0, 0, 0, 0); acc1 = __builtin_amdgcn_mfma_f32_16x16x32_bf16(uh, wl[s4][1], acc1, 0, 0, 0);
        }
#pragma unroll
        for (int r = 0; r < 4; ++r) { part[(wave * 16 + 4 * fq + r) * 32 + fr] = acc0[r]; part[(wave * 16 + 4 * fq + r) * 32 + 16 + fr] = acc1[r]; }
        __syncthreads();
        { const int rr = lane >> 5, e = lane & 31, r16 = 2 * wave + rr; const size_t row = (size_t)(rbase + r16);
            float sv = rbias;
#pragma unroll
            for (int w8 = 0; w8 < 8; ++w8) sv += part[(w8 * 16 + r16) * 32 + e];
            logit[r16 * 32 + e] = sv;
            asm volatile("s_waitcnt lgkmcnt(0)" ::: "memory");
            int rank = 0;
#pragma unroll
            for (int e4 = 0; e4 < 8; ++e4) { const f32x4 t4 = *(const LAS f32x4*)(logit + r16 * 32 + 4 * e4);
#pragma unroll
                for (int c = 0; c < 4; ++c) { const int j = 4 * e4 + c; rank += (t4[c] > sv || (t4[c] == sv && j < e)) ? 1 : 0; } }
            LAS float* sel = logit + 512 + r16 * 4;
            if (rank < 4) sel[rank] = sv;
            asm volatile("s_waitcnt lgkmcnt(0)" ::: "memory");
            if (rank < 4) {
                const f32x4 t4 = *(const LAS f32x4*)sel;
                const float ex1 = __expf(t4[1] - t4[0]), ex2 = __expf(t4[2] - t4[0]), ex3 = __expf(t4[3] - t4[0]), inv = 1.0f / ((1.0f + ex1) + (ex2 + ex3));
                const unsigned k = __hip_atomic_fetch_add(lcnt + e, 1u, __ATOMIC_RELAXED, __HIP_MEMORY_SCOPE_WORKGROUP);
                lrec[(li * 16 + r16) * 4 + rank] = ((unsigned)e << 16) | k;
                TOPE[row * 4 + rank] = e; TOPG[row * 4 + rank] = __expf(sv - t4[0]) * inv;
            }
        }
        __syncthreads();
    }
    if (tid < NEXP) lcnt[32 + tid] = atomicAdd(&CNT[tid], lcnt[tid]);
    __syncthreads();
    for (int i = tid; i < li * 64; i += NTHR) { const unsigned rec = lrec[i]; const int sb = sb0 + (i >> 6) * Gb; POS[(size_t)sb * 64 + (i & 63)] = (int)(lcnt[32 + (rec >> 16)] + (rec & 0xffffu)); }
    __syncthreads();
}

__device__ __forceinline__ void unpack8(const u32x4 w, float (&f)[8]) {
#pragma unroll
    for (int c = 0; c < 4; ++c) { f[2 * c] = __uint_as_float(w[c] << 16); f[2 * c + 1] = __uint_as_float(w[c] & 0xffff0000u); }
}
__device__ __forceinline__ void unpack8_fp8(const u32x2 w, float (&f)[8]) {
#pragma unroll
    for (int c = 0; c < 2; ++c) { const auto lo = __builtin_amdgcn_cvt_pk_f32_fp8((int)w[c], false), hi = __builtin_amdgcn_cvt_pk_f32_fp8((int)w[c], true);
        f[4 * c] = lo[0]; f[4 * c + 1] = lo[1]; f[4 * c + 2] = hi[0]; f[4 * c + 3] = hi[1]; }
}
__device__ __forceinline__ void lnf_phase(LAS unsigned char* lds, const int wave, const int lane, const int bx, const int G, const unsigned char* __restrict__ YS, const int* __restrict__ SLOT, const float* __restrict__ TOPG,
                                          const float* __restrict__ lng, const float* __restrict__ lnb, const float* __restrict__ mod_l, const float* __restrict__ mod_n,
                                          const bf16_t* __restrict__ V, const float* __restrict__ STAT, const float* __restrict__ lmg, const float* __restrict__ lmb,
                                          bf16_t* __restrict__ X, bf16_t* __restrict__ U, float* __restrict__ out_final) {
    const int Gb = G / NB, bb = bx / Gb, kb = bx - bb * Gb, tid = wave * 64 + lane;
    if (bb >= NB) return;
    LAS float* par = (LAS float*)lds;
    { const float* m = mod_l + (size_t)bb * 6 * DM; const float* mn = mod_n + (size_t)bb * 6 * DM;
        for (int i = tid; i < DM / 4; i += NTHR) { *(LAS f32x4*)(par + 4 * i) = *(const f32x4*)(m + 5 * DM + 4 * i) + 1.0f; *(LAS f32x4*)(par + DM + 4 * i) = *(const f32x4*)(lng + 4 * i); *(LAS f32x4*)(par + 2 * DM + 4 * i) = *(const f32x4*)(lnb + 4 * i);
            *(LAS f32x4*)(par + 3 * DM + 4 * i) = *(const f32x4*)(lmg + 4 * i); *(LAS f32x4*)(par + 4 * DM + 4 * i) = *(const f32x4*)(lmb + 4 * i);
            if (!out_final) { *(LAS f32x4*)(par + 5 * DM + 4 * i) = *(const f32x4*)(mn + DM + 4 * i) + 1.0f; *(LAS f32x4*)(par + 6 * DM + 4 * i) = *(const f32x4*)(mn + 4 * i); } } }
    __syncthreads();
    for (int p = kb * NWAVES + wave; p < SEQ / 2; p += Gb * NWAVES) {
        const int row0 = bb * SEQ + 2 * p;
        int l8 = lane * 8; asm volatile("" : "+v"(l8));
        u32x4 sl[2]; f32x4 gk[2]; pg8::f32x2 st[2];
#pragma unroll
        for (int rr = 0; rr < 2; ++rr) { sl[rr] = *(const u32x4*)(SLOT + (size_t)(row0 + rr) * 4); gk[rr] = *(const f32x4*)(TOPG + (size_t)(row0 + rr) * 4) * 0.0625f; st[rr] = *(const pg8::f32x2*)(STAT + (size_t)(row0 + rr) * 2); }
        u32x2 yv[2][4][2]; u32x4 xv[2][2];
#pragma unroll
        for (int rr = 0; rr < 2; ++rr) {
#pragma unroll
            for (int k = 0; k < 4; ++k)
#pragma unroll
                for (int j = 0; j < 2; ++j) yv[rr][k][j] = *(const u32x2*)(YS + (size_t)sl[rr][k] * DM + j * 512 + l8);
#pragma unroll
            for (int j = 0; j < 2; ++j) xv[rr][j] = *(const u32x4*)(V + (size_t)(row0 + rr) * DM + j * 512 + l8);
        }
#pragma unroll
        for (int rr = 0; rr < 2; ++rr) {
            const size_t row = (size_t)(row0 + rr);
            float v[16]; float s = 0.f;
#pragma unroll
            for (int j = 0; j < 2; ++j) {
                float y[8], t[8], xs[8];
#pragma unroll
                for (int c = 0; c < 8; ++c) y[c] = 0.f;
#pragma unroll
                for (int k = 0; k < 4; ++k) { unpack8_fp8(yv[rr][k][j], t);
#pragma unroll
                    for (int c = 0; c < 8; ++c) y[c] += gk[rr][k] * t[c]; }
                unpack8(xv[rr][j], xs);
                { const f32x4 a0 = *(const LAS f32x4*)(par + 3 * DM + j * 512 + l8), a1 = *(const LAS f32x4*)(par + 3 * DM + j * 512 + l8 + 4), b0 = *(const LAS f32x4*)(par + 4 * DM + j * 512 + l8), b1 = *(const LAS f32x4*)(par + 4 * DM + j * 512 + l8 + 4);
#pragma unroll
                  for (int c = 0; c < 8; ++c) xs[c] = (xs[c] - st[rr].x) * st[rr].y * (c < 4 ? a0[c & 3] : a1[c & 3]) + (c < 4 ? b0[c & 3] : b1[c & 3]); }
                const f32x4 g0 = *(const LAS f32x4*)(par + j * 512 + l8), g1 = *(const LAS f32x4*)(par + j * 512 + l8 + 4);
#pragma unroll
                for (int c = 0; c < 8; ++c) { v[8 * j + c] = ALPHA * xs[c] + (c < 4 ? g0[c & 3] : g1[c & 3]) * y[c]; s += v[8 * j + c]; }
            }
            const float mean = wave_sum_l(s, lane) * (1.f / DM); float q = 0.f;
#pragma unroll
            for (int i = 0; i < 16; ++i) { v[i] -= mean; q += v[i] * v[i]; }
            const float rstd = rsqrtf(wave_sum_l(q, lane) * (1.f / DM) + LN_EPS);
#pragma unroll
            for (int j = 0; j < 2; ++j) {
                const f32x4 a0 = *(const LAS f32x4*)(par + DM + j * 512 + l8), a1 = *(const LAS f32x4*)(par + DM + j * 512 + l8 + 4), b0 = *(const LAS f32x4*)(par + 2 * DM + j * 512 + l8), b1 = *(const LAS f32x4*)(par + 2 * DM + j * 512 + l8 + 4);
                f32x4 x0, x1;
#pragma unroll
                for (int c = 0; c < 4; ++c) { x0[c] = v[8 * j + c] * rstd * a0[c] + b0[c]; x1[c] = v[8 * j + 4 + c] * rstd * a1[c] + b1[c]; }
                if (out_final) { *(f32x4*)(out_final + row * DM + j * 512 + l8) = x0; *(f32x4*)(out_final + row * DM + j * 512 + l8 + 4) = x1; }
                else {
                    *(u32x4*)(X + row * DM + j * 512 + l8) = pg8::pack8(x0, x1);
                    const f32x4 sc0 = *(const LAS f32x4*)(par + 5 * DM + j * 512 + l8), sc1 = *(const LAS f32x4*)(par + 5 * DM + j * 512 + l8 + 4), sh0 = *(const LAS f32x4*)(par + 6 * DM + j * 512 + l8), sh1 = *(const LAS f32x4*)(par + 6 * DM + j * 512 + l8 + 4);
                    *(u32x4*)(U + row * DM + j * 512 + l8) = pg8::pack8(x0 * sc0 + sh0, x1 * sc1 + sh1);
                }
            }
        }
    }
}

struct Params {
    const float *x_in, *c_in; const int* pos_in;
    const float *ada_w, *ada_b, *ln_mix_g, *ln_mix_b, *ln_ffn_g, *ln_ffn_b;
    const float *ev_w_in, *ev_conv_w, *ev_sg_w, *ev_sg_b, *ev_vn_g, *ev_vn_b, *ev_w_out;
    const float *od_w_in, *od_dw_w, *od_dw_b, *od_cn_g, *od_cn_b, *od_qn_g, *od_w_uq, *od_kvn_g, *od_w_ukv, *od_w_out;
    const float *r_w, *r_b, *w_gu, *b_gu, *w_dn, *b_dn;
    float* out; unsigned char* ws;
    int ph_lo, ph_hi;
};
constexpr int PH_PREP = 0, PH_MOD0 = 1, PH_LAYER0 = 2, PH_STRIDE = 16, PH_END = PH_LAYER0 + PH_STRIDE * (DEPTH - 1) + 10;
constexpr int LP_IN = 0, LP_MIX = 1, LP_UP = 2, LP_ATT = 3, LP_OUT = 4, LP_LNR = 5, LP_SCAT = 6, LP_M1 = 7, LP_M2 = 8, LP_LNF = 9;

enum { WM_ID = 0, WM_GU = 1, WM_EIN = 2, WM_OIN = 3, WM_UQ = 4, WM_UKV = 5 };
__device__ __forceinline__ int srccol(int mode, int pr) {
    const int tile = pr >> 8, r = pr & 255;
    switch (mode) {
        case WM_GU: return (r < 128 ? 0 : 1024) + tile * 128 + (r & 127);
        case WM_EIN: return (tile < 2 || tile >= 6) ? pr : ((r < 128 ? 512 : 1024) + (tile - 2) * 128 + (r & 127));
        case WM_OIN: if (tile < 4) return (r < 128 ? 0 : 512) + tile * 128 + (r & 127); if (tile == 4) return 1024 + r; return r < 128 ? 1280 + r : (r < 160 ? 1408 + (r - 128) : -1);
        case WM_UQ: { const int h = pr / 96, d = pr - 96 * h; return d < 64 ? pr : h * 96 + 64 + 16 * ((d - 64) & 1) + ((d - 64) >> 1); }
        case WM_UKV: { const int j = pr & 511, h = j >> 6, d = j & 63; return h * 128 + (pr < 512 ? 0 : 64) + d; }
        default: return pr;
    }
}
__device__ __forceinline__ void transpose_item(const float* W, int ldw, bf16_t* WT, int ldk, int k0, int n0, int mode, LAS float* scr, int lane) {
    if (mode == WM_UQ) {
        const int sc = srccol(mode, n0 + (lane & 31));
#pragma unroll 8
        for (int i = 0; i < 32; ++i) { const int kk = 2 * i + (lane >> 5); scr[kk * 33 + (lane & 31)] = W[(size_t)(k0 + kk) * ldw + sc]; }
    } else {
        const int c4 = (lane & 7) * 4, sc = srccol(mode, n0 + c4);
        f32x4 t[8];
#pragma unroll
        for (int i = 0; i < 8; ++i) { const int kk = 8 * i + (lane >> 3); t[i] = sc >= 0 ? __builtin_nontemporal_load((const f32x4*)(W + (size_t)(k0 + kk) * ldw + sc)) : (f32x4){0.f, 0.f, 0.f, 0.f}; }
#pragma unroll
        for (int i = 0; i < 8; ++i) { const int kk = 8 * i + (lane >> 3); LAS float* d = scr + kk * 33 + c4; d[0] = t[i][0]; d[1] = t[i][1]; d[2] = t[i][2]; d[3] = t[i][3]; }
    }
    asm volatile("s_waitcnt lgkmcnt(0)" ::: "memory");
    const int c = lane & 7;
#pragma unroll
    for (int j = 0; j < 4; ++j) { const int n = (lane >> 3) + 8 * j; const LAS float* s = scr + (8 * c) * 33 + n;
        u32x4 o; o.x = pg8::cvt_pk_bf16(s[0 * 33], s[1 * 33]); o.y = pg8::cvt_pk_bf16(s[2 * 33], s[3 * 33]); o.z = pg8::cvt_pk_bf16(s[4 * 33], s[5 * 33]); o.w = pg8::cvt_pk_bf16(s[6 * 33], s[7 * 33]);
        *(u32x4*)(WT + (size_t)(n0 + n) * ldk + k0 + 8 * c) = o; }
    asm volatile("s_waitcnt lgkmcnt(0)" ::: "memory");
}
__device__ __forceinline__ void transpose_item_f8(const float* W, int ldw, unsigned char* WT, int ldk, int k0, int n0, int mode, float mul, LAS float* scr, int lane) {
    const int c4 = (lane & 7) * 4, sc = srccol(mode, n0 + c4);
    f32x4 t[8];
#pragma unroll
    for (int i = 0; i < 8; ++i) { const int kk = 8 * i + (lane >> 3); t[i] = __builtin_nontemporal_load((const f32x4*)(W + (size_t)(k0 + kk) * ldw + sc)); }
#pragma unroll
    for (int i = 0; i < 8; ++i) { const int kk = 8 * i + (lane >> 3); LAS float* d = scr + kk * 33 + c4; d[0] = t[i][0] * mul; d[1] = t[i][1] * mul; d[2] = t[i][2] * mul; d[3] = t[i][3] * mul; }
    asm volatile("s_waitcnt lgkmcnt(0)" ::: "memory");
    const int c = lane & 3;
#pragma unroll
    for (int j = 0; j < 2; ++j) { const int n = (lane >> 2) + 16 * j; const LAS float* s = scr + (16 * c) * 33 + n;
        u32x4 o; o.x = pk4_fp8(s[0 * 33], s[1 * 33], s[2 * 33], s[3 * 33]); o.y = pk4_fp8(s[4 * 33], s[5 * 33], s[6 * 33], s[7 * 33]);
        o.z = pk4_fp8(s[8 * 33], s[9 * 33], s[10 * 33], s[11 * 33]); o.w = pk4_fp8(s[12 * 33], s[13 * 33], s[14 * 33], s[15 * 33]);
        *(u32x4*)(WT + (size_t)(n0 + n) * ldk + k0 + 16 * c) = o; }
    asm volatile("s_waitcnt lgkmcnt(0)" ::: "memory");
}
__device__ __forceinline__ bool prep_family_f8(int& it, const float* W, size_t wstride, int ldw, int K, int nphys, unsigned char* WT, size_t tstride, int ldk, int nmat, int mode, float mul, LAS float* scr, int lane) {
    const int nblk = nphys / 32, per = (K / 64) * nblk, tot = per * nmat;
    if (it >= tot) { it -= tot; return false; }
    const int mi = it / per, r = it % per, kb = r / nblk, nb = r % nblk;
    transpose_item_f8(W + (size_t)mi * wstride, ldw, WT + (size_t)mi * tstride, ldk, kb * 64, nb * 32, mode, mul, scr, lane);
    return true;
}
__device__ __forceinline__ bool prep_family(int& it, const float* W, size_t wstride, int ldw, int K, int nphys, bf16_t* WT, size_t tstride, int ldk, int koff, int nmat, int mode, LAS float* scr, int lane) {
    const int nblk = nphys / 32, per = (K / 64) * nblk, tot = per * nmat;
    if (it >= tot) { it -= tot; return false; }
    const int mi = it / per, r = it % per, kb = r / nblk, nb = r % nblk;
    transpose_item(W + (size_t)mi * wstride, ldw, WT + (size_t)mi * tstride + koff, ldk, kb * 64, nb * 32, mode, scr, lane);
    return true;
}


struct F8Item { const float* src; unsigned char* dst; float mul; };
constexpr int F8_SCR = 128 * 33 * 4;
__device__ __forceinline__ F8Item f8_item(const Params& P, unsigned char* ws, int it, int lane) {
    F8Item r; const int c4 = (lane & 7) * 4;
    if (it < 128 * 512) { const int mi = it >> 9, q = it & 511, k0 = (q >> 6) * 128, n0 = (q & 63) * 32;
        r.src = P.w_gu + (size_t)mi * DM * 2048 + (size_t)(k0 + (lane >> 3)) * 2048 + srccol(WM_GU, n0 + c4);
        r.dst = ws + WT_GU + (size_t)mi * 2048 * DM + (size_t)(n0 + (lane >> 3)) * DM + k0 + 16 * (lane & 7); r.mul = (float)(1 << W8_GU_SH); }
    else { const int i2 = it - 128 * 512, mi = i2 >> 8, q = i2 & 255, k0 = (q >> 5) * 128, n0 = (q & 31) * 32;
        r.src = P.w_dn + (size_t)mi * DM * DM + (size_t)(k0 + (lane >> 3)) * DM + n0 + c4;
        r.dst = ws + WT_DN + (size_t)mi * DM * DM + (size_t)(n0 + (lane >> 3)) * DM + k0 + 16 * (lane & 7); r.mul = (float)(1 << W8_DN_SH); }
    return r;
}
constexpr int F8_ITEMS_GU = 32 * 512, F8_ITEMS_DN = 32 * 256, F8_ITEMS_LAYER = F8_ITEMS_GU + F8_ITEMS_DN;
__device__ __forceinline__ int f8_item_id(int layer, int j) { return j < F8_ITEMS_GU ? layer * F8_ITEMS_GU + j : DEPTH * F8_ITEMS_GU + layer * F8_ITEMS_DN + (j - F8_ITEMS_GU); }
__device__ __forceinline__ void f8_convert(const Params& P, unsigned char* ws, LAS float* scr, int lane, int it) {
    const F8Item cur = f8_item(P, ws, it, lane);
    const int ldw = it < 128 * 512 ? 2048 : DM;
    f32x4 t[16];
#pragma unroll
    for (int i = 0; i < 16; ++i) t[i] = __builtin_nontemporal_load((const f32x4*)(cur.src + (size_t)(8 * i) * ldw));
    const int c4 = (lane & 7) * 4;
#pragma unroll
    for (int i = 0; i < 16; ++i) { const int kk = 8 * i + (lane >> 3); LAS float* d = scr + kk * 33 + c4; d[0] = t[i][0] * cur.mul; d[1] = t[i][1] * cur.mul; d[2] = t[i][2] * cur.mul; d[3] = t[i][3] * cur.mul; }
    asm volatile("s_waitcnt lgkmcnt(0)" ::: "memory");
#pragma unroll
    for (int j = 0; j < 4; ++j) { const LAS float* sp = scr + (16 * (lane & 7)) * 33 + (lane >> 3) + 8 * j;
        u32x4 o; o.x = pk4_fp8(sp[0 * 33], sp[1 * 33], sp[2 * 33], sp[3 * 33]); o.y = pk4_fp8(sp[4 * 33], sp[5 * 33], sp[6 * 33], sp[7 * 33]);
        o.z = pk4_fp8(sp[8 * 33], sp[9 * 33], sp[10 * 33], sp[11 * 33]); o.w = pk4_fp8(sp[12 * 33], sp[13 * 33], sp[14 * 33], sp[15 * 33]);
        *(u32x4*)(cur.dst + (size_t)(8 * j) * DM) = o; }
    asm volatile("s_waitcnt lgkmcnt(0)" ::: "memory");
}
struct SparePlan { int g1, q1, g2, q2, done; };
__device__ __forceinline__ SparePlan spare_plan(int nM, int G) {
    SparePlan p; const int n1 = nM * 8, r1 = (n1 + G - 1) / G, n2 = nM * 4, r2 = (n2 + G - 1) / G;
    p.g1 = (n1 + r1 - 1) / r1; p.q1 = 32 * r1; p.g2 = (n2 + r2 - 1) / r2; p.q2 = 40 * r2;
    const int d = (G - p.g1) * p.q1 + (G - p.g2) * p.q2; p.done = d < F8_ITEMS_LAYER ? d : F8_ITEMS_LAYER; return p;
}
__device__ __forceinline__ void f8_convert_range(const Params& P, unsigned char* ws, LAS float* scr, int lane, int wave, int layer, int j0, int j1) {
    if (j1 > F8_ITEMS_LAYER) j1 = F8_ITEMS_LAYER;
    for (int j = j0 + wave; j < j1; j += NWAVES) f8_convert(P, ws, scr, lane, f8_item_id(layer, j));
}
#define PH_LOCALS \
    __attribute__((address_space(1))) unsigned char* wsg = (__attribute__((address_space(1))) unsigned char*)P.ws; asm volatile("" : "+s"(wsg)); unsigned char* ws = (unsigned char*)wsg;     \
    const int lane = lane_id_asm(); \
    int wave = wave0; asm volatile("" : "+s"(wave)); const int tid = wave * 64 + lane; \
    int bx = blockIdx.x, G = gridDim.x; asm volatile("" : "+s"(bx), "+s"(G)); \
    const int gw = bx * NWAVES + wave, NW = G * NWAVES; \
    const size_t gtid = (size_t)bx * NTHR + tid, GT = (size_t)G * NTHR; \
    unsigned* ctl = (unsigned*)(ws + WS_CTL); \
    float* MOD = (float*)(ws + WS_MOD); float* CS = (float*)(ws + WS_CS); float* X = (float*)(ws + WS_X); float* V = (float*)(ws + WS_V); \
    bf16_t* U = (bf16_t*)(ws + WS_U); bf16_t* Y = (bf16_t*)(ws + WS_Y); bf16_t* BG = (bf16_t*)(ws + WS_BG); bf16_t* CX = (bf16_t*)(ws + WS_CX); bf16_t* GZU = (bf16_t*)(ws + WS_GZU); bf16_t* GZV = (bf16_t*)(ws + WS_GZV); \
    bf16_t* GLU = (bf16_t*)(ws + WS_GLU); bf16_t* CQKV = (bf16_t*)(ws + WS_CQKV); bf16_t* CQKVN = (bf16_t*)(ws + WS_CQKVN); bf16_t* KRR = (bf16_t*)(ws + WS_KRR); bf16_t* KR = (bf16_t*)(ws + WS_KR); \
    bf16_t* Q = (bf16_t*)(ws + WS_Q); bf16_t* KN = (bf16_t*)(ws + WS_KN); bf16_t* VV = (bf16_t*)(ws + WS_VV); \
    int* TOPE = (int*)(ws + WS_TOPE); float* TOPG = (float*)(ws + WS_TOPG); int* POS = (int*)(ws + WS_POS); int* SLOT = (int*)(ws + WS_SLOT); int* ROWTOK = (int*)(ws + WS_ROWTOK); \
    bf16_t* H = (bf16_t*)(ws + WS_H); unsigned char* YS = (unsigned char*)(ws + WS_YS); \
    (void)lane; (void)wave; (void)gw; (void)NW; (void)gtid; (void)GT; (void)ctl; (void)MOD; (void)CS; (void)X; (void)V; (void)U; (void)Y; (void)BG; (void)CX; (void)GZU; (void)GZV; (void)GLU; (void)CQKV; (void)CQKVN; \
    (void)KRR; (void)KR; (void)Q; (void)KN; (void)VV; (void)TOPE; (void)TOPG; (void)POS; (void)SLOT; (void)ROWTOK; (void)H; (void)YS
#define LY_LOCALS \
    int ly = layer; asm volatile("" : "+s"(ly)); const int li = ly >> 1; \
    const float* mod_l = MOD + (size_t)ly * NB * 6 * DM; const float* mod_n = MOD + (size_t)(ly + 1) * NB * 6 * DM; \
    const float* xres = ly == 0 ? P.x_in : X; \
    unsigned* CNT = ctl + CW_CNT + ly * 32; unsigned* OFFS = ctl + CW_OFFS + ly * 64; \
    (void)li; (void)mod_l; (void)mod_n; (void)xres; (void)CNT; (void)OFFS

__global__ void __launch_bounds__(NTHR, 2) mega(Params P) {
    extern __shared__ __attribute__((aligned(16))) unsigned char lds_raw[];
    LAS unsigned char* lds = (LAS unsigned char*)lds_raw;
    volatile LAS unsigned* MISC = (volatile LAS unsigned*)(lds + MISC_OFF);
    for (int u = threadIdx.x; u < (LDS_BYTES - MISC_OFF) / 4; u += NTHR) ((LAS unsigned*)(lds + MISC_OFF))[u] = 0u;
    __syncthreads();
    const int wave0 = __builtin_amdgcn_readfirstlane((int)(threadIdx.x >> 6));
    XcdBarrier bar = xcd_barrier_post((unsigned*)(P.ws + WS_CTL) + CW_BAR, MISC + 8, wave0);
    const int lo = P.ph_lo, hi = P.ph_hi;
#define IN(k) (lo <= (k) && (k) < hi)
#define SEAM(k) do { if ((k) + 1 < hi) xcd_barrier(bar); } while (0)

    if (IN(PH_PREP)) {
        PH_LOCALS;
        LAS float* scr = (LAS float*)(lds + wave * F8_SCR);
        for (int j = gw; j < F8_ITEMS_LAYER; j += NW) f8_convert(P, ws, scr, lane, f8_item_id(0, j));
        constexpr int NITEMS = 2 * 1280 + 2 * 512 + 2 * 768 + 2 * 96 + 2 * 64 + 2 * 512;
        for (int it0 = gw; it0 < NITEMS; it0 += NW) {
            int it = it0;
            if (prep_family(it, P.ev_w_in, (size_t)DM * 2560, 2560, DM, 2560, (bf16_t*)(ws + WT_EIN), (size_t)2560 * DM, DM, 0, 2, WM_EIN, scr, lane)) continue;
            if (prep_family(it, P.ev_w_out, (size_t)DM * DM, DM, DM, DM, (bf16_t*)(ws + WT_EOUT), (size_t)DM * DM, DM, 0, 2, WM_ID, scr, lane)) continue;
            if (prep_family(it, P.od_w_in, (size_t)DM * 1440, 1440, DM, 1536, (bf16_t*)(ws + WT_OIN), (size_t)1536 * DM, DM, 0, 2, WM_OIN, scr, lane)) continue;
            if (prep_family(it, P.od_w_uq, (size_t)256 * 768, 768, 256, 768, (bf16_t*)(ws + WT_OUP), (size_t)1792 * 256, 256, 0, 2, WM_UQ, scr, lane)) continue;
            if (prep_family(it, P.od_w_ukv, (size_t)128 * 1024, 1024, 128, 1024, (bf16_t*)(ws + WT_OUP) + (size_t)768 * 256, (size_t)1792 * 256, 256, 128, 2, WM_UKV, scr, lane)) continue;
            prep_family(it, P.od_w_out, (size_t)DM * DM, DM, DM, DM, (bf16_t*)(ws + WT_OOUT), (size_t)DM * DM, DM, 0, 2, WM_ID, scr, lane);
        }
        for (size_t i = gtid; i < (size_t)2 * 1792 * 256; i += GT) { const int col = (int)(i & 255), row = (int)((i >> 8) % 1792); if (row >= 768 && col < 128) ((bf16_t*)(ws + WT_OUP))[i] = 0; }
        for (size_t i = gtid; i < (size_t)2 * 8 * 128 * 128; i += GT) { const int jj = (int)(i & 127), ii = (int)((i >> 7) & 127); ((bf16_t*)(ws + WT_SGW))[i] = jj <= ii ? f2bf(P.ev_sg_w[i]) : (bf16_t)0; }
        for (size_t i = gtid; i < (size_t)NT * 16; i += GT) { const int tok = (int)(i >> 4), f = (int)(i & 15); float c, s; sincos_d((double)P.pos_in[tok] * INVF[f], c, s); CS[(size_t)tok * 32 + f] = c; CS[(size_t)tok * 32 + 16 + f] = s; }
        __syncthreads();
        {
            LAS float* sc = (LAS float*)lds;
            LAS float* red = (LAS float*)(lds + 32768);
            for (int i = tid; i < NB * DM; i += NTHR) { const float v = P.c_in[i]; sc[i] = v * sigmoidf_(v); }
            __syncthreads();
            for (int item = bx; item < DEPTH * 6 * DM / 64; item += G) {
                const int col = item * 64 + (tid & 63), l = col / (6 * DM), n = col % (6 * DM), kg = tid >> 6;
                float a[NB];
#pragma unroll
                for (int b = 0; b < NB; ++b) a[b] = 0.f;
                const float* w = P.ada_w + (size_t)l * DM * 6 * DM + (size_t)(kg * 128) * 6 * DM + n;
                for (int k = 0; k < 128; ++k) { const float wv = w[(size_t)k * 6 * DM];
#pragma unroll
                    for (int b = 0; b < NB; ++b) a[b] += sc[b * DM + kg * 128 + k] * wv; }
#pragma unroll
                for (int b = 0; b < NB; ++b) red[(kg * NB + b) * 64 + (tid & 63)] = a[b];
                __syncthreads();
                { const int b = tid >> 6, cc = tid & 63; float s = 0.f;
#pragma unroll
                    for (int k8 = 0; k8 < 8; ++k8) s += red[(k8 * NB + b) * 64 + cc];
                    const int col2 = item * 64 + cc, l2 = col2 / (6 * DM), n2 = col2 % (6 * DM);
                    MOD[((size_t)l2 * NB + b) * 6 * DM + n2] = s + P.ada_b[(size_t)l2 * 6 * DM + n2]; }
                __syncthreads();
            }
        }
        SEAM(PH_PREP);
    }
    if (IN(PH_MOD0)) {
        PH_LOCALS;
        for (size_t i = gtid * 4; i < (size_t)NT * DM; i += GT * 4) { const int tok = (int)(i / DM), col = (int)(i % DM), b = tok / SEQ; const float* m = MOD + (size_t)b * 6 * DM;
            const float4 xv = *(const float4*)(P.x_in + i), sc = *(const float4*)(m + DM + col), sh = *(const float4*)(m + col);
            ushort4 o; o.x = f2bf(xv.x * (1.f + sc.x) + sh.x); o.y = f2bf(xv.y * (1.f + sc.y) + sh.y); o.z = f2bf(xv.z * (1.f + sc.z) + sh.z); o.w = f2bf(xv.w * (1.f + sc.w) + sh.w);
            *(ushort4*)(U + i) = o; }
        SEAM(PH_MOD0);
    }

#define CATCHUP_F8 do { if (ly > 0) { const int nMp = __builtin_amdgcn_readfirstlane((int)(ctl[CW_OFFS + (ly - 1) * 64 + NEXP] >> 8)); const SparePlan spc = spare_plan(nMp, G); \
            LAS float* scr = (LAS float*)(lds + wave * F8_SCR); for (int j = spc.done + gw; j < F8_ITEMS_LAYER; j += NW) f8_convert(P, ws, scr, lane, f8_item_id(ly, j)); __syncthreads(); } } while (0)
    for (int layer = 0; layer < DEPTH; ++layer) {
        const int pb = PH_LAYER0 + PH_STRIDE * layer;
        if ((layer & 1) == 0) {
            if (IN(pb + LP_IN)) {
                PH_LOCALS; LY_LOCALS;
                pg8::Gemm g{U, DM, nullptr, (const bf16_t*)(ws + WT_EIN) + (size_t)li * 2560 * DM, DM, 0, DM};
                pg8::Sched S; S.init(NT / 256, 10, G, bx, nullptr);
                pg8::EpiE1 E{BG, CX, GZU, GZV};
                const bool cfirst = ((bx >> 3) & 1) != 0;
#pragma unroll 1
                for (int st = 0; st < 2; ++st) { if ((st == 0) == cfirst) CATCHUP_F8; else pg8::gemm_phase(lds, wave, g, S, E); }
                SEAM(pb + LP_IN);
            }
            if (IN(pb + LP_MIX)) {
                PH_LOCALS; LY_LOCALS;
                even_mix_phase(lds, wave, lane, bx, G, BG, CX, GZU, GZV, (const bf16_t*)(ws + WT_SGW) + (size_t)li * 8 * 128 * 128, P.ev_conv_w + (size_t)li * 3 * 512, P.ev_sg_b + (size_t)li * 8 * 128,
                               P.ev_vn_g + (size_t)li * 512, P.ev_vn_b + (size_t)li * 512, Y);
                SEAM(pb + LP_MIX);
            }
        } else {
            if (IN(pb + LP_IN)) {
                PH_LOCALS; LY_LOCALS;
                pg8::Gemm g{U, DM, nullptr, (const bf16_t*)(ws + WT_OIN) + (size_t)li * 1536 * DM, DM, 0, DM};
                pg8::Sched S; S.init(NT / 256, 6, G, bx, nullptr);
                pg8::EpiO1 E{GLU, CQKV, KRR};
                const bool cfirst = ((bx >> 3) & 1) != 0;
#pragma unroll 1
                for (int st = 0; st < 2; ++st) { if ((st == 0) == cfirst) CATCHUP_F8; else pg8::gemm_phase(lds, wave, g, S, E); }
                SEAM(pb + LP_IN);
            }
            if (IN(pb + LP_MIX)) {
                PH_LOCALS; LY_LOCALS;
                odd_mix_phase(lds, wave, lane, bx, G, GLU, CQKV, KRR, CS, P.od_dw_w + (size_t)li * 31 * 512, P.od_dw_b + (size_t)li * 512, P.od_cn_g + (size_t)li * 512, P.od_cn_b + (size_t)li * 512,
                              P.od_qn_g + (size_t)li * 256, P.od_kvn_g + (size_t)li * 128, Y, CQKVN, KR);
                SEAM(pb + LP_MIX);
            }
            if (IN(pb + LP_UP)) {
                PH_LOCALS; LY_LOCALS;
                pg8::Gemm g{CQKVN, 384, nullptr, (const bf16_t*)(ws + WT_OUP) + (size_t)li * 1792 * 256, 256, 0, 256, 3, 128};
                pg8::Sched S; S.init(NT / 256, 7, G, bx, nullptr);
                pg8::EpiO3 E{Q, KN, VV, CS};
                pg8::gemm_phase(lds, wave, g, S, E);
                SEAM(pb + LP_UP);
            }
            if (IN(pb + LP_ATT)) {
                PH_LOCALS; LY_LOCALS;
                attn_phase(lds, wave, lane, bx, G, Q, KN, KR, VV, Y);
                SEAM(pb + LP_ATT);
            }
        }
        if (IN(pb + LP_OUT)) {
                PH_LOCALS; LY_LOCALS;
            pg8::Gemm g{Y, DM, nullptr, (const bf16_t*)(ws + ((ly & 1) ? WT_OOUT : WT_EOUT)) + (size_t)li * DM * DM, DM, 0, DM};
            pg8::Sched S; S.init(NT / 256, 4, G, bx, nullptr);
            if (ly == 0) { pg8::EpiOut<true> E{P.x_in, mod_l + 2 * DM, (bf16_t*)V, lds}; pg8::gemm_phase(lds, wave, g, S, E); }
            else { pg8::EpiOut<false> E{X, mod_l + 2 * DM, (bf16_t*)V, lds}; pg8::gemm_phase(lds, wave, g, S, E); }
            SEAM(pb + LP_OUT);
        }
        if (IN(pb + LP_LNR)) {
                PH_LOCALS; LY_LOCALS;
            lnr_phase(lds, wave, lane, bx, G, (const bf16_t*)V, P.ln_mix_g + (size_t)ly * DM, P.ln_mix_b + (size_t)ly * DM, mod_l, (float*)(ws + WS_STAT), ws + WS_U8, P.r_w + (size_t)ly * DM * NEXP, P.r_b + (size_t)ly * NEXP, TOPE, TOPG, POS, CNT);
            SEAM(pb + LP_LNR);
        }
        if (IN(pb + LP_SCAT)) {
                PH_LOCALS; LY_LOCALS;
            LAS unsigned char* l2 = lds; asm volatile("" : "+v"(l2));
            volatile LAS unsigned* offs = (volatile LAS unsigned*)(l2 + MISC_OFF) + 64;
            if (tid < NEXP) offs[48 + tid] = CNT[tid];
            __syncthreads();
            if (tid <= NEXP) { unsigned o = 0; for (int e = 0; e < NEXP; ++e) { const unsigned c = offs[48 + e]; if (e < tid) o += (c + 255u) & ~255u; } offs[tid] = o; }
            __syncthreads();
            if (bx == 0 && tid <= NEXP) OFFS[tid] = offs[tid];
            for (size_t a = gtid; a < (size_t)NASSIGN; a += GT) { const int e = TOPE[a]; const int slot = (int)offs[e] + POS[a]; SLOT[a] = slot; ROWTOK[slot] = (int)(a >> 2); }
            for (int e = 0; e < NEXP; ++e) for (size_t s = offs[e] + offs[48 + e] + gtid; s < offs[e + 1]; s += GT) ROWTOK[s] = 0;
            __syncthreads();
            SEAM(pb + LP_SCAT);
        }
        if (IN(pb + LP_M1)) {
                PH_LOCALS; LY_LOCALS;
            const int nM = __builtin_amdgcn_readfirstlane((int)(OFFS[NEXP] >> 8));
            LAS int* tile_e = (LAS int*)(lds + MISC_OFF + 1024);
            for (int pm = tid; pm < nM; pm += NTHR) { const unsigned rowb = (unsigned)pm * 256u; int e = 0;
                for (int j = 1; j < NEXP; ++j) e += (rowb >= OFFS[j]) ? 1 : 0;
                tile_e[pm] = e; }
            __syncthreads();
            pg8::Gemm g{(const bf16_t*)(ws + WS_U8), DM / 2, ROWTOK, (const bf16_t*)(ws + WT_GU) + (size_t)ly * NEXP * 2048 * (DM / 2), DM / 2, (size_t)2048 * (DM / 2), DM / 2};
            const SparePlan sp = spare_plan(nM, G);
            if (bx < sp.g1) {
                pg8::Sched S; S.init(nM, 8, sp.g1, bx, tile_e);
                pg8::EpiM1 E{P.b_gu + (size_t)ly * NEXP * 2048, (unsigned char*)H, lds};
                pg8::gemm_phase<pg8::EpiM1, 127 - W8_GU_SH>(lds, wave, g, S, E);
            } else if (ly + 1 < DEPTH) { const int k = bx - sp.g1; f8_convert_range(P, ws, (LAS float*)(lds + wave * F8_SCR), lane, wave, ly + 1, k * sp.q1, (k + 1) * sp.q1); }
            SEAM(pb + LP_M1);
        }
        if (IN(pb + LP_M2)) {
                PH_LOCALS; LY_LOCALS;
            const int nM = __builtin_amdgcn_readfirstlane((int)(OFFS[NEXP] >> 8));
            LAS int* tile_e = (LAS int*)(lds + MISC_OFF + 1024);
            for (int pm = tid; pm < nM; pm += NTHR) { const unsigned rowb = (unsigned)pm * 256u; int e = 0;
                for (int j = 1; j < NEXP; ++j) e += (rowb >= OFFS[j]) ? 1 : 0;
                tile_e[pm] = e; }
            __syncthreads();
            pg8::Gemm g{H, DM / 2, nullptr, (const bf16_t*)(ws + WT_DN) + (size_t)ly * NEXP * DM * (DM / 2), DM / 2, (size_t)DM * (DM / 2), DM / 2};
            const SparePlan sp = spare_plan(nM, G);
            if (bx < sp.g2) {
                pg8::Sched S; S.init(nM, 4, sp.g2, bx, tile_e);
                pg8::EpiM2 E{P.b_dn + (size_t)ly * NEXP * DM, YS, lds};
                pg8::gemm_phase<pg8::EpiM2, 127 - W8_DN_SH>(lds, wave, g, S, E);
            } else if (ly + 1 < DEPTH) { const int k = bx - sp.g2, first = (G - sp.g1) * sp.q1; f8_convert_range(P, ws, (LAS float*)(lds + wave * F8_SCR), lane, wave, ly + 1, first + k * sp.q2, first + (k + 1) * sp.q2); }
            SEAM(pb + LP_M2);
        }
        if (IN(pb + LP_LNF)) {
                PH_LOCALS; LY_LOCALS;
            const float* lng = P.ln_ffn_g + (size_t)ly * DM; const float* lnb = P.ln_ffn_b + (size_t)ly * DM;
            float* out_final = ly == DEPTH - 1 ? P.out : nullptr;
            lnf_phase(lds, wave, lane, bx, G, YS, SLOT, TOPG, lng, lnb, mod_l, mod_n, (const bf16_t*)V, (const float*)(ws + WS_STAT), P.ln_mix_g + (size_t)ly * DM, P.ln_mix_b + (size_t)ly * DM, (bf16_t*)X, U, out_final);
            SEAM(pb + LP_LNF);
        }
    }
#undef IN
#undef SEAM
#undef CATCHUP_F8
}

extern "C" void kernel_launch(void* const* d_in, const int* in_sizes, int n_in, void* d_out, int out_size, void* d_ws, size_t ws_size, hipStream_t stream) {
    if (n_in != 32 || in_sizes[0] != NT * DM || out_size != NT * DM || ws_size < WS_END) { fprintf(stderr, "kernel_launch: built for 32 inputs, x / out of %d floats and >= %zu bytes of workspace; got n_in %d, out %d, ws %zu; nothing launched\n", NT * DM, (size_t)WS_END, n_in, out_size, ws_size); return; }
    static int grid = 0;
    if (grid == 0) {
        int dev = 0, cus = 0;
        if (hipGetDevice(&dev) != hipSuccess || hipDeviceGetAttribute(&cus, hipDeviceAttributeMultiprocessorCount, dev) != hipSuccess) { fprintf(stderr, "kernel_launch: device query failed; nothing launched\n"); grid = -1; return; }
        if (hipFuncSetAttribute((const void*)mega, hipFuncAttributeMaxDynamicSharedMemorySize, LDS_BYTES) != hipSuccess) { fprintf(stderr, "kernel_launch: hipFuncSetAttribute(%d B of dynamic LDS) failed; nothing launched\n", LDS_BYTES); grid = -1; return; }
        int per_cu = 0;
        if (hipOccupancyMaxActiveBlocksPerMultiprocessor(&per_cu, (const void*)mega, NTHR, LDS_BYTES) != hipSuccess || per_cu < 1) { fprintf(stderr, "kernel_launch: the occupancy query reports %d workgroups per CU; nothing launched\n", per_cu); (void)hipGetLastError(); grid = -1; return; }
        (void)hipGetLastError();
        grid = cus;
    }
    if (grid < 0) return;
    (void)hipMemsetAsync((unsigned char*)d_ws + WS_CTL, 0, 1 * MiB, stream);
    Params P{};
    P.x_in = (const float*)d_in[0]; P.c_in = (const float*)d_in[1]; P.pos_in = (const int*)d_in[2]; P.ada_w = (const float*)d_in[3]; P.ada_b = (const float*)d_in[4];
    P.ln_mix_g = (const float*)d_in[5]; P.ln_mix_b = (const float*)d_in[6]; P.ln_ffn_g = (const float*)d_in[7]; P.ln_ffn_b = (const float*)d_in[8];
    P.ev_w_in = (const float*)d_in[9]; P.ev_conv_w = (const float*)d_in[10]; P.ev_sg_w = (const float*)d_in[11]; P.ev_sg_b = (const float*)d_in[12]; P.ev_vn_g = (const float*)d_in[13]; P.ev_vn_b = (const float*)d_in[14]; P.ev_w_out = (const float*)d_in[15];
    P.od_w_in = (const float*)d_in[16]; P.od_dw_w = (const float*)d_in[17]; P.od_dw_b = (const float*)d_in[18]; P.od_cn_g = (const float*)d_in[19]; P.od_cn_b = (const float*)d_in[20]; P.od_qn_g = (const float*)d_in[21];
    P.od_w_uq = (const float*)d_in[22]; P.od_kvn_g = (const float*)d_in[23]; P.od_w_ukv = (const float*)d_in[24]; P.od_w_out = (const float*)d_in[25];
    P.r_w = (const float*)d_in[26]; P.r_b = (const float*)d_in[27]; P.w_gu = (const float*)d_in[28]; P.b_gu = (const float*)d_in[29]; P.w_dn = (const float*)d_in[30]; P.b_dn = (const float*)d_in[31];
    P.out = (float*)d_out; P.ws = (unsigned char*)d_ws; P.ph_lo = 0; P.ph_hi = PH_END;
    hipLaunchKernelGGL(mega, dim3(grid), dim3(NTHR), LDS_BYTES, stream, P);
}
```

```cpp
#include <hip/hip_runtime.h>
#include <cstdio>
#include <cstdint>

constexpr int NB = 8, SEQ = 4096, DM = 1024, NT = NB * SEQ, DEPTH = 4;
constexpr int NEXP = 32, TOPK = 4, NASSIGN = NT * TOPK;
constexpr int NSLOT = NASSIGN + NEXP * 256;
constexpr float ALPHA = 1.681792830507429f;
constexpr float LN_EPS = 1e-5f, RMS_EPS = 1e-6f;
constexpr float QSCALE = 0.1472444460259031f;

typedef unsigned short bf16_t;
__device__ __forceinline__ float bf2f(bf16_t v) { return __uint_as_float(((unsigned)v) << 16); }
__device__ __forceinline__ bf16_t f2bf(float f) { unsigned u = __float_as_uint(f); u += 0x7fffu + ((u >> 16) & 1u); return (bf16_t)(u >> 16); }
__device__ __forceinline__ float wave_sum(float v) {
#pragma unroll
    for (int o = 1; o < 64; o <<= 1) v += __shfl_xor(v, o);
    return v;
}
__device__ __forceinline__ float gelu_erf(float x) { return 0.5f * x * (1.0f + erff(x * 0.70710678118654752f)); }
__device__ __forceinline__ float sigmoidf_(float x) { return 1.0f / (1.0f + __expf(-x)); }

constexpr size_t MiB = 1ull << 20;
constexpr size_t WS_CTL = 0;
constexpr size_t WS_MOD = 1 * MiB;
constexpr size_t WS_CS = 2 * MiB;
constexpr size_t WS_X = 8 * MiB;
constexpr size_t WS_V = 136 * MiB;
constexpr size_t WS_U = 264 * MiB;
constexpr size_t WS_Y = 328 * MiB;
constexpr size_t WS_BG = 392 * MiB;
constexpr size_t WS_CX = 424 * MiB;
constexpr size_t WS_GZU = 456 * MiB;
constexpr size_t WS_GZV = 488 * MiB;
constexpr size_t WS_GLU = 520 * MiB;
constexpr size_t WS_CQKV = 552 * MiB;
constexpr size_t WS_CQKVN = 584 * MiB;
constexpr size_t WS_KRR = 616 * MiB;
constexpr size_t WS_KR = 620 * MiB;
constexpr size_t WS_Q = 624 * MiB;
constexpr size_t WS_KN = 672 * MiB;
constexpr size_t WS_VV = 704 * MiB;
constexpr size_t WS_TOPE = 736 * MiB;
constexpr size_t WS_TOPG = 737 * MiB;
constexpr size_t WS_POS = 738 * MiB;
constexpr size_t WS_SLOT = 739 * MiB;
constexpr size_t WS_ROWTOK = 740 * MiB;
constexpr size_t WS_STAT = 741 * MiB;
constexpr size_t WS_H = 744 * MiB;
constexpr size_t WS_YS = 1016 * MiB;
constexpr size_t WS_WT = 1288 * MiB;
constexpr size_t WS_U8 = 3176 * MiB;
constexpr size_t WS_LIST = 3208 * MiB;
constexpr size_t WS_END = 3213 * MiB;
constexpr int CW_CNT = 1024;
constexpr int CW_OFFS = 2048;

__device__ __constant__ double INVF[16] = {1.0, 0.5623413251903491, 0.31622776601683794, 0.1778279410038923, 0.1, 0.05623413251903491, 0.03162277660168379, 0.01778279410038923,
                                            0.01, 0.005623413251903491, 0.0031622776601683794, 0.0017782794100389228, 0.001, 0.0005623413251903491, 0.00031622776601683794, 0.00017782794100389227};

__device__ __forceinline__ void sincos_d(double a, float& c, float& s) {
    const double TWO_PI = 6.283185307179586476925286766559;
    double r = a - rint(a / TWO_PI) * TWO_PI;
    r *= 0.25;
    const double r2 = r * r;
    double sn = r * (1.0 + r2 * (-1.0 / 6 + r2 * (1.0 / 120 + r2 * (-1.0 / 5040 + r2 * (1.0 / 362880 + r2 * (-1.0 / 39916800 + r2 * (1.0 / 6227020800.0 + r2 * (-1.0 / 1307674368000.0))))))));
    double cs = 1.0 + r2 * (-0.5 + r2 * (1.0 / 24 + r2 * (-1.0 / 720 + r2 * (1.0 / 40320 + r2 * (-1.0 / 3628800 + r2 * (1.0 / 479001600.0 + r2 * (-1.0 / 87178291200.0 + r2 * (1.0 / 20922789888000.0))))))));
#pragma unroll
    for (int i = 0; i < 2; ++i) { const double s2 = 2.0 * sn * cs, c2 = 1.0 - 2.0 * sn * sn; sn = s2; cs = c2; }
    c = (float)cs; s = (float)sn;
}
#define LAS __attribute__((address_space(3)))
typedef short bf16x8 __attribute__((ext_vector_type(8)));
typedef float f32x4 __attribute__((ext_vector_type(4)));
typedef unsigned u32x4 __attribute__((ext_vector_type(4)));
constexpr int NWAVES = 8, NTHR = 512;
constexpr int RING_BYTES = 131072;
constexpr int MISC_OFF = 139264;
constexpr int MISC_OFF_OLD_UNUSED = RING_BYTES;
constexpr int LDS_BYTES = 147456;
constexpr size_t WT_GU = WS_WT, WT_DN = WS_WT + 512 * MiB, WT_EIN = WS_WT + 768 * MiB, WT_EOUT = WS_WT + 778 * MiB, WT_OIN = WS_WT + 782 * MiB, WT_OUP = WS_WT + 788 * MiB, WT_OOUT = WS_WT + 791 * MiB, WT_SGW = WS_WT + 795 * MiB;
constexpr int BIASSLOT_OFF = MISC_OFF + 5120;
constexpr int ROWSLOT_OFF = MISC_OFF + 4096;
constexpr int CW_BAR = 4096;

__device__ __forceinline__ int lane_id_asm() { int l; asm volatile("v_mbcnt_lo_u32_b32 %0, -1, 0\n\tv_mbcnt_hi_u32_b32 %0, -1, %0" : "=v"(l)); return l; }
__device__ __forceinline__ float shfl_xor_l(float v, int o, int lane) { return __int_as_float(__builtin_amdgcn_ds_bpermute((lane ^ o) << 2, __float_as_int(v))); }
__device__ __forceinline__ float wave_sum_l(float v, int lane) {
#pragma unroll
    for (int o = 1; o < 64; o <<= 1) v += shfl_xor_l(v, o, lane);
    return v;
}
template <int N> __device__ __forceinline__ void wave_sum_n(float (&v)[N], int lane) {
#pragma unroll
    for (int o = 1; o < 64; o <<= 1) { float t[N];
#pragma unroll
        for (int i = 0; i < N; ++i) t[i] = shfl_xor_l(v[i], o, lane);
#pragma unroll
        for (int i = 0; i < N; ++i) v[i] += t[i]; }
}
#define XB_TMO      128
#define XB_XCNT(j)  (256  + 64 * (j))
#define XB_XSUB(j)  (1280 + 64 * (j))
#define XB_XGEN(j)  (2304 + 64 * (j))
#define XB_TOP      3328
#define XB_TOPGEN   3392
#define XCD_BAR_WORDS 3456
#define XB_SPIN_CAP (1u << 18)
__device__ __forceinline__ unsigned xb_ld(unsigned* p)              { return __hip_atomic_load(p, __ATOMIC_RELAXED, __HIP_MEMORY_SCOPE_AGENT); }
__device__ __forceinline__ unsigned xb_add(unsigned* p, unsigned v) { return __hip_atomic_fetch_add(p, v, __ATOMIC_RELAXED, __HIP_MEMORY_SCOPE_AGENT); }
__device__ __forceinline__ unsigned xb_xcc_id() { return (unsigned)__builtin_amdgcn_s_getreg((3 << 11) | 20) & 0xFu; }
#define XB_SPIN(cond, bar) do { unsigned _sp = 0; while (cond) { __builtin_amdgcn_s_sleep(1); \
    if ((++_sp & 255u) == 0u) { if (xb_ld(&(bar)[XB_TMO])) break; if (_sp > XB_SPIN_CAP) { atomicAdd(&(bar)[XB_TMO], 1u); break; } } } } while (0)
struct XcdBarrier { unsigned* bar; unsigned x; volatile LAS unsigned* st; int wave; };
__device__ __forceinline__ XcdBarrier xcd_barrier_post(unsigned* bar, volatile LAS unsigned* st, int wave) {
    XcdBarrier b; b.bar = bar; b.x = xb_xcc_id(); b.st = st; b.wave = wave;
    if (threadIdx.x == 0) (void)xb_add(&bar[XB_XCNT(b.x)], 1u);
    return b;
}
__device__ __forceinline__ void xcd_barrier_complete(unsigned* bar, unsigned x, unsigned& nloc, unsigned& nx) {
    const unsigned G = gridDim.x * gridDim.y * gridDim.z;
    unsigned sum, cnt, mine, sp = 0u;
    for (;;) {
        sum = 0u; cnt = 0u; mine = 0u;
#pragma unroll
        for (unsigned j = 0; j < 16; ++j) { const unsigned c = xb_ld(&bar[XB_XCNT(j)]); sum += c; cnt += (c > 0u) ? 1u : 0u; mine = (j == x) ? c : mine; }
        if (sum == G) break;
        __builtin_amdgcn_s_sleep(1);
        if ((++sp & 255u) == 0u) { if (xb_ld(&bar[XB_TMO])) break; if (sp > XB_SPIN_CAP) { atomicAdd(&bar[XB_TMO], 1u); break; } }
    }
    nloc = mine > 0u ? mine : 1u; nx = cnt > 0u ? cnt : 1u;
}
__device__ __forceinline__ void xcd_barrier(const XcdBarrier& b) {
    asm volatile("s_waitcnt vmcnt(0)" ::: "memory");
    __syncthreads();
    if (b.wave == 0 && lane_id_asm() == 0) {
        unsigned* bar = b.bar; asm volatile("" : "+s"(bar));
        __builtin_amdgcn_s_waitcnt(0);
        unsigned nloc = b.st[0], nx = b.st[1];
        if (nloc == 0u) { xcd_barrier_complete(bar, b.x, nloc, nx); b.st[0] = nloc; b.st[1] = nx; }
        const unsigned old = xb_add(&bar[XB_XSUB(b.x)], 1u);
        const unsigned gen = old / nloc;
        if (old + 1u == (gen + 1u) * nloc) {
            __builtin_amdgcn_fence(__ATOMIC_RELEASE, "agent");
            asm volatile("s_waitcnt vmcnt(0)" ::: "memory");
            const unsigned og = xb_add(&bar[XB_TOP], 1u);
            const unsigned tg = og / nx;
            if (og + 1u == (tg + 1u) * nx) xb_add(&bar[XB_TOPGEN], 1u);
            else XB_SPIN(xb_ld(&bar[XB_TOPGEN]) == tg, bar);
            __builtin_amdgcn_fence(__ATOMIC_ACQUIRE, "agent");
            xb_add(&bar[XB_XGEN(b.x)], 1u);
            asm volatile("s_waitcnt vmcnt(0)" ::: "memory");
        } else {
            XB_SPIN(xb_ld(&bar[XB_XGEN(b.x)]) == gen, bar);
            __builtin_amdgcn_fence(__ATOMIC_ACQUIRE, "agent");
            asm volatile("s_waitcnt vmcnt(0)" ::: "memory");
        }
    }
    __syncthreads();
}

constexpr int W8_GU_SH = 4, W8_DN_SH = 5;
typedef int v8i_t __attribute__((ext_vector_type(8)));
typedef int u32x4i __attribute__((ext_vector_type(4)));
__device__ __forceinline__ unsigned pk4_fp8(float a, float b, float c, float d) { int w = __builtin_amdgcn_cvt_pk_fp8_f32(a, b, 0, false); w = __builtin_amdgcn_cvt_pk_fp8_f32(c, d, w, true); return (unsigned)w; }
namespace pg8 {
constexpr int BM = 256, BK = 64, HALF = 128, HTB = HALF * BK * 2, STAGE_BYTES = 8 * HTB, NXCD = 8, WGM = 8;
__device__ __forceinline__ int lds_byte(int r, int c) { const int st = (r >> 4) * 2 + (c >> 5), rr = r & 15, cc = c & 31, ob = rr * 64 + cc * 2; return st * 1024 + (ob ^ (((ob >> 9) & 1) << 5)); }
__device__ __forceinline__ void stage_rc(int b, int& R, int& C) { const int st = b / 1024, sb = b % 1024, swz = sb ^ (((sb >> 9) & 1) << 5); R = (st >> 1) * 16 + swz / 64; C = (st & 1) * 32 + (swz % 64) / 2; }
__device__ __forceinline__ int perm32(int rho) { const int n = rho >> 4, i = rho & 15; return 8 * (i >> 2) + 4 * n + (i & 3); }
struct Unit { int pm, pn, e; };
struct Gemm { const bf16_t* A; int lda; const int* rowmap; const bf16_t* Bt; int ldb; size_t strideB; int K; int asplit = 1 << 30, aoff = 0; };
struct Sched {
    int nM, nN, nwg, G, c; const LAS int* tile_e;
    __device__ __forceinline__ void init(int nM_, int nN_, int G_, int c_, const LAS int* tile_e_) { nM = nM_; nN = nN_; nwg = nM * nN; G = G_; c = c_; tile_e = tile_e_; }
    __device__ __forceinline__ bool next(int i, Unit& u) const {
        const int L = i * G + c; if (L >= nwg) return false;
        int wgid = L; { const int q = nwg / NXCD, r = nwg % NXCD, xcd = wgid % NXCD, off = wgid / NXCD; wgid = (xcd < r ? xcd * (q + 1) : r * (q + 1) + (xcd - r) * q) + off; }
        const int nig = WGM * nN, gid = wgid / nig, fm = gid * WGM, gsz = (nM - fm) < WGM ? (nM - fm) : WGM;
        u.pm = fm + ((wgid % nig) % gsz); u.pn = (wgid % nig) / gsz; u.e = 0;
        if (tile_e) u.e = __builtin_amdgcn_readfirstlane(tile_e[u.pm]);
        return true;
    }
};
__device__ __forceinline__ unsigned cvt_pk_bf16(float lo, float hi) { unsigned r; asm volatile("v_cvt_pk_bf16_f32 %0, %1, %2" : "=v"(r) : "v"(lo), "v"(hi)); return r; }
__device__ __forceinline__ u32x4 pack8(const f32x4 a, const f32x4 b) { u32x4 w; w.x = cvt_pk_bf16(a[0], a[1]); w.y = cvt_pk_bf16(a[2], a[3]); w.z = cvt_pk_bf16(b[0], b[1]); w.w = cvt_pk_bf16(b[2], b[3]); return w; }
typedef float f32x2 __attribute__((ext_vector_type(2)));
typedef unsigned u32x2 __attribute__((ext_vector_type(2)));
__device__ __forceinline__ f32x2 gelu_pk(f32x2 v) {
    const f32x2 av = __builtin_elementwise_abs(v), d = av * 0.2316418882f + 1.0f;
    const float rp = __builtin_amdgcn_rcpf(d.x * d.y);
    f32x2 t; t.x = rp * d.y; t.y = rp * d.x;
    f32x2 q = t * 0.5307027145f + (-0.7265760135f); q = q * t + 0.7107068705f; q = q * t + (-0.142248368f); q = q * t + 0.127414796f; q = q * t;
    const f32x2 s = (v * v) * (-0.72134752044f);
    f32x2 e; e.x = __builtin_amdgcn_exp2f(s.x); e.y = __builtin_amdgcn_exp2f(s.y);
    const f32x2 m = v * (q * e), r = v - m;
    f32x2 o; o.x = v.x < 0.f ? m.x : r.x; o.y = v.y < 0.f ? m.y : r.y; return o;
}
__device__ __forceinline__ f32x4 gelu4(const f32x4 v) { const f32x2 a = gelu_pk((f32x2){v[0], v[1]}), b = gelu_pk((f32x2){v[2], v[3]}); return (f32x4){a.x, a.y, b.x, b.y}; }
__device__ __forceinline__ float fsig(float x) { return __builtin_amdgcn_rcpf(1.0f + __builtin_amdgcn_exp2f(-1.4426950408889634f * x)); }

#define EPI_ROWS for (int ai = 0; ai < 2; ++ai) _Pragma("unroll") for (int m = 0; m < 4; ++m)

struct EpiE1 {
    static constexpr bool LDS_BIAS = false; static constexpr bool ACC_BIAS = false;
    bf16_t *BG, *CX, *GZU, *GZV;
    __device__ __forceinline__ void operator()(const f32x4 (&acc)[2][2][4][2], const Unit& u, int wr, int wc, int fr, int fq) const {
        const int row0 = u.pm * BM + wr * 64 + fr, cl = wc * 32 + 8 * fq, t = u.pn;
        if (t < 2) {
#pragma unroll
            EPI_ROWS { bf16_t* rp = BG + (size_t)(row0 + ai * HALF + m * 16) * 512 + t * 256 + cl;
#pragma unroll
                for (int bj = 0; bj < 2; ++bj) *(u32x4*)(rp + bj * HALF) = pack8(acc[ai][bj][m][0], acc[ai][bj][m][1]); }
        } else if (t < 6) {
#pragma unroll
            EPI_ROWS { bf16_t* rp = CX + (size_t)(row0 + ai * HALF + m * 16) * 512 + (t - 2) * 128 + cl;
                *(u32x4*)rp = pack8(acc[ai][0][m][0] * acc[ai][1][m][0], acc[ai][0][m][1] * acc[ai][1][m][1]); }
        } else {
            bf16_t* O = t < 8 ? GZU : GZV; const int tc = (t & 1) * 256 + cl;
#pragma unroll
            EPI_ROWS { bf16_t* rp = O + (size_t)(row0 + ai * HALF + m * 16) * 512 + tc;
#pragma unroll
                for (int bj = 0; bj < 2; ++bj) *(u32x4*)(rp + bj * HALF) = pack8(gelu4(acc[ai][bj][m][0]), gelu4(acc[ai][bj][m][1])); }
        }
    }
};
struct EpiO1 {
    static constexpr bool LDS_BIAS = false; static constexpr bool ACC_BIAS = false;
    bf16_t *GLU, *CQKV, *KRR;
    __device__ __forceinline__ void operator()(const f32x4 (&acc)[2][2][4][2], const Unit& u, int wr, int wc, int fr, int fq) const {
        const int row0 = u.pm * BM + wr * 64 + fr, cl = wc * 32 + 8 * fq, t = u.pn;
        if (t < 4) {
#pragma unroll
            EPI_ROWS { bf16_t* rp = GLU + (size_t)(row0 + ai * HALF + m * 16) * 512 + t * 128 + cl; f32x4 o[2];
#pragma unroll
                for (int n = 0; n < 2; ++n) {
                    const f32x4 ga = acc[ai][0][m][n], tb = acc[ai][1][m][n] * (-1.4426950408889634f);
                    f32x4 e; e[0] = __builtin_amdgcn_exp2f(tb[0]); e[1] = __builtin_amdgcn_exp2f(tb[1]); e[2] = __builtin_amdgcn_exp2f(tb[2]); e[3] = __builtin_amdgcn_exp2f(tb[3]);
                    const f32x4 d = e + 1.0f;
                    f32x4 r; r[0] = __builtin_amdgcn_rcpf(d[0]); r[1] = __builtin_amdgcn_rcpf(d[1]); r[2] = __builtin_amdgcn_rcpf(d[2]); r[3] = __builtin_amdgcn_rcpf(d[3]);
                    o[n] = ga * r; }
                *(u32x4*)rp = pack8(o[0], o[1]); }
        } else if (t == 4) {
#pragma unroll
            EPI_ROWS { bf16_t* rp = CQKV + (size_t)(row0 + ai * HALF + m * 16) * 384 + cl;
#pragma unroll
                for (int bj = 0; bj < 2; ++bj) *(u32x4*)(rp + bj * HALF) = pack8(acc[ai][bj][m][0], acc[ai][bj][m][1]); }
        } else {
#pragma unroll
            EPI_ROWS { const size_t r = (size_t)(row0 + ai * HALF + m * 16);
                *(u32x4*)(CQKV + r * 384 + 256 + cl) = pack8(acc[ai][0][m][0], acc[ai][0][m][1]);
                if (wc == 0) *(u32x4*)(KRR + r * 32 + 8 * fq) = pack8(acc[ai][1][m][0], acc[ai][1][m][1]); }
        }
    }
};
struct EpiO3 {
    static constexpr bool LDS_BIAS = false; static constexpr bool ACC_BIAS = false;
    bf16_t *Q, *KN, *VV; const float* CS;
    __device__ __forceinline__ void operator()(const f32x4 (&acc)[2][2][4][2], const Unit& u, int wr, int wc, int fr, int fq) const {
        const int row0 = u.pm * BM + wr * 64 + fr, cl = wc * 32 + 8 * fq, t = u.pn;
        if (t < 3) {
#pragma unroll
            for (int bj = 0; bj < 2; ++bj) { const int c0 = t * 256 + bj * HALF + cl, h = c0 / 96, d0 = c0 - 96 * h;
                if (d0 < 64) {
#pragma unroll
                    EPI_ROWS *(u32x4*)(Q + (size_t)(row0 + ai * HALF + m * 16) * 768 + c0) = pack8(acc[ai][bj][m][0] * QSCALE, acc[ai][bj][m][1] * QSCALE);
                } else { const int i0 = (d0 - 64) >> 1;
#pragma unroll
                    for (int ai = 0; ai < 2; ++ai) {
                    f32x4 csv[4], snv[4];
#pragma unroll
                    for (int m = 0; m < 4; ++m) { const size_t r = (size_t)(row0 + ai * HALF + m * 16); csv[m] = *(const f32x4*)(CS + r * 32 + i0); snv[m] = *(const f32x4*)(CS + r * 32 + 16 + i0); }
#pragma unroll
                    for (int m = 0; m < 4; ++m) { const size_t r = (size_t)(row0 + ai * HALF + m * 16); const f32x4 cs = csv[m], sn = snv[m];
                        const f32x4 a = acc[ai][bj][m][0], b = acc[ai][bj][m][1]; f32x4 o0, o1;
                        o0[0] = (a[0] * cs[0] - a[1] * sn[0]) * QSCALE; o0[1] = (a[1] * cs[0] + a[0] * sn[0]) * QSCALE; o0[2] = (a[2] * cs[1] - a[3] * sn[1]) * QSCALE; o0[3] = (a[3] * cs[1] + a[2] * sn[1]) * QSCALE;
                        o1[0] = (b[0] * cs[2] - b[1] * sn[2]) * QSCALE; o1[1] = (b[1] * cs[2] + b[0] * sn[2]) * QSCALE; o1[2] = (b[2] * cs[3] - b[3] * sn[3]) * QSCALE; o1[3] = (b[3] * cs[3] + b[2] * sn[3]) * QSCALE;
                        *(u32x4*)(Q + r * 768 + c0) = pack8(o0, o1); } }
                } }
        } else {
            bf16_t* O = t < 5 ? KN : VV; const int tc = ((t - 3) & 1) * 256 + cl;
#pragma unroll
            EPI_ROWS { bf16_t* rp = O + (size_t)(row0 + ai * HALF + m * 16) * 512 + tc;
#pragma unroll
                for (int bj = 0; bj < 2; ++bj) *(u32x4*)(rp + bj * HALF) = pack8(acc[ai][bj][m][0], acc[ai][bj][m][1]); }
        }
    }
};
template <bool XF32> struct EpiOut {
    static constexpr bool LDS_BIAS = true;
    static constexpr bool ACC_BIAS = false;
    const void* xres; const float* gate; bf16_t* V; LAS unsigned char* lds;
    __device__ __forceinline__ const float* bias_src(const Unit& u, int lane) const { return gate + (size_t)((u.pm * BM) / SEQ) * 6 * DM + u.pn * BM + lane * 4; }
    __device__ __forceinline__ void operator()(const f32x4 (&acc)[2][2][4][2], const Unit& u, int wr, int wc, int fr, int fq) const {
        const int row0 = u.pm * BM + wr * 64 + fr, b = (u.pm * BM) / SEQ;
        f32x4 g[2][2];
#pragma unroll
        for (int bj = 0; bj < 2; ++bj)
#pragma unroll
            for (int n = 0; n < 2; ++n) g[bj][n] = *(const LAS f32x4*)((const LAS float*)(lds + BIASSLOT_OFF) + bj * HALF + wc * 32 + 8 * fq + 4 * n) + 1.0f;
        const size_t cb = (size_t)u.pn * BM + wc * 32 + 8 * fq;
        if constexpr (!XF32) {
#pragma unroll
            for (int ai = 0; ai < 2; ++ai) {
                u32x4 xb[4][2];
#pragma unroll
                for (int m = 0; m < 4; ++m)
#pragma unroll
                    for (int bj = 0; bj < 2; ++bj) xb[m][bj] = *(const u32x4*)((const bf16_t*)xres + (size_t)(row0 + ai * HALF + m * 16) * DM + cb + bj * HALF);
#pragma unroll
                for (int m = 0; m < 4; ++m)
#pragma unroll
                    for (int bj = 0; bj < 2; ++bj) { const u32x4 t = xb[m][bj];
                        const f32x4 x0 = (f32x4){__uint_as_float(t.x << 16), __uint_as_float(t.x & 0xffff0000u), __uint_as_float(t.y << 16), __uint_as_float(t.y & 0xffff0000u)};
                        const f32x4 x1 = (f32x4){__uint_as_float(t.z << 16), __uint_as_float(t.z & 0xffff0000u), __uint_as_float(t.w << 16), __uint_as_float(t.w & 0xffff0000u)};
                        *(u32x4*)(V + (size_t)(row0 + ai * HALF + m * 16) * DM + cb + bj * HALF) = pack8(x0 * ALPHA + g[bj][0] * acc[ai][bj][m][0], x1 * ALPHA + g[bj][1] * acc[ai][bj][m][1]); }
            }
        } else {
#pragma unroll
            for (int ai = 0; ai < 2; ++ai)
#pragma unroll
                for (int mh = 0; mh < 2; ++mh) {
                    f32x4 xf[2][2][2];
#pragma unroll
                    for (int m2 = 0; m2 < 2; ++m2)
#pragma unroll
                        for (int bj = 0; bj < 2; ++bj) { const float* xp = (const float*)xres + (size_t)(row0 + ai * HALF + (2 * mh + m2) * 16) * DM + cb + bj * HALF; xf[m2][bj][0] = *(const f32x4*)xp; xf[m2][bj][1] = *(const f32x4*)(xp + 4); }
#pragma unroll
                    for (int m2 = 0; m2 < 2; ++m2)
#pragma unroll
                        for (int bj = 0; bj < 2; ++bj) { const int m = 2 * mh + m2;
                            *(u32x4*)(V + (size_t)(row0 + ai * HALF + m * 16) * DM + cb + bj * HALF) = pack8(xf[m2][bj][0] * ALPHA + g[bj][0] * acc[ai][bj][m][0], xf[m2][bj][1] * ALPHA + g[bj][1] * acc[ai][bj][m][1]); }
                }
        }
    }
};
struct EpiM1 {
    const float* bgu; unsigned char* H; LAS unsigned char* lds;
    static constexpr bool LDS_BIAS = false; static constexpr bool ACC_BIAS = true;
    __device__ __forceinline__ void acc_init(f32x4 (&acc)[2][2][4][2], const LAS float* slot, int wc, int fq) const {
        const LAS float* bp = slot + wc * 32 + 8 * fq;
#pragma unroll
        for (int n = 0; n < 2; ++n) { const f32x4 bg = *(const LAS f32x4*)(bp + 4 * n), bu = *(const LAS f32x4*)(bp + 128 + 4 * n) + 1.0f;
#pragma unroll
            for (int ai = 0; ai < 2; ++ai)
#pragma unroll
                for (int m = 0; m < 4; ++m) { acc[ai][0][m][n] = bg; acc[ai][1][m][n] = bu; } }
    }
    __device__ __forceinline__ const float* bias_src(const Unit& u, int lane) const { return bgu + (size_t)u.e * 2048 + (lane >> 5) * 1024 + u.pn * 128 + (lane & 31) * 4; }
    static __device__ __forceinline__ f32x2 act2(f32x2 g, f32x2 u) {
        f32x2 gg, uu; gg.x = __builtin_amdgcn_fmed3f(g.x, -24.0f, 7.0f); gg.y = __builtin_amdgcn_fmed3f(g.y, -24.0f, 7.0f); uu.x = __builtin_amdgcn_fmed3f(u.x, -6.0f, 8.0f); uu.y = __builtin_amdgcn_fmed3f(u.y, -6.0f, 8.0f);
        const f32x2 t = gg * (-1.702f * 1.4426950408889634f);
        f32x2 e; e.x = __builtin_amdgcn_exp2f(t.x); e.y = __builtin_amdgcn_exp2f(t.y);
        const f32x2 d = e + 1.0f;
        const float rp = __builtin_amdgcn_rcpf(d.x * d.y);
        f32x2 r; r.x = rp * d.y; r.y = rp * d.x;
        return (uu * gg) * r;
    }
    __device__ __forceinline__ void operator()(const f32x4 (&acc)[2][2][4][2], const Unit& u, int wr, int wc, int fr, int fq) const {
        const int row0 = u.pm * BM + wr * 64 + fr, col = u.pn * 128 + wc * 32 + 8 * fq;
#pragma unroll
        EPI_ROWS { f32x2 o[2][2];
#pragma unroll
            for (int n = 0; n < 2; ++n) { const f32x4 gv = acc[ai][0][m][n], uv = acc[ai][1][m][n];
                o[n][0] = act2((f32x2){gv[0], gv[1]}, (f32x2){uv[0], uv[1]}); o[n][1] = act2((f32x2){gv[2], gv[3]}, (f32x2){uv[2], uv[3]}); }
            u32x2 w; w.x = pk4_fp8(o[0][0].x, o[0][0].y, o[0][1].x, o[0][1].y); w.y = pk4_fp8(o[1][0].x, o[1][0].y, o[1][1].x, o[1][1].y);
            *(u32x2*)(H + (size_t)(row0 + ai * HALF + m * 16) * DM + col) = w; }
    }
};
struct EpiM2 {
    const float* bdn; unsigned char* YS; LAS unsigned char* lds;
    static constexpr bool LDS_BIAS = false; static constexpr bool ACC_BIAS = true;
    __device__ __forceinline__ void acc_init(f32x4 (&acc)[2][2][4][2], const LAS float* slot, int wc, int fq) const {
#pragma unroll
        for (int bj = 0; bj < 2; ++bj)
#pragma unroll
            for (int n = 0; n < 2; ++n) { const f32x4 b = *(const LAS f32x4*)(slot + wc * 32 + 8 * fq + bj * HALF + 4 * n) * 16.0f;
#pragma unroll
                for (int ai = 0; ai < 2; ++ai)
#pragma unroll
                    for (int m = 0; m < 4; ++m) acc[ai][bj][m][n] = b; }
    }
    __device__ __forceinline__ const float* bias_src(const Unit& u, int lane) const { return bdn + (size_t)u.e * DM + u.pn * BM + lane * 4; }
    __device__ __forceinline__ void operator()(const f32x4 (&acc)[2][2][4][2], const Unit& u, int wr, int wc, int fr, int fq) const {
        const int row0 = u.pm * BM + wr * 64 + fr, col = u.pn * BM + wc * 32 + 8 * fq;
#pragma unroll
        EPI_ROWS { unsigned char* rp = YS + (size_t)(row0 + ai * HALF + m * 16) * DM + col;
#pragma unroll
            for (int bj = 0; bj < 2; ++bj) { const f32x4 a = acc[ai][bj][m][0], b = acc[ai][bj][m][1];
                u32x2 w; w.x = pk4_fp8(a[0], a[1], a[2], a[3]); w.y = pk4_fp8(b[0], b[1], b[2], b[3]); *(u32x2*)(rp + bj * HALF) = w; } }
    }
};

template <class Epi, int F8SCALE = -1>
__device__ __forceinline__ void gemm_phase(LAS unsigned char* lds, const int wave_id, const Gemm g, const Sched& S, const Epi& E) {
    const int lane = lane_id_asm();
    const int wid = wave_id, wr = wid >> 2, wc = wid & 3, fr = lane & 15, fq = lane >> 4;
    const int K = g.K, nt = K / BK;
    const int swz = (lane * 16) ^ ((((lane * 16) >> 9) & 1) << 5);
#define PG8_STR(i) ((((wid + 8 * (i)) >> 1) * 16) + (swz >> 6))
#define PG8_STC ((wid & 1) * 32 + ((swz & 63) >> 1))
    unsigned voffB[2];
#pragma unroll
    for (int i = 0; i < 2; ++i) { const int R = PG8_STR(i), Rb = (R & ~31) + perm32(R & 31); voffB[i] = (unsigned)(Rb * g.ldb + PG8_STC) * 2u; }
    const size_t kstep = (size_t)(BK * 2);
    const size_t hstepB = (size_t)HALF * g.ldb * 2;
    const unsigned ldsw = (unsigned)wid * 1024u;
    const int aoff = lds_byte(wr * 64 + fr, fq * 8), boff = lds_byte(wc * 32 + fr, fq * 8);
    const char* const abase = (const char*)g.A;
#define PG8_SA(b, h) (((b) * 2 + (h)) * HTB)
#define PG8_SB(b, h) ((4 + (b) * 2 + (h)) * HTB)
#define PG8_STAGEB(bufoff, gbase) do { _Pragma("unroll") for (int _i = 0; _i < 2; ++_i) \
        __builtin_amdgcn_global_load_lds((const unsigned*)((const char*)(gbase) + voffB[_i]), (LAS unsigned*)(lds + (bufoff) + ldsw + _i * 8192), 16, 0, 0); } while (0)
#define PG8_STAGEA(bufoff, koff, VO, h) do { _Pragma("unroll") for (int _i = 0; _i < 2; ++_i) \
        __builtin_amdgcn_global_load_lds((const unsigned*)(abase + (size_t)(koff) + (VO)[h][_i]), (LAS unsigned*)(lds + (bufoff) + ldsw + _i * 8192), 16, 0, 0); } while (0)
#define PG8_LDA(dst, b, h) do { _Pragma("unroll") for (int m = 0; m < 4; ++m) _Pragma("unroll") for (int k = 0; k < 2; ++k) dst[m][k] = *(const LAS bf16x8*)(lds + PG8_SA(b, h) + aoff + m * 2048 + k * 1024); } while (0)
#define PG8_LDB(dst, b, h) do { _Pragma("unroll") for (int n = 0; n < 2; ++n) _Pragma("unroll") for (int k = 0; k < 2; ++k) dst[n][k] = *(const LAS bf16x8*)(lds + PG8_SB(b, h) + boff + n * 2048 + k * 1024); } while (0)
#define PG8_MMA(ai, bj, At, Bt) do { __builtin_amdgcn_s_setprio(1); \
        if constexpr (F8SCALE < 0) { _Pragma("unroll") for (int m = 0; m < 4; ++m) _Pragma("unroll") for (int n = 0; n < 2; ++n) _Pragma("unroll") for (int k = 0; k < 2; ++k) \
            acc[ai][bj][m][n] = __builtin_amdgcn_mfma_f32_16x16x32_bf16(Bt[n][k], At[m][k], acc[ai][bj][m][n], 0, 0, 0); } \
        else { _Pragma("unroll") for (int m = 0; m < 4; ++m) _Pragma("unroll") for (int n = 0; n < 2; ++n) { \
            const v8i_t _b8 = __builtin_shufflevector(__builtin_bit_cast(u32x4i, Bt[n][0]), __builtin_bit_cast(u32x4i, Bt[n][1]), 0, 1, 2, 3, 4, 5, 6, 7); \
            const v8i_t _a8 = __builtin_shufflevector(__builtin_bit_cast(u32x4i, At[m][0]), __builtin_bit_cast(u32x4i, At[m][1]), 0, 1, 2, 3, 4, 5, 6, 7); \
            acc[ai][bj][m][n] = __builtin_amdgcn_mfma_scale_f32_16x16x128_f8f6f4(_b8, _a8, acc[ai][bj][m][n], 0, 0, 0, f8_sb, 0, f8_sa); } \
            _Pragma("unroll") for (int m = 0; m < 4; ++m) _Pragma("unroll") for (int n = 0; n < 2; ++n) asm volatile("" : "+v"(acc[ai][bj][m][n])); }     \
        __builtin_amdgcn_s_setprio(0); } while (0)
#define PG8_WAIT_V(n) asm volatile("s_waitcnt vmcnt(" #n ")" ::: "memory")
#define PG8_WAIT_L(n) asm volatile("s_waitcnt lgkmcnt(" #n ")" ::: "memory")
#define PG8_BAR __builtin_amdgcn_s_barrier()
#define PG8_SCHED __builtin_amdgcn_sched_barrier(0)
#define PG8_LOADROWS(U, RW) do { _Pragma("unroll") for (int _h = 0; _h < 2; ++_h) _Pragma("unroll") for (int _i = 0; _i < 2; ++_i) { const int _row = (U).pm * BM + _h * HALF + PG8_STR(_i); \
        if (g.rowmap) { const int _e = (U).e, _ob = (int)otab[_e], _lim = (int)otab[48 + _e] + _ob - (U).pm * BM, _loc = _h * HALF + PG8_STR(_i); \
            (RW)[_h][_i] = _loc < _lim ? ((const __attribute__((address_space(1))) int*)g.rowmap)[(size_t)_e * NT - _ob + _row] : 0; } else (RW)[_h][_i] = _row; } } while (0)
#define PG8_ROWS2OFF(U, RW, VO) do { const int _ao = (U).pn >= g.asplit ? g.aoff : 0; _Pragma("unroll") for (int _h = 0; _h < 2; ++_h) _Pragma("unroll") for (int _i = 0; _i < 2; ++_i) (VO)[_h][_i] = (unsigned)((RW)[_h][_i] * g.lda + _ao + PG8_STC) * 2u; } while (0)
#define PG8_CALCA(U, VO) do { int _rw[2][2]; PG8_LOADROWS(U, _rw); PG8_ROWS2OFF(U, _rw, VO); } while (0)
    const LAS unsigned* otab = (const LAS unsigned*)(lds + MISC_OFF) + 64;
    int f8_sb = (F8SCALE) * 0x01010101, f8_sa = 0x7f7f7f7f; asm volatile("" : "+v"(f8_sb), "+v"(f8_sa));
    Unit cur, nxt; int ui = 0;
    if (!S.next(0, cur)) return;
    f32x4 acc[2][2][4][2];
#pragma unroll
    for (int a = 0; a < 2; ++a)
#pragma unroll
        for (int b = 0; b < 2; ++b)
#pragma unroll
            for (int m = 0; m < 4; ++m)
#pragma unroll
                for (int n = 0; n < 2; ++n) acc[a][b][m][n] = (f32x4){0.f, 0.f, 0.f, 0.f};
    bf16x8 At[4][2], B0[2][2], B1[2][2];
    unsigned voC[2][2];
    PG8_CALCA(cur, voC);
    const char* cB = (const char*)g.Bt + ((size_t)cur.e * g.strideB + (size_t)cur.pn * BM * g.ldb) * 2;
    if constexpr (Epi::ACC_BIAS) { if (wid == 0) { const int ln = lane_id_asm(); __builtin_amdgcn_global_load_lds((const unsigned*)E.bias_src(cur, ln), (LAS unsigned*)(lds + BIASSLOT_OFF), 16, 0, 0); } }
    PG8_STAGEB(PG8_SB(0, 0), cB); PG8_STAGEB(PG8_SB(0, 1), cB + hstepB); PG8_STAGEA(PG8_SA(0, 0), 0, voC, 0); PG8_STAGEA(PG8_SA(0, 1), 0, voC, 1);
    if (wr == 1) PG8_BAR;
    PG8_WAIT_V(2); PG8_BAR;
    PG8_STAGEB(PG8_SB(1, 0), cB + kstep); PG8_STAGEA(PG8_SA(1, 0), kstep, voC, 0); PG8_STAGEB(PG8_SB(1, 1), cB + hstepB + kstep);
    PG8_WAIT_V(6); PG8_BAR;
    if constexpr (Epi::ACC_BIAS) E.acc_init(acc, (const LAS float*)(lds + BIASSLOT_OFF), wc, fq);
    for (;;) {
        const bool has_next = S.next(ui + 1, nxt);
        const char* nB = has_next ? (const char*)g.Bt + ((size_t)nxt.e * g.strideB + (size_t)nxt.pn * BM * g.ldb) * 2 : cB;
        int rwN[2][2];
#pragma unroll 1
        for (int t = 0; t < nt; t += 2) {
            const bool last = (t == nt - 2);
            const size_t k1 = (size_t)(t + 1) * kstep;
            const size_t k2 = last ? 0 : (size_t)(t + 2) * kstep, k3 = k2 + kstep;
            const char* b2 = last ? nB : cB + (size_t)(t + 2) * kstep; const char* b3 = b2 + kstep;
            if constexpr (Epi::ACC_BIAS) { if (t == 2 && wid == 0 && has_next) { const int ln = lane_id_asm(); __builtin_amdgcn_global_load_lds((const unsigned*)E.bias_src(nxt, ln), (LAS unsigned*)(lds + BIASSLOT_OFF + ((ui + 1) & 1) * 1024), 16, 0, 0); } }
            if constexpr (Epi::LDS_BIAS) { if (t == 2 && wid == 0) { const int ln = lane_id_asm(); __builtin_amdgcn_global_load_lds((const unsigned*)E.bias_src(cur, ln), (LAS unsigned*)(lds + BIASSLOT_OFF), 16, 0, 0); } }
            if (t == nt - 4 && has_next) {
                if (g.rowmap) { if (wid == 0) { const int ln = lane_id_asm(); __builtin_amdgcn_global_load_lds((const unsigned*)(g.rowmap + ((size_t)nxt.e * NT - otab[nxt.e] + (size_t)nxt.pm * BM) + ln * 4), (LAS unsigned*)(lds + ROWSLOT_OFF), 16, 0, 0); } }
                else PG8_LOADROWS(nxt, rwN);
            }
            PG8_LDB(B0, 0, 0); PG8_LDB(B1, 0, 1); PG8_SCHED; PG8_LDA(At, 0, 0); PG8_STAGEA(PG8_SA(1, 1), k1, voC, 1);
            PG8_WAIT_V(8); PG8_WAIT_L(0); PG8_BAR; PG8_MMA(0, 0, At, B0); PG8_MMA(0, 1, At, B1); PG8_BAR; PG8_SCHED;
            if (last && has_next) {
                if (g.rowmap) {
#pragma unroll
                    for (int h = 0; h < 2; ++h)
#pragma unroll
                        for (int i = 0; i < 2; ++i) { const int lim = (int)otab[48 + nxt.e] + (int)otab[nxt.e] - nxt.pm * BM, loc = h * HALF + PG8_STR(i); const int v = *(const LAS int*)(lds + ROWSLOT_OFF + 4 * loc); rwN[h][i] = loc < lim ? v : 0; }
                }
                PG8_ROWS2OFF(nxt, rwN, voC);
            }
            PG8_LDA(At, 0, 1); PG8_STAGEB(PG8_SB(0, 0), b2); PG8_STAGEB(PG8_SB(0, 1), b2 + hstepB); PG8_STAGEA(PG8_SA(0, 0), k2, voC, 0);
            PG8_WAIT_V(8); PG8_WAIT_L(0); PG8_BAR; PG8_MMA(1, 0, At, B0); PG8_MMA(1, 1, At, B1); PG8_BAR; PG8_SCHED;
            PG8_LDB(B0, 1, 0); PG8_LDB(B1, 1, 1); PG8_SCHED; PG8_LDA(At, 1, 0); PG8_STAGEA(PG8_SA(0, 1), k2, voC, 1);
            PG8_WAIT_V(8); PG8_WAIT_L(0); PG8_BAR; PG8_MMA(0, 0, At, B0); PG8_MMA(0, 1, At, B1); PG8_BAR; PG8_SCHED;
            PG8_LDA(At, 1, 1); PG8_STAGEB(PG8_SB(1, 0), b3); PG8_STAGEB(PG8_SB(1, 1), b3 + hstepB); PG8_STAGEA(PG8_SA(1, 0), k3, voC, 0);
            PG8_WAIT_V(8); PG8_WAIT_L(0); PG8_BAR; PG8_MMA(1, 0, At, B0); PG8_MMA(1, 1, At, B1); PG8_BAR; PG8_SCHED;
        }
        if (wr == 0) PG8_BAR;
        E(acc, cur, wr, wc, fr, fq);
        if (!has_next) break;
        if constexpr (Epi::ACC_BIAS) E.acc_init(acc, (const LAS float*)(lds + BIASSLOT_OFF + ((ui + 1) & 1) * 1024), wc, fq);
        else {
#pragma unroll
        for (int a = 0; a < 2; ++a)
#pragma unroll
            for (int b = 0; b < 2; ++b)
#pragma unroll
                for (int m = 0; m < 4; ++m)
#pragma unroll
                    for (int n = 0; n < 2; ++n) acc[a][b][m][n] = (f32x4){0.f, 0.f, 0.f, 0.f};
        }
        cur = nxt; cB = nB; ++ui;
        if (wr == 1) PG8_BAR;
    }
    PG8_WAIT_V(0);
    PG8_BAR;
#undef PG8_SA
#undef PG8_SB
#undef PG8_STAGEA
#undef PG8_STAGEB
#undef PG8_LDA
#undef PG8_LDB
#undef PG8_MMA
#undef PG8_WAIT_V
#undef PG8_WAIT_L
#undef PG8_BAR
#undef PG8_SCHED
#undef PG8_CALCA
#undef PG8_LOADROWS
#undef PG8_ROWS2OFF
#undef PG8_STR
#undef PG8_STC
}
}


typedef float f32x16 __attribute__((ext_vector_type(16)));
__device__ __forceinline__ float max3f_(float a, float b, float c) { float r; asm("v_max3_f32 %0, %1, %2, %3" : "=v"(r) : "v"(a), "v"(b), "v"(c)); return r; }
__device__ __forceinline__ float max2f_(float a, float b) { float r; asm("v_max_f32_e32 %0, %1, %2" : "=v"(r) : "v"(a), "v"(b)); return r; }
typedef short v4i16_t __attribute__((ext_vector_type(4)));
using pg8::u32x2;
constexpr float AT_THR = 8.0f;
constexpr int AT_KROW = 208, AT_KBYTES = 64 * AT_KROW, AT_VBYTES = 8192, AT_BUF = AT_KBYTES + AT_VBYTES;
__device__ __forceinline__ void attn_phase(LAS unsigned char* lds, const int wave, const int lane, const int bx, const int G,
                                           const bf16_t* __restrict__ Q, const bf16_t* __restrict__ KN, const bf16_t* __restrict__ KR, const bf16_t* __restrict__ VV, bf16_t* __restrict__ Y) {
    const int hi = lane >> 5, r32 = lane & 31, tid = wave * 64 + lane;
    const int g1 = (lane >> 4) & 1, i16 = lane & 15, tq = i16 >> 2, tp = i16 & 3;
    const int vlane_off = (4 * hi + tq) * 64 + (16 * g1 + 4 * tp) * 2;
    const int vbx = (G % 8 == 0) ? (bx % 8) * (G / 8) + bx / 8 : bx;
    for (int pidx = vbx; pidx < 512; pidx += G) {
#pragma unroll 1
        for (int jj = 0; jj < 2; ++jj) {
            const int bh = pidx >> 3, x = pidx & 7, qb = jj ? 15 - x : x, b = bh >> 3, h = bh & 7;
            const size_t tb = (size_t)b * SEQ;
            const int q0 = qb * 256 + wave * 32;
            const bf16_t* kn = KN + tb * 512 + h * 64; const bf16_t* kr = KR + tb * 32; const bf16_t* vv = VV + tb * 512 + h * 64;
            bf16x8 qf[6];
#pragma unroll
            for (int s = 0; s < 6; ++s) qf[s] = *(const bf16x8*)(Q + (tb + q0 + r32) * 768 + h * 96 + 16 * s + 8 * hi);
            f32x16 o0, o1;
#pragma unroll
            for (int r = 0; r < 16; ++r) { o0[r] = 0.f; o1[r] = 0.f; }
            float mrow = 0.f, lsum = 0.f;
            const int nt = 4 * (qb + 1);
            u32x4 pfa[3], pfb[3];
            bf16x8 pb[2][2];
            const unsigned offKV = (unsigned)((tid >> 3) * 512 + (tid & 7) * 8) * 2u, offKR = (unsigned)((tid >> 2) * 32 + (tid & 3) * 8) * 2u;
            const unsigned ldsK = (unsigned)((tid >> 3) * AT_KROW + (tid & 7) * 16), ldsR = (unsigned)((tid >> 2) * AT_KROW + 128 + (tid & 3) * 16), ldsV = (unsigned)(((tid & 7) >> 2) * 4096 + (tid >> 3) * 64 + (tid & 3) * 16);
            typedef const __attribute__((address_space(1))) unsigned char* gcp_t; typedef const __attribute__((address_space(1))) u32x4* gv4_t;
#define AT_LOAD(kt, pf) do { const size_t _k0 = (size_t)(kt) * 64; \
                pf[0] = *(gv4_t)((gcp_t)(kn + _k0 * 512) + offKV); pf[1] = *(gv4_t)((gcp_t)(vv + _k0 * 512) + offKV); \
                if (tid < 256) pf[2] = *(gv4_t)((gcp_t)(kr + _k0 * 32) + offKR); } while (0)
#define AT_STORE(par, pf) do { LAS unsigned char* _kb = lds + (par) * AT_KBYTES; LAS unsigned char* _vb = lds + 2 * AT_KBYTES + (par) * AT_VBYTES; \
                *(LAS u32x4*)(_kb + ldsK) = pf[0]; *(LAS u32x4*)(_vb + ldsV) = pf[1]; if (tid < 256) *(LAS u32x4*)(_kb + ldsR) = pf[2]; } while (0)
#define AT_PV(vbuf) do { LAS unsigned char* vlane = lds + 2 * AT_KBYTES + (vbuf) * AT_VBYTES + vlane_off; \
                bf16x8 vf[2][2][2]; \
                _Pragma("unroll") for (int kb2 = 0; kb2 < 2; ++kb2) _Pragma("unroll") for (int s2 = 0; s2 < 2; ++s2) _Pragma("unroll") for (int db = 0; db < 2; ++db) { \
                    LAS unsigned char* va = vlane + db * 4096 + (32 * kb2 + 16 * s2) * 64; \
                    const v4i16_t lo = __builtin_amdgcn_ds_read_tr16_b64_v4i16((LAS v4i16_t*)va); \
                    const v4i16_t hh = __builtin_amdgcn_ds_read_tr16_b64_v4i16((LAS v4i16_t*)(va + 8 * 64)); \
                    vf[kb2][s2][db] = (bf16x8){lo[0], lo[1], lo[2], lo[3], hh[0], hh[1], hh[2], hh[3]}; } \
                __builtin_amdgcn_sched_barrier(0); \
                _Pragma("unroll") for (int kb2 = 0; kb2 < 2; ++kb2) _Pragma("unroll") for (int s2 = 0; s2 < 2; ++s2) { \
                    o0 = __builtin_amdgcn_mfma_f32_32x32x16_bf16(vf[kb2][s2][0], pb[kb2][s2], o0, 0, 0, 0); \
                    o1 = __builtin_amdgcn_mfma_f32_32x32x16_bf16(vf[kb2][s2][1], pb[kb2][s2], o1, 0, 0, 0); } } while (0)
#define AT_ITER(KT, PAR, PFL, PFS) do { const int kt = (KT); \
                if (kt + 2 < nt) AT_LOAD(kt + 2, PFL); \
                const int kbase = kt * 64; \
                if (kbase <= q0 + 31) { \
                    LAS unsigned char* kb = lds + (PAR) * AT_KBYTES; \
                    f32x16 p0, p1; \
                _Pragma("unroll") \
                    for (int r = 0; r < 16; ++r) { p0[r] = 0.f; p1[r] = 0.f; }        \
                      \
                    bf16x8 kn0 = *(const LAS bf16x8*)(kb + r32 * AT_KROW + (8 * hi) * 2), kn1 = *(const LAS bf16x8*)(kb + (32 + r32) * AT_KROW + (8 * hi) * 2); \
                _Pragma("unroll") \
                    for (int s = 0; s < 6; ++s) { \
                        const bf16x8 k0 = kn0, k1 = kn1; \
                        if (s + 1 < 6) { kn0 = *(const LAS bf16x8*)(kb + r32 * AT_KROW + (16 * (s + 1) + 8 * hi) * 2); kn1 = *(const LAS bf16x8*)(kb + (32 + r32) * AT_KROW + (16 * (s + 1) + 8 * hi) * 2); } \
                        __builtin_amdgcn_sched_barrier(0); \
                        p0 = __builtin_amdgcn_mfma_f32_32x32x16_bf16(k0, qf[s], p0, 0, 0, 0); \
                        p1 = __builtin_amdgcn_mfma_f32_32x32x16_bf16(k1, qf[s], p1, 0, 0, 0); \
                        __builtin_amdgcn_sched_barrier(0); \
                    } \
                    if (__builtin_amdgcn_ballot_w64(mrow != 0.f) != 0ull) {            \
                _Pragma("unroll") \
                        for (int r = 0; r < 16; ++r) { p0[r] -= mrow; p1[r] -= mrow; } \
                    } \
                    if (kbase + 63 > q0) { \
                        const int qrel = q0 + r32 - kbase - 4 * hi; \
                _Pragma("unroll") \
                        for (int r = 0; r < 16; ++r) { if ((r & 3) + 8 * (r >> 2) > qrel) p0[r] = -INFINITY; if ((r & 3) + 8 * (r >> 2) + 32 > qrel) p1[r] = -INFINITY; } \
                    } \
                    float mxa = max3f_(p0[0], p0[1], p1[0]), mxb = max3f_(p0[2], p0[3], p1[1]); mxa = max3f_(mxa, p1[2], p1[3]); \
                _Pragma("unroll") \
                    for (int r = 4; r < 16; r += 4) { mxa = max3f_(mxa, p0[r], p0[r + 1]); mxb = max3f_(mxb, p0[r + 2], p0[r + 3]); mxa = max3f_(mxa, p1[r], p1[r + 1]); mxb = max3f_(mxb, p1[r + 2], p1[r + 3]); } \
                    float mx = max2f_(mxa, mxb); \
                    if (__builtin_amdgcn_ballot_w64(mx > AT_THR) != 0ull) {       \
                        mx = max2f_(mx, shfl_xor_l(mx, 32, lane)); \
                        const float d = max2f_(mx, 0.f), sc = __builtin_amdgcn_exp2f(-d); \
                        lsum *= sc; \
                _Pragma("unroll") \
                        for (int r = 0; r < 16; ++r) { o0[r] *= sc; o1[r] *= sc; p0[r] -= d; p1[r] -= d; } \
                        mrow += d; \
                    } \
                    pg8::f32x2 psa = (pg8::f32x2){0.f, 0.f}, psb = (pg8::f32x2){0.f, 0.f};        \
                _Pragma("unroll") \
                    for (int r = 0; r < 16; r += 2) { p0[r] = __builtin_amdgcn_exp2f(p0[r]); p0[r + 1] = __builtin_amdgcn_exp2f(p0[r + 1]); p1[r] = __builtin_amdgcn_exp2f(p1[r]); p1[r + 1] = __builtin_amdgcn_exp2f(p1[r + 1]); \
                        psa += (pg8::f32x2){p0[r], p0[r + 1]}; psb += (pg8::f32x2){p1[r], p1[r + 1]}; } \
                    psa += psb; \
                    lsum += psa.x + psa.y; \
                _Pragma("unroll") \
                    for (int s2 = 0; s2 < 2; ++s2) { \
                        u32x4 w0, w1; \
                        w0.x = pg8::cvt_pk_bf16(p0[8 * s2 + 0], p0[8 * s2 + 1]); w0.y = pg8::cvt_pk_bf16(p0[8 * s2 + 2], p0[8 * s2 + 3]); w0.z = pg8::cvt_pk_bf16(p0[8 * s2 + 4], p0[8 * s2 + 5]); w0.w = pg8::cvt_pk_bf16(p0[8 * s2 + 6], p0[8 * s2 + 7]); \
                        w1.x = pg8::cvt_pk_bf16(p1[8 * s2 + 0], p1[8 * s2 + 1]); w1.y = pg8::cvt_pk_bf16(p1[8 * s2 + 2], p1[8 * s2 + 3]); w1.z = pg8::cvt_pk_bf16(p1[8 * s2 + 4], p1[8 * s2 + 5]); w1.w = pg8::cvt_pk_bf16(p1[8 * s2 + 6], p1[8 * s2 + 7]); \
                        pb[0][s2] = __builtin_bit_cast(bf16x8, w0); pb[1][s2] = __builtin_bit_cast(bf16x8, w1); \
                    } \
                    AT_PV(PAR); \
                } \
                if (kt + 1 < nt) AT_STORE(1 - (PAR), PFS); \
                asm volatile("s_waitcnt lgkmcnt(0)\n\ts_barrier" ::: "memory");     \
            } while (0)
            AT_LOAD(0, pfa);
            AT_STORE(0, pfa);
            AT_LOAD(1, pfb);
            __syncthreads();
            for (int kt2 = 0; kt2 < nt; kt2 += 2) { AT_ITER(kt2, 0, pfa, pfb); AT_ITER(kt2 + 1, 1, pfb, pfa); }
#undef AT_ITER
            __syncthreads();
#undef AT_LOAD
#undef AT_STORE
#undef AT_PV
            const float inv = 1.0f / (lsum + shfl_xor_l(lsum, 32, lane));
            bf16_t* yrow = Y + (tb + q0 + r32) * DM + 512 + h * 64 + 4 * hi;
#pragma unroll
            for (int g4 = 0; g4 < 4; ++g4) {
                u32x2 w; w.x = pg8::cvt_pk_bf16(o0[4 * g4] * inv, o0[4 * g4 + 1] * inv); w.y = pg8::cvt_pk_bf16(o0[4 * g4 + 2] * inv, o0[4 * g4 + 3] * inv);
                *(u32x2*)(yrow + 8 * g4) = w;
                u32x2 w2; w2.x = pg8::cvt_pk_bf16(o1[4 * g4] * inv, o1[4 * g4 + 1] * inv); w2.y = pg8::cvt_pk_bf16(o1[4 * g4 + 2] * inv, o1[4 * g4 + 3] * inv);
                *(u32x2*)(yrow + 32 + 8 * g4) = w2;
            }
        }
    }
}

__device__ __forceinline__ void even_mix_phase(LAS unsigned char* lds, const int wave, const int lane, const int bx, const int G,
                                               const bf16_t* __restrict__ BG, const bf16_t* __restrict__ CX, const bf16_t* __restrict__ GZU, const bf16_t* __restrict__ GZV, const bf16_t* __restrict__ SGW,
                                               const float* __restrict__ conv_w, const float* __restrict__ sg_b, const float* __restrict__ vn_g, const float* __restrict__ vn_b, bf16_t* __restrict__ Y) {
    const int hi = lane >> 5, r32 = lane & 31;
    for (int chunk = bx; chunk < NT / 128; chunk += G) {
        const int tok0 = chunk * 128, t0 = tok0 % SEQ;
        {
            float gch[8], bch[8], w0[8], w1[8], w2[8];
#pragma unroll
            for (int c = 0; c < 8; ++c) { gch[c] = vn_g[lane * 8 + c]; bch[c] = vn_b[lane * 8 + c]; w0[c] = conv_w[lane * 8 + c]; w1[c] = conv_w[512 + lane * 8 + c]; w2[c] = conv_w[1024 + lane * 8 + c]; }
            float p1[8], p2[8];
            { const int j0 = wave * 16; const int tq = t0 + j0;
              const u32x4 a1 = tq >= 1 ? *(const u32x4*)(CX + (size_t)(tok0 + j0 - 1) * 512 + lane * 8) : (u32x4){0u, 0u, 0u, 0u};
              const u32x4 a2 = tq >= 2 ? *(const u32x4*)(CX + (size_t)(tok0 + j0 - 2) * 512 + lane * 8) : (u32x4){0u, 0u, 0u, 0u};
#pragma unroll
              for (int c = 0; c < 8; ++c) { p1[c] = __uint_as_float((c & 1) ? (a1[c >> 1] & 0xffff0000u) : (a1[c >> 1] << 16)); p2[c] = __uint_as_float((c & 1) ? (a2[c >> 1] & 0xffff0000u) : (a2[c >> 1] << 16)); } }
            u32x4 zvn[4], cxn[4], bgn[4];
#pragma unroll
            for (int r4 = 0; r4 < 4; ++r4) { const size_t rowoff = (size_t)(tok0 + wave * 16 + r4) * 512 + lane * 8; zvn[r4] = *(const u32x4*)(GZV + rowoff); cxn[r4] = *(const u32x4*)(CX + rowoff); bgn[r4] = *(const u32x4*)(BG + rowoff); }
#pragma unroll
            for (int jb = 0; jb < 16; jb += 4) {
                u32x4 zv4[4], cx4[4], bg4[4];
#pragma unroll
                for (int r4 = 0; r4 < 4; ++r4) { zv4[r4] = zvn[r4]; cx4[r4] = cxn[r4]; bg4[r4] = bgn[r4]; }
                if (jb + 4 < 16) {
#pragma unroll
                    for (int r4 = 0; r4 < 4; ++r4) { const size_t rowoff = (size_t)(tok0 + wave * 16 + jb + 4 + r4) * 512 + lane * 8; zvn[r4] = *(const u32x4*)(GZV + rowoff); cxn[r4] = *(const u32x4*)(CX + rowoff); bgn[r4] = *(const u32x4*)(BG + rowoff); }
                }
#pragma unroll
                for (int r4 = 0; r4 < 4; ++r4) {
                const int j = wave * 16 + jb + r4;
                const u32x4 zv = zv4[r4], cxv = cx4[r4], bgv = bg4[r4];
                float v[8]; float s = 0.f;
#pragma unroll
                for (int c = 0; c < 8; ++c) { v[c] = __uint_as_float((c & 1) ? (zv[c >> 1] & 0xffff0000u) : (zv[c >> 1] << 16)); s += v[c]; }
                const float mean = wave_sum_l(s, lane) * (1.f / 512.f); float q = 0.f;
#pragma unroll
                for (int c = 0; c < 8; ++c) { v[c] -= mean; q += v[c] * v[c]; }
                const float rstd = rsqrtf(wave_sum_l(q, lane) * (1.f / 512.f) + LN_EPS);
                float z[8];
#pragma unroll
                for (int c = 0; c < 8; ++c) z[c] = v[c] * rstd * gch[c] + bch[c];
                *(LAS u32x4*)(lds + (lane >> 2) * 8192 + j * 64 + (lane & 3) * 16) = pg8::pack8((f32x4){z[0], z[1], z[2], z[3]}, (f32x4){z[4], z[5], z[6], z[7]});
                float ya[8];
#pragma unroll
                for (int c = 0; c < 8; ++c) { const float cxc = __uint_as_float((c & 1) ? (cxv[c >> 1] & 0xffff0000u) : (cxv[c >> 1] << 16)), bgc = __uint_as_float((c & 1) ? (bgv[c >> 1] & 0xffff0000u) : (bgv[c >> 1] << 16));
                    ya[c] = bgc * (w0[c] * p2[c] + w1[c] * p1[c] + w2[c] * cxc); p2[c] = p1[c]; p1[c] = cxc; }
                *(u32x4*)(Y + (size_t)(tok0 + j) * DM + lane * 8) = pg8::pack8((f32x4){ya[0], ya[1], ya[2], ya[3]}, (f32x4){ya[4], ya[5], ya[6], ya[7]});
                }
            }
        }
        __syncthreads();
        {
            const int h = wave;
            const int g1 = (lane >> 4) & 1, i16 = lane & 15, tq = i16 >> 2, tp = i16 & 3;
            LAS unsigned char* zl = lds + (2 * h) * 8192 + (8 * hi + tq) * 64 + (16 * g1 + 4 * tp) * 2;
            const bf16_t* wh = SGW + (size_t)h * 128 * 128;
#pragma unroll 1
            for (int ib = 0; ib < 4; ++ib) {
                f32x16 a0, a1;
#pragma unroll
                for (int r = 0; r < 16; ++r) { a0[r] = 0.f; a1[r] = 0.f; }
                const bf16_t* wrow = wh + (size_t)(32 * ib + r32) * 128 + 8 * hi;
                const int irow = 32 * ib + r32; const float bias = sg_b[h * 128 + irow];
                const size_t trow = (size_t)(tok0 + irow);
                u32x2 zuv[2][4];
#pragma unroll
                for (int cb = 0; cb < 2; ++cb)
#pragma unroll
                    for (int g4 = 0; g4 < 4; ++g4) zuv[cb][g4] = *(const u32x2*)(GZU + trow * 512 + h * 64 + cb * 32 + 8 * g4 + 4 * hi);
                bf16x8 bnx = *(const bf16x8*)wrow;
                for (int ks = 0; ks < 2 * ib + 2; ++ks) {
                    const bf16x8 bfr = bnx;
                    if (ks + 1 < 2 * ib + 2) bnx = *(const bf16x8*)(wrow + 16 * (ks + 1));
                    LAS unsigned char* za = zl + (16 * ks) * 64;
                    const v4i16_t l0 = __builtin_amdgcn_ds_read_tr16_b64_v4i16((LAS v4i16_t*)za), h0 = __builtin_amdgcn_ds_read_tr16_b64_v4i16((LAS v4i16_t*)(za + 4 * 64));
                    const v4i16_t l1 = __builtin_amdgcn_ds_read_tr16_b64_v4i16((LAS v4i16_t*)(za + 8192)), h1 = __builtin_amdgcn_ds_read_tr16_b64_v4i16((LAS v4i16_t*)(za + 8192 + 4 * 64));
                    a0 = __builtin_amdgcn_mfma_f32_32x32x16_bf16((bf16x8){l0[0], l0[1], l0[2], l0[3], h0[0], h0[1], h0[2], h0[3]}, bfr, a0, 0, 0, 0);
                    a1 = __builtin_amdgcn_mfma_f32_32x32x16_bf16((bf16x8){l1[0], l1[1], l1[2], l1[3], h1[0], h1[1], h1[2], h1[3]}, bfr, a1, 0, 0, 0);
                }
#pragma unroll
                for (int cb = 0; cb < 2; ++cb)
#pragma unroll
                    for (int g4 = 0; g4 < 4; ++g4) {
                        const int ch = h * 64 + cb * 32 + 8 * g4 + 4 * hi;
                        const u32x2 zu = zuv[cb][g4];
                        float o[4];
#pragma unroll
                        for (int c = 0; c < 4; ++c) { const float acc = cb ? a1[4 * g4 + c] : a0[4 * g4 + c]; const float zuf = __uint_as_float((c & 1) ? (zu[c >> 1] & 0xffff0000u) : (zu[c >> 1] << 16)); o[c] = zuf * (acc + bias); }
                        u32x2 w; w.x = pg8::cvt_pk_bf16(o[0], o[1]); w.y = pg8::cvt_pk_bf16(o[2], o[3]);
                        *(u32x2*)(Y + trow * DM + 512 + ch) = w;
                    }
            }
        }
        __syncthreads();
    }
}

typedef __bf16 bf16x2_t __attribute__((ext_vector_type(2)));
constexpr int OM_WBYTES = 31 * 512 * 4, OM_TILE = 32, OM_ROWS = OM_TILE + 30;
__device__ __forceinline__ void odd_mix_phase(LAS unsigned char* lds, const int wave, const int lane, const int bx, const int G,
                                              const bf16_t* __restrict__ GLU, const bf16_t* __restrict__ CQKV, const bf16_t* __restrict__ KRR, const float* __restrict__ CS,
                                              const float* __restrict__ dw_w, const float* __restrict__ dw_b, const float* __restrict__ cn_g, const float* __restrict__ cn_b,
                                              const float* __restrict__ qn_g, const float* __restrict__ kvn_g, bf16_t* __restrict__ Y, bf16_t* __restrict__ CQKVN, bf16_t* __restrict__ KR) {
    const int tid = wave * 64 + lane;
    LAS unsigned char* gl = lds + OM_WBYTES;
    LAS float* wl = (LAS float*)lds;
    for (int i = tid; i < 31 * 512 / 4; i += NTHR) *(LAS f32x4*)(wl + 4 * i) = *(const f32x4*)(dw_w + 4 * i);
    float bch[8], gch[8], cch[8];
#pragma unroll
    for (int c = 0; c < 8; ++c) { bch[c] = dw_b[lane * 8 + c]; gch[c] = cn_g[lane * 8 + c]; cch[c] = cn_b[lane * 8 + c]; }
    const f32x4 qg = *(const f32x4*)(qn_g + lane * 4); const float kg0 = kvn_g[lane * 2], kg1 = kvn_g[lane * 2 + 1];
    u32x4 pf[8];
#define OM_LOAD(tile_) do { const int _tok0 = (tile_) * OM_TILE, _t0 = _tok0 % SEQ; _Pragma("unroll") for (int i = 0; i < 8; ++i) { const int c = tid + NTHR * i, rr = c >> 6, cc = c & 63; \
        pf[i] = (c < OM_ROWS * 64 && _t0 - 30 + rr >= 0) ? *(const u32x4*)(GLU + (size_t)(_tok0 - 30 + rr) * 512 + cc * 8) : (u32x4){0u, 0u, 0u, 0u}; } } while (0)
    int tile = bx;
    if (tile < NT / OM_TILE) OM_LOAD(tile);
    for (; tile < NT / OM_TILE; tile += G) {
        const int tok0 = tile * OM_TILE;
        __syncthreads();
#pragma unroll
        for (int i = 0; i < 8; ++i) { const int c = tid + NTHR * i, rr = c >> 6, cc = c & 63; if (c < OM_ROWS * 64) *(LAS u32x4*)(gl + rr * 1024 + cc * 16) = pf[i]; }
        __syncthreads();
        if (tile + G < NT / OM_TILE) OM_LOAD(tile + G);
        u32x2 cqv[4]; unsigned ckv[4]; float kx1[4], kx2[4], kcs[4], ksn[4];
#pragma unroll
        for (int tt = 0; tt < 4; ++tt) { const size_t row = (size_t)(tok0 + wave * 4 + tt);
            cqv[tt] = *(const u32x2*)(CQKV + row * 384 + lane * 4); ckv[tt] = *(const unsigned*)(CQKV + row * 384 + 256 + lane * 2);
            kx1[tt] = bf2f(KRR[row * 32 + (lane & 15)]); kx2[tt] = bf2f(KRR[row * 32 + 16 + (lane & 15)]); kcs[tt] = CS[row * 32 + (lane & 15)]; ksn[tt] = CS[row * 32 + 16 + (lane & 15)]; }
        pg8::f32x2 acc2[4][4], W[4][4];
#pragma unroll
        for (int tt = 0; tt < 4; ++tt)
#pragma unroll
            for (int i = 0; i < 4; ++i) acc2[tt][i] = (pg8::f32x2){bch[2 * i], bch[2 * i + 1]};
        const int rb = wave * 4;
#define OM_ROW(dst, ridx) do { const u32x4 g4_ = *(const LAS u32x4*)(gl + (ridx) * 1024 + lane * 16); _Pragma("unroll") for (int i = 0; i < 4; ++i) dst[i] = (pg8::f32x2){__uint_as_float(g4_[i] << 16), __uint_as_float(g4_[i] & 0xffff0000u)}; } while (0)
#define OM_TAP(k, A, B, C, D) do { const f32x4 wa_ = *(const LAS f32x4*)(wl + (k) * 512 + lane * 8), wb_ = *(const LAS f32x4*)(wl + (k) * 512 + lane * 8 + 4); \
            const pg8::f32x2 w2_[4] = {(pg8::f32x2){wa_[0], wa_[1]}, (pg8::f32x2){wa_[2], wa_[3]}, (pg8::f32x2){wb_[0], wb_[1]}, (pg8::f32x2){wb_[2], wb_[3]}}; \
            _Pragma("unroll") for (int i = 0; i < 4; ++i) { acc2[0][i] += w2_[i] * W[A][i]; acc2[1][i] += w2_[i] * W[B][i]; acc2[2][i] += w2_[i] * W[C][i]; acc2[3][i] += w2_[i] * W[D][i]; } } while (0)
        OM_ROW(W[0], rb); OM_ROW(W[1], rb + 1); OM_ROW(W[2], rb + 2); OM_ROW(W[3], rb + 3);
#pragma unroll 1
        for (int k = 0; k < 28; k += 4) {
            OM_TAP(k, 0, 1, 2, 3); OM_ROW(W[0], rb + k + 4);
            OM_TAP(k + 1, 1, 2, 3, 0); OM_ROW(W[1], rb + k + 5);
            OM_TAP(k + 2, 2, 3, 0, 1); OM_ROW(W[2], rb + k + 6);
            OM_TAP(k + 3, 3, 0, 1, 2); OM_ROW(W[3], rb + k + 7);
        }
        OM_TAP(28, 0, 1, 2, 3); OM_ROW(W[0], rb + 32);
        OM_TAP(29, 1, 2, 3, 0); OM_ROW(W[1], rb + 33);
        OM_TAP(30, 2, 3, 0, 1);
#undef OM_ROW
#undef OM_TAP
        float acc[4][8];
#pragma unroll
        for (int tt = 0; tt < 4; ++tt)
#pragma unroll
            for (int i = 0; i < 4; ++i) { acc[tt][2 * i] = acc2[tt][i].x; acc[tt][2 * i + 1] = acc2[tt][i].y; }
        float red[12]; float cq[4][4], ck[4][2];
#pragma unroll
        for (int tt = 0; tt < 4; ++tt) {
            float s = 0.f;
#pragma unroll
            for (int c = 0; c < 8; ++c) s += acc[tt][c];
            float sq = 0.f;
#pragma unroll
            for (int c = 0; c < 4; ++c) { cq[tt][c] = __uint_as_float((c & 1) ? (cqv[tt][c >> 1] & 0xffff0000u) : (cqv[tt][c >> 1] << 16)); sq += cq[tt][c] * cq[tt][c]; }
            ck[tt][0] = __uint_as_float(ckv[tt] << 16); ck[tt][1] = __uint_as_float(ckv[tt] & 0xffff0000u);
            red[tt] = s; red[4 + tt] = sq; red[8 + tt] = ck[tt][0] * ck[tt][0] + ck[tt][1] * ck[tt][1];
        }
        wave_sum_n<12>(red, lane);
        float qv[4];
#pragma unroll
        for (int tt = 0; tt < 4; ++tt) { const float mean = red[tt] * (1.f / 512.f); float q = 0.f;
#pragma unroll
            for (int c = 0; c < 8; ++c) { acc[tt][c] -= mean; q += acc[tt][c] * acc[tt][c]; }
            qv[tt] = q; }
        wave_sum_n<4>(qv, lane);
#pragma unroll
        for (int tt = 0; tt < 4; ++tt) {
            const int row = tok0 + wave * 4 + tt;
            const float rstd = rsqrtf(qv[tt] * (1.f / 512.f) + LN_EPS);
            float o8[8];
#pragma unroll
            for (int c = 0; c < 8; ++c) { const float z = acc[tt][c] * rstd * gch[c] + cch[c]; o8[c] = z * pg8::fsig(z); }
            *(u32x4*)(Y + (size_t)row * DM + lane * 8) = pg8::pack8((f32x4){o8[0], o8[1], o8[2], o8[3]}, (f32x4){o8[4], o8[5], o8[6], o8[7]});
            const float rq = rsqrtf(red[4 + tt] * (1.f / 256.f) + RMS_EPS), rk = rsqrtf(red[8 + tt] * (1.f / 128.f) + RMS_EPS);
            u32x2 wq; wq.x = pg8::cvt_pk_bf16(cq[tt][0] * rq * qg[0], cq[tt][1] * rq * qg[1]); wq.y = pg8::cvt_pk_bf16(cq[tt][2] * rq * qg[2], cq[tt][3] * rq * qg[3]);
            *(u32x2*)(CQKVN + (size_t)row * 384 + lane * 4) = wq;
            *(unsigned*)(CQKVN + (size_t)row * 384 + 256 + lane * 2) = pg8::cvt_pk_bf16(ck[tt][0] * rk * kg0, ck[tt][1] * rk * kg1);
            if (lane < 16) *(unsigned*)(KR + (size_t)row * 32 + 2 * lane) = pg8::cvt_pk_bf16(kx1[tt] * kcs[tt] - kx2[tt] * ksn[tt], kx2[tt] * kcs[tt] + kx1[tt] * ksn[tt]);
        }
    }
#undef OM_LOAD
    __syncthreads();
}

constexpr int LR_USTRIDE = 2048 + 32;
constexpr int LR_UH = 0, LR_UL = 16 * LR_USTRIDE, LR_PART = 2 * 16 * LR_USTRIDE, LR_LOG = LR_PART + 8 * 16 * 32 * 4, LR_CNT = LR_LOG + 16 * 32 * 4 + 16 * 4 * 4, LR_REC = LR_CNT + 256, LR_PAR = LR_REC + 4096, LR_END = LR_PAR + 4 * DM * 4;
static_assert(LR_END <= MISC_OFF, "lnr LDS map");
__device__ __forceinline__ void lnr_phase(LAS unsigned char* lds, const int wave, const int lane, const int bx, const int G,
                                          const bf16_t* __restrict__ V, const float* __restrict__ lng, const float* __restrict__ lnb, const float* __restrict__ mod_l, float* __restrict__ STAT, unsigned char* __restrict__ U8,
                                          const float* __restrict__ rw, const float* __restrict__ rb, int* __restrict__ TOPE, float* __restrict__ TOPG, int* __restrict__ POS, int* __restrict__ LIST, unsigned* CNT) {
    const int tid = wave * 64 + lane, fr = lane & 15, fq = lane >> 4;
    LAS unsigned* lcnt = (LAS unsigned*)(lds + LR_CNT);
    LAS unsigned* lrec = (LAS unsigned*)(lds + LR_REC);
    LAS float* part = (LAS float*)(lds + LR_PART); LAS float* logit = (LAS float*)(lds + LR_LOG);
    bf16x8 wh[4][2], wl[4][2];
#pragma unroll
    for (int s4 = 0; s4 < 4; ++s4)
#pragma unroll
        for (int nt = 0; nt < 2; ++nt) {
            float wv[8], wr[8];
#pragma unroll
            for (int j = 0; j < 8; ++j) { wv[j] = rw[(size_t)(128 * wave + 32 * s4 + 8 * fq + j) * NEXP + 16 * nt + fr]; wr[j] = wv[j] - bf2f(f2bf(wv[j])); }
            wh[s4][nt] = __builtin_bit_cast(bf16x8, pg8::pack8((f32x4){wv[0], wv[1], wv[2], wv[3]}, (f32x4){wv[4], wv[5], wv[6], wv[7]}));
            wl[s4][nt] = __builtin_bit_cast(bf16x8, pg8::pack8((f32x4){wr[0], wr[1], wr[2], wr[3]}, (f32x4){wr[4], wr[5], wr[6], wr[7]}));
        }
    const int Gb = G / NB, bb = bx / Gb, kb = bx - bb * Gb;
    const bool act = bb < NB;
    LAS float* par = (LAS float*)(lds + LR_PAR);
    if (act) { const float* m = mod_l + (size_t)bb * 6 * DM;
        for (int i = tid; i < DM / 4; i += NTHR) { *(LAS f32x4*)(par + 4 * i) = *(const f32x4*)(lng + 4 * i); *(LAS f32x4*)(par + DM + 4 * i) = *(const f32x4*)(lnb + 4 * i);
            *(LAS f32x4*)(par + 2 * DM + 4 * i) = *(const f32x4*)(m + 4 * DM + 4 * i) + 1.0f; *(LAS f32x4*)(par + 3 * DM + 4 * i) = *(const f32x4*)(m + 3 * DM + 4 * i); } }
    if (tid < 64) lcnt[tid] = 0u;
    const float rbias = rb[lane & 31];
    __syncthreads();
    u32x2 vpre[2][4];
    const int sb0 = bb * (SEQ / 16) + kb;
    if (act && kb < SEQ / 16) {
#pragma unroll
        for (int rr = 0; rr < 2; ++rr)
#pragma unroll
            for (int j = 0; j < 4; ++j) vpre[rr][j] = *(const u32x2*)(V + (size_t)(sb0 * 16 + 2 * wave + rr) * DM + j * 256 + lane * 4);
    }
    int li = 0;
    for (int sq = act ? kb : SEQ / 16; sq < SEQ / 16; sq += Gb, ++li) {
        const int sb = bb * (SEQ / 16) + sq, rbase = sb * 16;
        int l4 = lane * 4; asm volatile("" : "+v"(l4));
        float vv[2][16], s2[2], q2[2], mean2[2];
#pragma unroll
        for (int rr = 0; rr < 2; ++rr) { float s = 0.f;
#pragma unroll
            for (int j = 0; j < 4; ++j) { const u32x2 tb = vpre[rr][j]; const f32x4 t4 = (f32x4){__uint_as_float(tb.x << 16), __uint_as_float(tb.x & 0xffff0000u), __uint_as_float(tb.y << 16), __uint_as_float(tb.y & 0xffff0000u)};
                vv[rr][4 * j] = t4[0]; vv[rr][4 * j + 1] = t4[1]; vv[rr][4 * j + 2] = t4[2]; vv[rr][4 * j + 3] = t4[3]; s += (t4[0] + t4[1]) + (t4[2] + t4[3]); }
            s2[rr] = s; }
        wave_sum_n<2>(s2, lane);
#pragma unroll
        for (int rr = 0; rr < 2; ++rr) { mean2[rr] = s2[rr] * (1.f / DM); float q = 0.f;
#pragma unroll
            for (int i = 0; i < 16; ++i) { vv[rr][i] -= mean2[rr]; q += vv[rr][i] * vv[rr][i]; }
            q2[rr] = q; }
        wave_sum_n<2>(q2, lane);
#pragma unroll
        for (int rr = 0; rr < 2; ++rr) {
            const int r16 = 2 * wave + rr; const size_t row = (size_t)(rbase + r16);
            float (&v)[16] = vv[rr];
            const float mean = mean2[rr];
            const float rstd = rsqrtf(q2[rr] * (1.f / DM) + LN_EPS);
            if (lane == 0) *(pg8::f32x2*)(STAT + row * 2) = (pg8::f32x2){mean, rstd};
#pragma unroll
            for (int j = 0; j < 4; ++j) {
                const f32x4 g4 = *(const LAS f32x4*)(par + j * 256 + l4), b4 = *(const LAS f32x4*)(par + DM + j * 256 + l4), sc4 = *(const LAS f32x4*)(par + 2 * DM + j * 256 + l4), sh4 = *(const LAS f32x4*)(par + 3 * DM + j * 256 + l4);
                f32x4 xn, uu, ur;
#pragma unroll
                for (int c = 0; c < 4; ++c) { xn[c] = v[4 * j + c] * rstd * g4[c] + b4[c]; uu[c] = xn[c] * sc4[c] + sh4[c]; }
                u32x2 ub; ub.x = pg8::cvt_pk_bf16(uu[0], uu[1]); ub.y = pg8::cvt_pk_bf16(uu[2], uu[3]);
                *(unsigned*)(U8 + row * DM + j * 256 + l4) = pk4_fp8(uu[0], uu[1], uu[2], uu[3]);
                ur[0] = uu[0] - __uint_as_float(ub.x << 16); ur[1] = uu[1] - __uint_as_float(ub.x & 0xffff0000u); ur[2] = uu[2] - __uint_as_float(ub.y << 16); ur[3] = uu[3] - __uint_as_float(ub.y & 0xffff0000u);
                u32x2 ul; ul.x = pg8::cvt_pk_bf16(ur[0], ur[1]); ul.y = pg8::cvt_pk_bf16(ur[2], ur[3]);
                *(LAS u32x2*)(lds + LR_UH + r16 * LR_USTRIDE + (j * 256 + l4) * 2) = ub;
                *(LAS u32x2*)(lds + LR_UL + r16 * LR_USTRIDE + (j * 256 + l4) * 2) = ul;
            }
        }
        if (sq + Gb < SEQ / 16) {
#pragma unroll
            for (int rr = 0; rr < 2; ++rr)
#pragma unroll
                for (int j = 0; j < 4; ++j) vpre[rr][j] = *(const u32x2*)(V + (size_t)((sb + Gb) * 16 + 2 * wave + rr) * DM + j * 256 + l4);
        }
        __syncthreads();
        f32x4 acc0 = (f32x4){0.f, 0.f, 0.f, 0.f}, acc1 = (f32x4){0.f, 0.f, 0.f, 0.f};
#pragma unroll
        for (int s4 = 0; s4 < 4; ++s4) {
            const bf16x8 uh = *(const LAS bf16x8*)(lds + LR_UH + fr * LR_USTRIDE + (128 * wave + 32 * s4 + 8 * fq) * 2);
            const bf16x8 ul = *(const LAS bf16x8*)(lds + LR_UL + fr * LR_USTRIDE + (128 * wave + 32 * s4 + 8 * fq) * 2);
            acc0 = __builtin_amdgcn_mfma_f32_16x16x32_bf16(uh, wh[s4][0], acc0, 0, 0, 0); acc1 = __builtin_amdgcn_mfma_f32_16x16x32_bf16(uh, wh[s4][1], acc1, 0, 0, 0);
            acc0 = __builtin_amdgcn_mfma_f32_16x16x32_bf16(ul, wh[s4][0], acc0, 0, 0, 0); acc1 = __builtin_amdgcn_mfma_f32_16x16x32_bf16(ul, wh[s4][1], acc1, 0, 0, 0);
            acc0 = __builtin_amdgcn_mfma_f32_16x16x32_bf16(uh, wl[s4][0], acc0, 0, 0, 0); acc1 = __builtin_amdgcn_mfma_f32_16x16x32_bf16(uh, wl[s4][1], acc1, 0, 0, 0);
        }
#pragma unroll
        for (int r = 0; r < 4; ++r) { part[(wave * 16 + 4 * fq + r) * 32 + fr] = acc0[r]; part[(wave * 16 + 4 * fq + r) * 32 + 16 + fr] = acc1[r]; }
        __syncthreads();
        { const int rr = lane >> 5, e = lane & 31, r16 = 2 * wave + rr; const size_t row = (size_t)(rbase + r16);
            float sv = rbias;
#pragma unroll
            for (int w8 = 0; w8 < 8; ++w8) sv += part[(w8 * 16 + r16) * 32 + e];
            logit[r16 * 32 + e] = sv;
            asm volatile("s_waitcnt lgkmcnt(0)" ::: "memory");
            int rank = 0;
#pragma unroll
            for (int e4 = 0; e4 < 8; ++e4) { const f32x4 t4 = *(const LAS f32x4*)(logit + r16 * 32 + 4 * e4);
#pragma unroll
                for (int c = 0; c < 4; ++c) { const int j = 4 * e4 + c; rank += (t4[c] > sv || (t4[c] == sv && j < e)) ? 1 : 0; } }
            LAS float* sel = logit + 512 + r16 * 4;
            if (rank < 4) sel[rank] = sv;
            asm volatile("s_waitcnt lgkmcnt(0)" ::: "memory");
            if (rank < 4) {
                const f32x4 t4 = *(const LAS f32x4*)sel;
                const float ex1 = __expf(t4[1] - t4[0]), ex2 = __expf(t4[2] - t4[0]), ex3 = __expf(t4[3] - t4[0]), inv = 1.0f / ((1.0f + ex1) + (ex2 + ex3));
                const unsigned k = __hip_atomic_fetch_add(lcnt + e, 1u, __ATOMIC_RELAXED, __HIP_MEMORY_SCOPE_WORKGROUP);
                lrec[(li * 16 + r16) * 4 + rank] = ((unsigned)e << 16) | k;
                TOPE[row * 4 + rank] = e; TOPG[row * 4 + rank] = __expf(sv - t4[0]) * inv;
            }
        }
        __syncthreads();
    }
    if (tid < NEXP) lcnt[32 + tid] = atomicAdd(&CNT[tid], lcnt[tid]);
    __syncthreads();
    for (int i = tid; i < li * 64; i += NTHR) { const unsigned rec = lrec[i]; const int sb = sb0 + (i >> 6) * Gb; const int pos = (int)(lcnt[32 + (rec >> 16)] + (rec & 0xffffu)); POS[(size_t)sb * 64 + (i & 63)] = pos; LIST[(size_t)(rec >> 16) * NT + pos] = sb * 16 + ((i & 63) >> 2); }
    __syncthreads();
}

__device__ __forceinline__ void unpack8(const u32x4 w, float (&f)[8]) {
#pragma unroll
    for (int c = 0; c < 4; ++c) { f[2 * c] = __uint_as_float(w[c] << 16); f[2 * c + 1] = __uint_as_float(w[c] & 0xffff0000u); }
}
__device__ __forceinline__ void unpack8_fp8(const u32x2 w, float (&f)[8]) {
#pragma unroll
    for (int c = 0; c < 2; ++c) { const auto lo = __builtin_amdgcn_cvt_pk_f32_fp8((int)w[c], false), hi = __builtin_amdgcn_cvt_pk_f32_fp8((int)w[c], true);
        f[4 * c] = lo[0]; f[4 * c + 1] = lo[1]; f[4 * c + 2] = hi[0]; f[4 * c + 3] = hi[1]; }
}
__device__ __forceinline__ void lnf_phase(LAS unsigned char* lds, const int wave, const int lane, const int bx, const int G, const unsigned char* __restrict__ YS, const int* __restrict__ TOPE, const int* __restrict__ POS, const unsigned* OFFS, const float* __restrict__ TOPG,
                                          const float* __restrict__ lng, const float* __restrict__ lnb, const float* __restrict__ mod_l, const float* __restrict__ mod_n,
                                          const bf16_t* __restrict__ V, const float* __restrict__ STAT, const float* __restrict__ lmg, const float* __restrict__ lmb,
                                          bf16_t* __restrict__ X, bf16_t* __restrict__ U, float* __restrict__ out_final) {
    const int Gb = G / NB, bb = bx / Gb, kb = bx - bb * Gb, tid = wave * 64 + lane;
    if (bb >= NB) return;
    LAS float* par = (LAS float*)lds;
    { const float* m = mod_l + (size_t)bb * 6 * DM; const float* mn = mod_n + (size_t)bb * 6 * DM;
        for (int i = tid; i < DM / 4; i += NTHR) { *(LAS f32x4*)(par + 4 * i) = *(const f32x4*)(m + 5 * DM + 4 * i) + 1.0f; *(LAS f32x4*)(par + DM + 4 * i) = *(const f32x4*)(lng + 4 * i); *(LAS f32x4*)(par + 2 * DM + 4 * i) = *(const f32x4*)(lnb + 4 * i);
            *(LAS f32x4*)(par + 3 * DM + 4 * i) = *(const f32x4*)(lmg + 4 * i); *(LAS f32x4*)(par + 4 * DM + 4 * i) = *(const f32x4*)(lmb + 4 * i);
            if (!out_final) { *(LAS f32x4*)(par + 5 * DM + 4 * i) = *(const f32x4*)(mn + DM + 4 * i) + 1.0f; *(LAS f32x4*)(par + 6 * DM + 4 * i) = *(const f32x4*)(mn + 4 * i); } } }
    LAS unsigned* ot = (LAS unsigned*)(par + 7 * DM);
    if (tid <= NEXP) ot[tid] = OFFS[tid];
    __syncthreads();
    for (int p = kb * NWAVES + wave; p < SEQ / 2; p += Gb * NWAVES) {
        const int row0 = bb * SEQ + 2 * p;
        int l8 = lane * 8; asm volatile("" : "+v"(l8));
        u32x4 sl[2]; f32x4 gk[2]; pg8::f32x2 st[2];
#pragma unroll
        for (int rr = 0; rr < 2; ++rr) { const u32x4 te = *(const u32x4*)(TOPE + (size_t)(row0 + rr) * 4), ps = *(const u32x4*)(POS + (size_t)(row0 + rr) * 4);
            sl[rr] = (u32x4){ot[te.x] + ps.x, ot[te.y] + ps.y, ot[te.z] + ps.z, ot[te.w] + ps.w}; gk[rr] = *(const f32x4*)(TOPG + (size_t)(row0 + rr) * 4) * 0.0625f; st[rr] = *(const pg8::f32x2*)(STAT + (size_t)(row0 + rr) * 2); }
        u32x2 yv[2][4][2]; u32x4 xv[2][2];
#pragma unroll
        for (int rr = 0; rr < 2; ++rr) {
#pragma unroll
            for (int k = 0; k < 4; ++k)
#pragma unroll
                for (int j = 0; j < 2; ++j) yv[rr][k][j] = *(const u32x2*)(YS + (size_t)sl[rr][k] * DM + j * 512 + l8);
#pragma unroll
            for (int j = 0; j < 2; ++j) xv[rr][j] = *(const u32x4*)(V + (size_t)(row0 + rr) * DM + j * 512 + l8);
        }
#pragma unroll
        for (int rr = 0; rr < 2; ++rr) {
            const size_t row = (size_t)(row0 + rr);
            float v[16]; float s = 0.f;
#pragma unroll
            for (int j = 0; j < 2; ++j) {
                float y[8], t[8], xs[8];
#pragma unroll
                for (int c = 0; c < 8; ++c) y[c] = 0.f;
#pragma unroll
                for (int k = 0; k < 4; ++k) { unpack8_fp8(yv[rr][k][j], t);
#pragma unroll
                    for (int c = 0; c < 8; ++c) y[c] += gk[rr][k] * t[c]; }
                unpack8(xv[rr][j], xs);
                { const f32x4 a0 = *(const LAS f32x4*)(par + 3 * DM + j * 512 + l8), a1 = *(const LAS f32x4*)(par + 3 * DM + j * 512 + l8 + 4), b0 = *(const LAS f32x4*)(par + 4 * DM + j * 512 + l8), b1 = *(const LAS f32x4*)(par + 4 * DM + j * 512 + l8 + 4);
#pragma unroll
                  for (int c = 0; c < 8; ++c) xs[c] = (xs[c] - st[rr].x) * st[rr].y * (c < 4 ? a0[c & 3] : a1[c & 3]) + (c < 4 ? b0[c & 3] : b1[c & 3]); }
                const f32x4 g0 = *(const LAS f32x4*)(par + j * 512 + l8), g1 = *(const LAS f32x4*)(par + j * 512 + l8 + 4);
#pragma unroll
                for (int c = 0; c < 8; ++c) { v[8 * j + c] = ALPHA * xs[c] + (c < 4 ? g0[c & 3] : g1[c & 3]) * y[c]; s += v[8 * j + c]; }
            }
            const float mean = wave_sum_l(s, lane) * (1.f / DM); float q = 0.f;
#pragma unroll
            for (int i = 0; i < 16; ++i) { v[i] -= mean; q += v[i] * v[i]; }
            const float rstd = rsqrtf(wave_sum_l(q, lane) * (1.f / DM) + LN_EPS);
#pragma unroll
            for (int j = 0; j < 2; ++j) {
                const f32x4 a0 = *(const LAS f32x4*)(par + DM + j * 512 + l8), a1 = *(const LAS f32x4*)(par + DM + j * 512 + l8 + 4), b0 = *(const LAS f32x4*)(par + 2 * DM + j * 512 + l8), b1 = *(const LAS f32x4*)(par + 2 * DM + j * 512 + l8 + 4);
                f32x4 x0, x1;
#pragma unroll
                for (int c = 0; c < 4; ++c) { x0[c] = v[8 * j + c] * rstd * a0[c] + b0[c]; x1[c] = v[8 * j + 4 + c] * rstd * a1[c] + b1[c]; }
                if (out_final) { *(f32x4*)(out_final + row * DM + j * 512 + l8) = x0; *(f32x4*)(out_final + row * DM + j * 512 + l8 + 4) = x1; }
                else {
                    *(u32x4*)(X + row * DM + j * 512 + l8) = pg8::pack8(x0, x1);
                    const f32x4 sc0 = *(const LAS f32x4*)(par + 5 * DM + j * 512 + l8), sc1 = *(const LAS f32x4*)(par + 5 * DM + j * 512 + l8 + 4), sh0 = *(const LAS f32x4*)(par + 6 * DM + j * 512 + l8), sh1 = *(const LAS f32x4*)(par + 6 * DM + j * 512 + l8 + 4);
                    *(u32x4*)(U + row * DM + j * 512 + l8) = pg8::pack8(x0 * sc0 + sh0, x1 * sc1 + sh1);
                }
            }
        }
    }
}

struct Params {
    const float *x_in, *c_in; const int* pos_in;
    const float *ada_w, *ada_b, *ln_mix_g, *ln_mix_b, *ln_ffn_g, *ln_ffn_b;
    const float *ev_w_in, *ev_conv_w, *ev_sg_w, *ev_sg_b, *ev_vn_g, *ev_vn_b, *ev_w_out;
    const float *od_w_in, *od_dw_w, *od_dw_b, *od_cn_g, *od_cn_b, *od_qn_g, *od_w_uq, *od_kvn_g, *od_w_ukv, *od_w_out;
    const float *r_w, *r_b, *w_gu, *b_gu, *w_dn, *b_dn;
    float* out; unsigned char* ws;
    int ph_lo, ph_hi;
};
constexpr int PH_PREP = 0, PH_MOD0 = 1, PH_LAYER0 = 2, PH_STRIDE = 16, PH_END = PH_LAYER0 + PH_STRIDE * (DEPTH - 1) + 10;
constexpr int LP_IN = 0, LP_MIX = 1, LP_UP = 2, LP_ATT = 3, LP_OUT = 4, LP_LNR = 5, LP_SCAT = 6, LP_M1 = 7, LP_M2 = 8, LP_LNF = 9;

enum { WM_ID = 0, WM_GU = 1, WM_EIN = 2, WM_OIN = 3, WM_UQ = 4, WM_UKV = 5 };
__device__ __forceinline__ int srccol(int mode, int pr) {
    const int tile = pr >> 8, r = pr & 255;
    switch (mode) {
        case WM_GU: return (r < 128 ? 0 : 1024) + tile * 128 + (r & 127);
        case WM_EIN: return (tile < 2 || tile >= 6) ? pr : ((r < 128 ? 512 : 1024) + (tile - 2) * 128 + (r & 127));
        case WM_OIN: if (tile < 4) return (r < 128 ? 0 : 512) + tile * 128 + (r & 127); if (tile == 4) return 1024 + r; return r < 128 ? 1280 + r : (r < 160 ? 1408 + (r - 128) : -1);
        case WM_UQ: { const int h = pr / 96, d = pr - 96 * h; return d < 64 ? pr : h * 96 + 64 + 16 * ((d - 64) & 1) + ((d - 64) >> 1); }
        case WM_UKV: { const int j = pr & 511, h = j >> 6, d = j & 63; return h * 128 + (pr < 512 ? 0 : 64) + d; }
        default: return pr;
    }
}
__device__ __forceinline__ void transpose_item(const float* W, int ldw, bf16_t* WT, int ldk, int k0, int n0, int mode, LAS float* scr, int lane) {
    if (mode == WM_UQ) {
        const int sc = srccol(mode, n0 + (lane & 31));
#pragma unroll 8
        for (int i = 0; i < 32; ++i) { const int kk = 2 * i + (lane >> 5); scr[kk * 33 + (lane & 31)] = W[(size_t)(k0 + kk) * ldw + sc]; }
    } else {
        const int c4 = (lane & 7) * 4, sc = srccol(mode, n0 + c4);
        f32x4 t[8];
#pragma unroll
        for (int i = 0; i < 8; ++i) { const int kk = 8 * i + (lane >> 3); t[i] = sc >= 0 ? __builtin_nontemporal_load((const f32x4*)(W + (size_t)(k0 + kk) * ldw + sc)) : (f32x4){0.f, 0.f, 0.f, 0.f}; }
#pragma unroll
        for (int i = 0; i < 8; ++i) { const int kk = 8 * i + (lane >> 3); LAS float* d = scr + kk * 33 + c4; d[0] = t[i][0]; d[1] = t[i][1]; d[2] = t[i][2]; d[3] = t[i][3]; }
    }
    asm volatile("s_waitcnt lgkmcnt(0)" ::: "memory");
    const int c = lane & 7;
#pragma unroll
    for (int j = 0; j < 4; ++j) { const int n = (lane >> 3) + 8 * j; const LAS float* s = scr + (8 * c) * 33 + n;
        u32x4 o; o.x = pg8::cvt_pk_bf16(s[0 * 33], s[1 * 33]); o.y = pg8::cvt_pk_bf16(s[2 * 33], s[3 * 33]); o.z = pg8::cvt_pk_bf16(s[4 * 33], s[5 * 33]); o.w = pg8::cvt_pk_bf16(s[6 * 33], s[7 * 33]);
        *(u32x4*)(WT + (size_t)(n0 + n) * ldk + k0 + 8 * c) = o; }
    asm volatile("s_waitcnt lgkmcnt(0)" ::: "memory");
}
__device__ __forceinline__ void transpose_item_f8(const float* W, int ldw, unsigned char* WT, int ldk, int k0, int n0, int mode, float mul, LAS float* scr, int lane) {
    const int c4 = (lane & 7) * 4, sc = srccol(mode, n0 + c4);
    f32x4 t[8];
#pragma unroll
    for (int i = 0; i < 8; ++i) { const int kk = 8 * i + (lane >> 3); t[i] = __builtin_nontemporal_load((const f32x4*)(W + (size_t)(k0 + kk) * ldw + sc)); }
#pragma unroll
    for (int i = 0; i < 8; ++i) { const int kk = 8 * i + (lane >> 3); LAS float* d = scr + kk * 33 + c4; d[0] = t[i][0] * mul; d[1] = t[i][1] * mul; d[2] = t[i][2] * mul; d[3] = t[i][3] * mul; }
    asm volatile("s_waitcnt lgkmcnt(0)" ::: "memory");
    const int c = lane & 3;
#pragma unroll
    for (int j = 0; j < 2; ++j) { const int n = (lane >> 2) + 16 * j; const LAS float* s = scr + (16 * c) * 33 + n;
        u32x4 o; o.x = pk4_fp8(s[0 * 33], s[1 * 33], s[2 * 33], s[3 * 33]); o.y = pk4_fp8(s[4 * 33], s[5 * 33], s[6 * 33], s[7 * 33]);
        o.z = pk4_fp8(s[8 * 33], s[9 * 33], s[10 * 33], s[11 * 33]); o.w = pk4_fp8(s[12 * 33], s[13 * 33], s[14 * 33], s[15 * 33]);
        *(u32x4*)(WT + (size_t)(n0 + n) * ldk + k0 + 16 * c) = o; }
    asm volatile("s_waitcnt lgkmcnt(0)" ::: "memory");
}
__device__ __forceinline__ bool prep_family_f8(int& it, const float* W, size_t wstride, int ldw, int K, int nphys, unsigned char* WT, size_t tstride, int ldk, int nmat, int mode, float mul, LAS float* scr, int lane) {
    const int nblk = nphys / 32, per = (K / 64) * nblk, tot = per * nmat;
    if (it >= tot) { it -= tot; return false; }
    const int mi = it / per, r = it % per, kb = r / nblk, nb = r % nblk;
    transpose_item_f8(W + (size_t)mi * wstride, ldw, WT + (size_t)mi * tstride, ldk, kb * 64, nb * 32, mode, mul, scr, lane);
    return true;
}
__device__ __forceinline__ bool prep_family(int& it, const float* W, size_t wstride, int ldw, int K, int nphys, bf16_t* WT, size_t tstride, int ldk, int koff, int nmat, int mode, LAS float* scr, int lane) {
    const int nblk = nphys / 32, per = (K / 64) * nblk, tot = per * nmat;
    if (it >= tot) { it -= tot; return false; }
    const int mi = it / per, r = it % per, kb = r / nblk, nb = r % nblk;
    transpose_item(W + (size_t)mi * wstride, ldw, WT + (size_t)mi * tstride + koff, ldk, kb * 64, nb * 32, mode, scr, lane);
    return true;
}


struct F8Item { const float* src; unsigned char* dst; float mul; };
constexpr int F8_SCR = 128 * 33 * 4;
__device__ __forceinline__ F8Item f8_item(const Params& P, unsigned char* ws, int it, int lane) {
    F8Item r; const int c4 = (lane & 7) * 4;
    if (it < 128 * 512) { const int mi = it >> 9, q = it & 511, k0 = (q >> 6) * 128, n0 = (q & 63) * 32;
        r.src = P.w_gu + (size_t)mi * DM * 2048 + (size_t)(k0 + (lane >> 3)) * 2048 + srccol(WM_GU, n0 + c4);
        r.dst = ws + WT_GU + (size_t)mi * 2048 * DM + (size_t)(n0 + (lane >> 3)) * DM + k0 + 16 * (lane & 7); r.mul = (float)(1 << W8_GU_SH); }
    else { const int i2 = it - 128 * 512, mi = i2 >> 8, q = i2 & 255, k0 = (q >> 5) * 128, n0 = (q & 31) * 32;
        r.src = P.w_dn + (size_t)mi * DM * DM + (size_t)(k0 + (lane >> 3)) * DM + n0 + c4;
        r.dst = ws + WT_DN + (size_t)mi * DM * DM + (size_t)(n0 + (lane >> 3)) * DM + k0 + 16 * (lane & 7); r.mul = (float)(1 << W8_DN_SH); }
    return r;
}
constexpr int F8_ITEMS_GU = 32 * 512, F8_ITEMS_DN = 32 * 256, F8_ITEMS_LAYER = F8_ITEMS_GU + F8_ITEMS_DN;
__device__ __forceinline__ int f8_item_id(int layer, int j) { return j < F8_ITEMS_GU ? layer * F8_ITEMS_GU + j : DEPTH * F8_ITEMS_GU + layer * F8_ITEMS_DN + (j - F8_ITEMS_GU); }
__device__ __forceinline__ void f8_convert(const Params& P, unsigned char* ws, LAS float* scr, int lane, int it) {
    const F8Item cur = f8_item(P, ws, it, lane);
    const int ldw = it < 128 * 512 ? 2048 : DM;
    f32x4 t[16];
#pragma unroll
    for (int i = 0; i < 16; ++i) t[i] = __builtin_nontemporal_load((const f32x4*)(cur.src + (size_t)(8 * i) * ldw));
    const int c4 = (lane & 7) * 4;
#pragma unroll
    for (int i = 0; i < 16; ++i) { const int kk = 8 * i + (lane >> 3); LAS float* d = scr + kk * 33 + c4; d[0] = t[i][0] * cur.mul; d[1] = t[i][1] * cur.mul; d[2] = t[i][2] * cur.mul; d[3] = t[i][3] * cur.mul; }
    asm volatile("s_waitcnt lgkmcnt(0)" ::: "memory");
#pragma unroll
    for (int j = 0; j < 4; ++j) { const LAS float* sp = scr + (16 * (lane & 7)) * 33 + (lane >> 3) + 8 * j;
        u32x4 o; o.x = pk4_fp8(sp[0 * 33], sp[1 * 33], sp[2 * 33], sp[3 * 33]); o.y = pk4_fp8(sp[4 * 33], sp[5 * 33], sp[6 * 33], sp[7 * 33]);
        o.z = pk4_fp8(sp[8 * 33], sp[9 * 33], sp[10 * 33], sp[11 * 33]); o.w = pk4_fp8(sp[12 * 33], sp[13 * 33], sp[14 * 33], sp[15 * 33]);
        *(u32x4*)(cur.dst + (size_t)(8 * j) * DM) = o; }
    asm volatile("s_waitcnt lgkmcnt(0)" ::: "memory");
}
struct SparePlan { int g1, q1, g2, q2, done; };
__device__ __forceinline__ SparePlan spare_plan(int nM, int G) {
    SparePlan p; const int n1 = nM * 8, r1 = (n1 + G - 1) / G, n2 = nM * 4, r2 = (n2 + G - 1) / G;
    p.g1 = (n1 + r1 - 1) / r1; p.q1 = 28 * r1; p.g2 = (n2 + r2 - 1) / r2; p.q2 = 30 * r2;
    const int d = (G - p.g1) * p.q1 + (G - p.g2) * p.q2; p.done = d < F8_ITEMS_LAYER ? d : F8_ITEMS_LAYER; return p;
}
__device__ __forceinline__ void f8_convert_range(const Params& P, unsigned char* ws, LAS float* scr, int lane, int wave, int layer, int j0, int j1) {
    if (j1 > F8_ITEMS_LAYER) j1 = F8_ITEMS_LAYER;
    for (int j = j0 + wave; j < j1; j += NWAVES) f8_convert(P, ws, scr, lane, f8_item_id(layer, j));
}
#define PH_LOCALS \
    __attribute__((address_space(1))) unsigned char* wsg = (__attribute__((address_space(1))) unsigned char*)P.ws; asm volatile("" : "+s"(wsg)); unsigned char* ws = (unsigned char*)wsg;     \
    const int lane = lane_id_asm(); \
    int wave = wave0; asm volatile("" : "+s"(wave)); const int tid = wave * 64 + lane; \
    int bx = blockIdx.x, G = gridDim.x; asm volatile("" : "+s"(bx), "+s"(G)); \
    const int gw = bx * NWAVES + wave, NW = G * NWAVES; \
    const size_t gtid = (size_t)bx * NTHR + tid, GT = (size_t)G * NTHR; \
    unsigned* ctl = (unsigned*)(ws + WS_CTL); \
    float* MOD = (float*)(ws + WS_MOD); float* CS = (float*)(ws + WS_CS); float* X = (float*)(ws + WS_X); float* V = (float*)(ws + WS_V); \
    bf16_t* U = (bf16_t*)(ws + WS_U); bf16_t* Y = (bf16_t*)(ws + WS_Y); bf16_t* BG = (bf16_t*)(ws + WS_BG); bf16_t* CX = (bf16_t*)(ws + WS_CX); bf16_t* GZU = (bf16_t*)(ws + WS_GZU); bf16_t* GZV = (bf16_t*)(ws + WS_GZV); \
    bf16_t* GLU = (bf16_t*)(ws + WS_GLU); bf16_t* CQKV = (bf16_t*)(ws + WS_CQKV); bf16_t* CQKVN = (bf16_t*)(ws + WS_CQKVN); bf16_t* KRR = (bf16_t*)(ws + WS_KRR); bf16_t* KR = (bf16_t*)(ws + WS_KR); \
    bf16_t* Q = (bf16_t*)(ws + WS_Q); bf16_t* KN = (bf16_t*)(ws + WS_KN); bf16_t* VV = (bf16_t*)(ws + WS_VV); \
    int* TOPE = (int*)(ws + WS_TOPE); float* TOPG = (float*)(ws + WS_TOPG); int* POS = (int*)(ws + WS_POS); int* SLOT = (int*)(ws + WS_SLOT); int* ROWTOK = (int*)(ws + WS_ROWTOK); \
    bf16_t* H = (bf16_t*)(ws + WS_H); unsigned char* YS = (unsigned char*)(ws + WS_YS); \
    (void)lane; (void)wave; (void)gw; (void)NW; (void)gtid; (void)GT; (void)ctl; (void)MOD; (void)CS; (void)X; (void)V; (void)U; (void)Y; (void)BG; (void)CX; (void)GZU; (void)GZV; (void)GLU; (void)CQKV; (void)CQKVN; \
    (void)KRR; (void)KR; (void)Q; (void)KN; (void)VV; (void)TOPE; (void)TOPG; (void)POS; (void)SLOT; (void)ROWTOK; (void)H; (void)YS
#define LY_LOCALS \
    int ly = layer; asm volatile("" : "+s"(ly)); const int li = ly >> 1; \
    const float* mod_l = MOD + (size_t)ly * NB * 6 * DM; const float* mod_n = MOD + (size_t)(ly + 1) * NB * 6 * DM; \
    const float* xres = ly == 0 ? P.x_in : X; \
    unsigned* CNT = ctl + CW_CNT + ly * 32; unsigned* OFFS = ctl + CW_OFFS + ly * 64; \
    (void)li; (void)mod_l; (void)mod_n; (void)xres; (void)CNT; (void)OFFS

__global__ void __launch_bounds__(NTHR, 2) mega(Params P) {
    extern __shared__ __attribute__((aligned(16))) unsigned char lds_raw[];
    LAS unsigned char* lds = (LAS unsigned char*)lds_raw;
    volatile LAS unsigned* MISC = (volatile LAS unsigned*)(lds + MISC_OFF);
    for (int u = threadIdx.x; u < (LDS_BYTES - MISC_OFF) / 4; u += NTHR) ((LAS unsigned*)(lds + MISC_OFF))[u] = 0u;
    __syncthreads();
    const int wave0 = __builtin_amdgcn_readfirstlane((int)(threadIdx.x >> 6));
    XcdBarrier bar = xcd_barrier_post((unsigned*)(P.ws + WS_CTL) + CW_BAR, MISC + 8, wave0);
    const int lo = P.ph_lo, hi = P.ph_hi;
#define IN(k) (lo <= (k) && (k) < hi)
#define SEAM(k) do { if ((k) + 1 < hi) xcd_barrier(bar); } while (0)

    if (IN(PH_PREP)) {
        PH_LOCALS;
        LAS float* scr = (LAS float*)(lds + wave * F8_SCR);
        for (int j = gw; j < F8_ITEMS_LAYER; j += NW) f8_convert(P, ws, scr, lane, f8_item_id(0, j));
        constexpr int NITEMS = 2 * 1280 + 2 * 512 + 2 * 768 + 2 * 96 + 2 * 64 + 2 * 512;
        for (int it0 = gw; it0 < NITEMS; it0 += NW) {
            int it = it0;
            if (prep_family(it, P.ev_w_in, (size_t)DM * 2560, 2560, DM, 2560, (bf16_t*)(ws + WT_EIN), (size_t)2560 * DM, DM, 0, 2, WM_EIN, scr, lane)) continue;
            if (prep_family(it, P.ev_w_out, (size_t)DM * DM, DM, DM, DM, (bf16_t*)(ws + WT_EOUT), (size_t)DM * DM, DM, 0, 2, WM_ID, scr, lane)) continue;
            if (prep_family(it, P.od_w_in, (size_t)DM * 1440, 1440, DM, 1536, (bf16_t*)(ws + WT_OIN), (size_t)1536 * DM, DM, 0, 2, WM_OIN, scr, lane)) continue;
            if (prep_family(it, P.od_w_uq, (size_t)256 * 768, 768, 256, 768, (bf16_t*)(ws + WT_OUP), (size_t)1792 * 256, 256, 0, 2, WM_UQ, scr, lane)) continue;
            if (prep_family(it, P.od_w_ukv, (size_t)128 * 1024, 1024, 128, 1024, (bf16_t*)(ws + WT_OUP) + (size_t)768 * 256, (size_t)1792 * 256, 256, 128, 2, WM_UKV, scr, lane)) continue;
            prep_family(it, P.od_w_out, (size_t)DM * DM, DM, DM, DM, (bf16_t*)(ws + WT_OOUT), (size_t)DM * DM, DM, 0, 2, WM_ID, scr, lane);
        }
        for (size_t i = gtid; i < (size_t)2 * 1792 * 256; i += GT) { const int col = (int)(i & 255), row = (int)((i >> 8) % 1792); if (row >= 768 && col < 128) ((bf16_t*)(ws + WT_OUP))[i] = 0; }
        for (size_t i = gtid; i < (size_t)2 * 8 * 128 * 128; i += GT) { const int jj = (int)(i & 127), ii = (int)((i >> 7) & 127); ((bf16_t*)(ws + WT_SGW))[i] = jj <= ii ? f2bf(P.ev_sg_w[i]) : (bf16_t)0; }
        for (size_t i = gtid; i < (size_t)NT * 16; i += GT) { const int tok = (int)(i >> 4), f = (int)(i & 15); float c, s; sincos_d((double)P.pos_in[tok] * INVF[f], c, s); CS[(size_t)tok * 32 + f] = c; CS[(size_t)tok * 32 + 16 + f] = s; }
        __syncthreads();
        {
            LAS float* sc = (LAS float*)lds;
            LAS float* red = (LAS float*)(lds + 32768);
            for (int i = tid; i < NB * DM; i += NTHR) { const float v = P.c_in[i]; sc[i] = v * sigmoidf_(v); }
            __syncthreads();
            for (int item = bx; item < DEPTH * 6 * DM / 64; item += G) {
                const int col = item * 64 + (tid & 63), l = col / (6 * DM), n = col % (6 * DM), kg = tid >> 6;
                float a[NB];
#pragma unroll
                for (int b = 0; b < NB; ++b) a[b] = 0.f;
                const float* w = P.ada_w + (size_t)l * DM * 6 * DM + (size_t)(kg * 128) * 6 * DM + n;
                for (int k = 0; k < 128; ++k) { const float wv = w[(size_t)k * 6 * DM];
#pragma unroll
                    for (int b = 0; b < NB; ++b) a[b] += sc[b * DM + kg * 128 + k] * wv; }
#pragma unroll
                for (int b = 0; b < NB; ++b) red[(kg * NB + b) * 64 + (tid & 63)] = a[b];
                __syncthreads();
                { const int b = tid >> 6, cc = tid & 63; float s = 0.f;
#pragma unroll
                    for (int k8 = 0; k8 < 8; ++k8) s += red[(k8 * NB + b) * 64 + cc];
                    const int col2 = item * 64 + cc, l2 = col2 / (6 * DM), n2 = col2 % (6 * DM);
                    MOD[((size_t)l2 * NB + b) * 6 * DM + n2] = s + P.ada_b[(size_t)l2 * 6 * DM + n2]; }
                __syncthreads();
            }
        }
        SEAM(PH_PREP);
    }
    if (IN(PH_MOD0)) {
        PH_LOCALS;
        for (size_t i = gtid * 4; i < (size_t)NT * DM; i += GT * 4) { const int tok = (int)(i / DM), col = (int)(i % DM), b = tok / SEQ; const float* m = MOD + (size_t)b * 6 * DM;
            const float4 xv = *(const float4*)(P.x_in + i), sc = *(const float4*)(m + DM + col), sh = *(const float4*)(m + col);
            ushort4 o; o.x = f2bf(xv.x * (1.f + sc.x) + sh.x); o.y = f2bf(xv.y * (1.f + sc.y) + sh.y); o.z = f2bf(xv.z * (1.f + sc.z) + sh.z); o.w = f2bf(xv.w * (1.f + sc.w) + sh.w);
            *(ushort4*)(U + i) = o; }
        SEAM(PH_MOD0);
    }

#define CATCHUP_F8 do { if (ly > 0) { const int nMp = __builtin_amdgcn_readfirstlane((int)(ctl[CW_OFFS + (ly - 1) * 64 + NEXP] >> 8)); const SparePlan spc = spare_plan(nMp, G); \
            LAS float* scr = (LAS float*)(lds + wave * F8_SCR); for (int j = spc.done + gw; j < F8_ITEMS_LAYER; j += NW) f8_convert(P, ws, scr, lane, f8_item_id(ly, j)); __syncthreads(); } } while (0)
    for (int layer = 0; layer < DEPTH; ++layer) {
        const int pb = PH_LAYER0 + PH_STRIDE * layer;
        if ((layer & 1) == 0) {
            if (IN(pb + LP_IN)) {
                PH_LOCALS; LY_LOCALS;
                pg8::Gemm g{U, DM, nullptr, (const bf16_t*)(ws + WT_EIN) + (size_t)li * 2560 * DM, DM, 0, DM};
                pg8::Sched S; S.init(NT / 256, 10, G, bx, nullptr);
                pg8::EpiE1 E{BG, CX, GZU, GZV};
                const bool cfirst = ((bx >> 3) & 1) != 0;
#pragma unroll 1
                for (int st = 0; st < 2; ++st) { if ((st == 0) == cfirst) CATCHUP_F8; else pg8::gemm_phase(lds, wave, g, S, E); }
                SEAM(pb + LP_IN);
            }
            if (IN(pb + LP_MIX)) {
                PH_LOCALS; LY_LOCALS;
                even_mix_phase(lds, wave, lane, bx, G, BG, CX, GZU, GZV, (const bf16_t*)(ws + WT_SGW) + (size_t)li * 8 * 128 * 128, P.ev_conv_w + (size_t)li * 3 * 512, P.ev_sg_b + (size_t)li * 8 * 128,
                               P.ev_vn_g + (size_t)li * 512, P.ev_vn_b + (size_t)li * 512, Y);
                SEAM(pb + LP_MIX);
            }
        } else {
            if (IN(pb + LP_IN)) {
                PH_LOCALS; LY_LOCALS;
                pg8::Gemm g{U, DM, nullptr, (const bf16_t*)(ws + WT_OIN) + (size_t)li * 1536 * DM, DM, 0, DM};
                pg8::Sched S; S.init(NT / 256, 6, G, bx, nullptr);
                pg8::EpiO1 E{GLU, CQKV, KRR};
                const bool cfirst = ((bx >> 3) & 1) != 0;
#pragma unroll 1
                for (int st = 0; st < 2; ++st) { if ((st == 0) == cfirst) CATCHUP_F8; else pg8::gemm_phase(lds, wave, g, S, E); }
                SEAM(pb + LP_IN);
            }
            if (IN(pb + LP_MIX)) {
                PH_LOCALS; LY_LOCALS;
                odd_mix_phase(lds, wave, lane, bx, G, GLU, CQKV, KRR, CS, P.od_dw_w + (size_t)li * 31 * 512, P.od_dw_b + (size_t)li * 512, P.od_cn_g + (size_t)li * 512, P.od_cn_b + (size_t)li * 512,
                              P.od_qn_g + (size_t)li * 256, P.od_kvn_g + (size_t)li * 128, Y, CQKVN, KR);
                SEAM(pb + LP_MIX);
            }
            if (IN(pb + LP_UP)) {
                PH_LOCALS; LY_LOCALS;
                pg8::Gemm g{CQKVN, 384, nullptr, (const bf16_t*)(ws + WT_OUP) + (size_t)li * 1792 * 256, 256, 0, 256, 3, 128};
                pg8::Sched S; S.init(NT / 256, 7, G, bx, nullptr);
                pg8::EpiO3 E{Q, KN, VV, CS};
                pg8::gemm_phase(lds, wave, g, S, E);
                SEAM(pb + LP_UP);
            }
            if (IN(pb + LP_ATT)) {
                PH_LOCALS; LY_LOCALS;
                attn_phase(lds, wave, lane, bx, G, Q, KN, KR, VV, Y);
                SEAM(pb + LP_ATT);
            }
        }
        if (IN(pb + LP_OUT)) {
                PH_LOCALS; LY_LOCALS;
            pg8::Gemm g{Y, DM, nullptr, (const bf16_t*)(ws + ((ly & 1) ? WT_OOUT : WT_EOUT)) + (size_t)li * DM * DM, DM, 0, DM};
            pg8::Sched S; S.init(NT / 256, 4, G, bx, nullptr);
            if (ly == 0) { pg8::EpiOut<true> E{P.x_in, mod_l + 2 * DM, (bf16_t*)V, lds}; pg8::gemm_phase(lds, wave, g, S, E); }
            else { pg8::EpiOut<false> E{X, mod_l + 2 * DM, (bf16_t*)V, lds}; pg8::gemm_phase(lds, wave, g, S, E); }
            SEAM(pb + LP_OUT);
        }
        if (IN(pb + LP_LNR)) {
                PH_LOCALS; LY_LOCALS;
            lnr_phase(lds, wave, lane, bx, G, (const bf16_t*)V, P.ln_mix_g + (size_t)ly * DM, P.ln_mix_b + (size_t)ly * DM, mod_l, (float*)(ws + WS_STAT), ws + WS_U8, P.r_w + (size_t)ly * DM * NEXP, P.r_b + (size_t)ly * NEXP, TOPE, TOPG, POS, (int*)(ws + WS_LIST), CNT);
            SEAM(pb + LP_LNR);
        }
        if (IN(pb + LP_M1)) {
                PH_LOCALS; LY_LOCALS;
            LAS unsigned char* l2 = lds; asm volatile("" : "+v"(l2));
            volatile LAS unsigned* offs = (volatile LAS unsigned*)(l2 + MISC_OFF) + 64;
            if (tid < NEXP) offs[48 + tid] = CNT[tid];
            __syncthreads();
            if (tid <= NEXP) { unsigned o = 0; for (int e = 0; e < NEXP; ++e) { const unsigned c = offs[48 + e]; if (e < tid) o += (c + 255u) & ~255u; } offs[tid] = o; }
            __syncthreads();
            if (bx == 0 && tid <= NEXP) OFFS[tid] = offs[tid];
            const int nM = __builtin_amdgcn_readfirstlane((int)(offs[NEXP] >> 8));
            LAS int* tile_e = (LAS int*)(lds + MISC_OFF + 1024);
            for (int pm = tid; pm < nM; pm += NTHR) { const unsigned rowb = (unsigned)pm * 256u; int e = 0;
                for (int j = 1; j < NEXP; ++j) e += (rowb >= offs[j]) ? 1 : 0;
                tile_e[pm] = e; }
            __syncthreads();
            pg8::Gemm g{(const bf16_t*)(ws + WS_U8), DM / 2, (const int*)(ws + WS_LIST), (const bf16_t*)(ws + WT_GU) + (size_t)ly * NEXP * 2048 * (DM / 2), DM / 2, (size_t)2048 * (DM / 2), DM / 2};
            const SparePlan sp = spare_plan(nM, G);
            if (bx < sp.g1) {
                pg8::Sched S; S.init(nM, 8, sp.g1, bx, tile_e);
                pg8::EpiM1 E{P.b_gu + (size_t)ly * NEXP * 2048, (unsigned char*)H, lds};
                pg8::gemm_phase<pg8::EpiM1, 127 - W8_GU_SH>(lds, wave, g, S, E);
            } else if (ly + 1 < DEPTH) { const int k = bx - sp.g1; f8_convert_range(P, ws, (LAS float*)(lds + wave * F8_SCR), lane, wave, ly + 1, k * sp.q1, (k + 1) * sp.q1); }
            SEAM(pb + LP_M1);
        }
        if (IN(pb + LP_M2)) {
                PH_LOCALS; LY_LOCALS;
            LAS unsigned char* l2 = lds; asm volatile("" : "+v"(l2));
            const int nM = __builtin_amdgcn_readfirstlane((int)(((volatile LAS unsigned*)(l2 + MISC_OFF))[64 + NEXP] >> 8));
            LAS int* tile_e = (LAS int*)(lds + MISC_OFF + 1024);
            pg8::Gemm g{H, DM / 2, nullptr, (const bf16_t*)(ws + WT_DN) + (size_t)ly * NEXP * DM * (DM / 2), DM / 2, (size_t)DM * (DM / 2), DM / 2};
            const SparePlan sp = spare_plan(nM, G);
            if (bx < sp.g2) {
                pg8::Sched S; S.init(nM, 4, sp.g2, bx, tile_e);
                pg8::EpiM2 E{P.b_dn + (size_t)ly * NEXP * DM, YS, lds};
                pg8::gemm_phase<pg8::EpiM2, 127 - W8_DN_SH + 4>(lds, wave, g, S, E);
            } else if (ly + 1 < DEPTH) { const int k = bx - sp.g2, first = (G - sp.g1) * sp.q1; f8_convert_range(P, ws, (LAS float*)(lds + wave * F8_SCR), lane, wave, ly + 1, first + k * sp.q2, first + (k + 1) * sp.q2); }
            SEAM(pb + LP_M2);
        }
        if (IN(pb + LP_LNF)) {
                PH_LOCALS; LY_LOCALS;
            const float* lng = P.ln_ffn_g + (size_t)ly * DM; const float* lnb = P.ln_ffn_b + (size_t)ly * DM;
            float* out_final = ly == DEPTH - 1 ? P.out : nullptr;
            lnf_phase(lds, wave, lane, bx, G, YS, TOPE, POS, OFFS, TOPG, lng, lnb, mod_l, mod_n, (const bf16_t*)V, (const float*)(ws + WS_STAT), P.ln_mix_g + (size_t)ly * DM, P.ln_mix_b + (size_t)ly * DM, (bf16_t*)X, U, out_final);
            SEAM(pb + LP_LNF);
        }
    }
#undef IN
#undef SEAM
#undef CATCHUP_F8
}

extern "C" void kernel_launch(void* const* d_in, const int* in_sizes, int n_in, void* d_out, int out_size, void* d_ws, size_t ws_size, hipStream_t stream) {
    if (n_in != 32 || in_sizes[0] != NT * DM || out_size != NT * DM || ws_size < WS_END) { fprintf(stderr, "kernel_launch: built for 32 inputs, x / out of %d floats and >= %zu bytes of workspace; got n_in %d, out %d, ws %zu; nothing launched\n", NT * DM, (size_t)WS_END, n_in, out_size, ws_size); return; }
    static int grid = 0;
    if (grid == 0) {
        int dev = 0, cus = 0;
        if (hipGetDevice(&dev) != hipSuccess || hipDeviceGetAttribute(&cus, hipDeviceAttributeMultiprocessorCount, dev) != hipSuccess) { fprintf(stderr, "kernel_launch: device query failed; nothing launched\n"); grid = -1; return; }
        if (hipFuncSetAttribute((const void*)mega, hipFuncAttributeMaxDynamicSharedMemorySize, LDS_BYTES) != hipSuccess) { fprintf(stderr, "kernel_launch: hipFuncSetAttribute(%d B of dynamic LDS) failed; nothing launched\n", LDS_BYTES); grid = -1; return; }
        int per_cu = 0;
        if (hipOccupancyMaxActiveBlocksPerMultiprocessor(&per_cu, (const void*)mega, NTHR, LDS_BYTES) != hipSuccess || per_cu < 1) { fprintf(stderr, "kernel_launch: the occupancy query reports %d workgroups per CU; nothing launched\n", per_cu); (void)hipGetLastError(); grid = -1; return; }
        (void)hipGetLastError();
        grid = cus;
    }
    if (grid < 0) return;
    (void)hipMemsetAsync((unsigned char*)d_ws + WS_CTL, 0, 1 * MiB, stream);
    Params P{};
    P.x_in = (const float*)d_in[0]; P.c_in = (const float*)d_in[1]; P.pos_in = (const int*)d_in[2]; P.ada_w = (const float*)d_in[3]; P.ada_b = (const float*)d_in[4];
    P.ln_mix_g = (const float*)d_in[5]; P.ln_mix_b = (const float*)d_in[6]; P.ln_ffn_g = (const float*)d_in[7]; P.ln_ffn_b = (const float*)d_in[8];
    P.ev_w_in = (const float*)d_in[9]; P.ev_conv_w = (const float*)d_in[10]; P.ev_sg_w = (const float*)d_in[11]; P.ev_sg_b = (const float*)d_in[12]; P.ev_vn_g = (const float*)d_in[13]; P.ev_vn_b = (const float*)d_in[14]; P.ev_w_out = (const float*)d_in[15];
    P.od_w_in = (const float*)d_in[16]; P.od_dw_w = (const float*)d_in[17]; P.od_dw_b = (const float*)d_in[18]; P.od_cn_g = (const float*)d_in[19]; P.od_cn_b = (const float*)d_in[20]; P.od_qn_g = (const float*)d_in[21];
    P.od_w_uq = (const float*)d_in[22]; P.od_kvn_g = (const float*)d_in[23]; P.od_w_ukv = (const float*)d_in[24]; P.od_w_out = (const float*)d_in[25];
    P.r_w = (const float*)d_in[26]; P.r_b = (const float*)d_in[27]; P.w_gu = (const float*)d_in[28]; P.b_gu = (const float*)d_in[29]; P.w_dn = (const float*)d_in[30]; P.b_dn = (const float*)d_in[31];
    P.out = (float*)d_out; P.ws = (unsigned char*)d_ws; P.ph_lo = 0; P.ph_hi = PH_END;
    hipLaunchKernelGGL(mega, dim3(grid), dim3(NTHR), LDS_BYTES, stream, P);
}
```
